# Optimizing an MI355X kernel written in HIP

```python
import math
import jax, jax.numpy as jnp
from jax import lax
import numpy as np

D_MODEL = 1024
BATCH = 2
SEQ = 8192
DEPTH = 1
DEC_BATCH = 128
DEC_SEQ = 8
PAST_LEN = 2048
PAGE_SIZE = 128

D_MIX = D_MODEL
D_ATT = D_MIX // 2
D_CONV = D_MIX - D_ATT
N_HEADS = 4
HEAD_DIM = D_ATT // (2 * N_HEADS)
V_DIM = 2 * HEAD_DIM
CONV_W = 31
Q_BLOCK = 128
EPS = 1e-5
SPLITS = (D_ATT, 2 * D_ATT, 3 * D_ATT, 4 * D_ATT, 4 * D_ATT + D_CONV, 4 * D_ATT + 2 * D_CONV)
D_IN = 4 * D_ATT + 3 * D_CONV

kernel_name = 'hymba_diffattn_conformer_step'


def rmsnorm(x, g):
    xf = x.astype(jnp.float32)
    y = xf * lax.rsqrt(jnp.mean(xf * xf, axis=-1, keepdims=True) + EPS)
    return y.astype(x.dtype) * g


def layernorm(x, g, b):
    xf = x.astype(jnp.float32)
    mu = jnp.mean(xf, axis=-1, keepdims=True)
    var = jnp.mean(jnp.square(xf - mu), axis=-1, keepdims=True)
    return ((xf - mu) * lax.rsqrt(var + EPS)).astype(x.dtype) * g + b


def in_project(h, w_in):
    n, t = h.shape[0], h.shape[1]
    z = h @ w_in
    q, k, v, g_att, a, b, g_conv = jnp.split(z, SPLITS, axis=-1)
    q = q.reshape(n, t, N_HEADS, 2, HEAD_DIM)
    k = k.reshape(n, t, N_HEADS, V_DIM)
    v = v.reshape(n, t, N_HEADS, V_DIM)
    u = a * jax.nn.sigmoid(b)
    return q, k, v, g_att, u, g_conv


def diff_attend(q, k, v, q_pos, k_pos, lam):
    k = k.reshape(k.shape[:3] + (2, HEAD_DIM))
    s = jnp.einsum('nqhmd,nkhmd->nhmqk', q, k).astype(jnp.float32) * (HEAD_DIM ** -0.5)
    mask = k_pos[None, :] <= q_pos[:, None]
    s = jnp.where(mask, s, -jnp.inf)
    p = jax.nn.softmax(s, axis=-1)
    a = p[:, :, 0] - lam * p[:, :, 1]
    return jnp.einsum('nhqk,nkhe->nqhe', a.astype(v.dtype), v)


def attn_post(o, subln_g, lam_init):
    n, t = o.shape[0], o.shape[1]
    o = rmsnorm(o, subln_g) * (1.0 - lam_init)
    return o.reshape(n, t, D_ATT)


def conv_branch(u, buf, dw_w, dw_b, ln_g, ln_b, w_pw2, b_pw2):
    u_ext = jnp.concatenate([buf, u], axis=1)
    c = lax.conv_general_dilated(u_ext, dw_w[:, None, :], window_strides=(1,), padding='VALID',
                                 dimension_numbers=('NWC', 'WIO', 'NWC'),
                                 feature_group_count=D_CONV) + dw_b
    c = jax.nn.silu(layernorm(c, ln_g, ln_b))
    return c @ w_pw2 + b_pw2, u_ext[:, -(CONV_W - 1):]


def mix_out(att, conv, g_att, g_conv, w_out):
    m = jnp.concatenate([att * jax.nn.silu(g_att), conv * jax.nn.silu(g_conv)], axis=-1)
    return m @ w_out


def setup_inputs(seed: int = 0) -> dict:
    key = jax.random.key(seed)
    ks = jax.random.split(key, 24)
    n_pages = PAST_LEN // PAGE_SIZE
    n_used = DEC_BATCH * n_pages
    n_pool = n_used + max(1, n_used // 4)
    f32 = jnp.float32
    nrm = lambda k, s, sc: jax.random.normal(k, s, f32) * sc
    page_table = jax.random.permutation(ks[5], n_pool)[:n_used].reshape(DEC_BATCH, n_pages).astype(jnp.int32)
    return {
        'x_prompt': nrm(ks[0], (BATCH, SEQ, D_MODEL), 1.0),
        'x_sample': nrm(ks[1], (DEC_BATCH, DEC_SEQ, D_MODEL), 1.0),
        'cache_k': nrm(ks[2], (DEPTH, n_pool, PAGE_SIZE, N_HEADS, V_DIM), 1.0),
        'cache_v': nrm(ks[3], (DEPTH, n_pool, PAGE_SIZE, N_HEADS, V_DIM), 1.0),
        'state_conv': nrm(ks[4], (DEPTH, DEC_BATCH, CONV_W - 1, D_CONV), 0.5),
        'page_table': page_table,
        'norm_g': 1.0 + nrm(ks[6], (DEPTH, D_MODEL), 0.02),
        'w_in': nrm(ks[7], (DEPTH, D_MODEL, D_IN), D_MODEL ** -0.5),
        'lambda_q1': nrm(ks[8], (DEPTH, HEAD_DIM), 0.1),
        'lambda_k1': nrm(ks[9], (DEPTH, HEAD_DIM), 0.1),
        'lambda_q2': nrm(ks[10], (DEPTH, HEAD_DIM), 0.1),
        'lambda_k2': nrm(ks[11], (DEPTH, HEAD_DIM), 0.1),
        'subln_g': 1.0 + nrm(ks[12], (DEPTH, V_DIM), 0.02),
        'dw_w': nrm(ks[13], (DEPTH, CONV_W, D_CONV), CONV_W ** -0.5),
        'dw_b': nrm(ks[14], (DEPTH, D_CONV), 0.02),
        'conv_ln_g': 1.0 + nrm(ks[15], (DEPTH, D_CONV), 0.02),
        'conv_ln_b': nrm(ks[16], (DEPTH, D_CONV), 0.02),
        'w_pw2': nrm(ks[17], (DEPTH, D_CONV, D_CONV), D_CONV ** -0.5),
        'b_pw2': nrm(ks[18], (DEPTH, D_CONV), 0.02),
        'w_out': nrm(ks[19], (DEPTH, D_MIX, D_MODEL), D_MIX ** -0.5),
        'final_norm_g': 1.0 + nrm(ks[20], (D_MODEL,), 0.02),
    }


def reference(x_prompt, x_sample, cache_k, cache_v, state_conv, page_table, norm_g, w_in,
              lambda_q1, lambda_k1, lambda_q2, lambda_k2, subln_g, dw_w, dw_b, conv_ln_g,
              conv_ln_b, w_pw2, b_pw2, w_out, final_norm_g):
    yp, ys = x_prompt, x_sample
    kp_l, vp_l, cp_l, ks_l, vs_l, cs_l = [], [], [], [], [], []
    n_blocks = SEQ // Q_BLOCK
    for l in range(DEPTH):
        lam_init = 0.8 - 0.6 * math.exp(-0.3 * l)
        f = lambda t: t.astype(jnp.float32)
        lam = (jnp.exp(jnp.sum(f(lambda_q1[l]) * f(lambda_k1[l])))
               - jnp.exp(jnp.sum(f(lambda_q2[l]) * f(lambda_k2[l]))) + lam_init)
        conv_p = (dw_w[l], dw_b[l], conv_ln_g[l], conv_ln_b[l], w_pw2[l], b_pw2[l])

        h = rmsnorm(yp, norm_g[l])
        q, k, v, g_att, u, g_conv = in_project(h, w_in[l])
        k_pos = jnp.arange(SEQ)

        def q_block(i, q=q, k=k, v=v, k_pos=k_pos, lam=lam):
            qb = lax.dynamic_slice_in_dim(q, i * Q_BLOCK, Q_BLOCK, axis=1)
            return diff_attend(qb, k, v, i * Q_BLOCK + jnp.arange(Q_BLOCK), k_pos, lam)

        o = lax.map(q_block, jnp.arange(n_blocks))
        o = jnp.moveaxis(o, 0, 1).reshape(BATCH, SEQ, N_HEADS, V_DIM)
        att = attn_post(o, subln_g[l], lam_init)
        zero_buf = jnp.zeros((BATCH, CONV_W - 1, D_CONV), u.dtype)
        conv, buf_p = conv_branch(u, zero_buf, *conv_p)
        yp = yp + mix_out(att, conv, g_att, g_conv, w_out[l])
        kp_l.append(k); vp_l.append(v); cp_l.append(buf_p)

        h = rmsnorm(ys, norm_g[l])
        q, k, v, g_att, u, g_conv = in_project(h, w_in[l])
        k_past = cache_k[l][page_table].reshape(DEC_BATCH, PAST_LEN, N_HEADS, V_DIM)
        v_past = cache_v[l][page_table].reshape(DEC_BATCH, PAST_LEN, N_HEADS, V_DIM)
        keys = jnp.concatenate([k_past, k], axis=1)
        vals = jnp.concatenate([v_past, v], axis=1)
        o = diff_attend(q, keys, vals, PAST_LEN + jnp.arange(DEC_SEQ),
                        jnp.arange(PAST_LEN + DEC_SEQ), lam)
        att = attn_post(o, subln_g[l], lam_init)
        conv, buf_s = conv_branch(u, state_conv[l], *conv_p)
        ys = ys + mix_out(att, conv, g_att, g_conv, w_out[l])
        ks_l.append(k); vs_l.append(v); cs_l.append(buf_s)

    y_prompt = rmsnorm(yp, final_norm_g)
    y_sample = rmsnorm(ys, final_norm_g)
    return (y_prompt, y_sample, jnp.stack(kp_l), jnp.stack(vp_l), jnp.stack(cp_l),
            jnp.stack(ks_l), jnp.stack(vs_l), jnp.stack(cs_l))
```

```cpp
#include <hip/hip_runtime.h>
#include <cstdio>
#include <cstdint>
constexpr int D_MODEL = 1024, SEQ = 8192, NBATCH = 2, MP = NBATCH * SEQ;
constexpr int DEC_B = 128, DEC_S = 8, MS = DEC_B * DEC_S;
constexpr int MT = MP + MS;
constexpr int D_IN = 3584, CONV_W = 31, HIST = 30, NPAGES = 16;
constexpr float EPS = 1e-5f, LOG2E = 1.4426950408889634f;
constexpr float QSCALE = 0.125f * LOG2E;
constexpr size_t OFF_YP = 0, OFF_YS = OFF_YP + (size_t)MP * D_MODEL, OFF_KP = OFF_YS + (size_t)MS * D_MODEL, OFF_VP = OFF_KP + (size_t)MP * 512, OFF_CP = OFF_VP + (size_t)MP * 512,
    OFF_KS = OFF_CP + (size_t)NBATCH * HIST * 512, OFF_VS = OFF_KS + (size_t)MS * 512, OFF_CS = OFF_VS + (size_t)MS * 512, OUT_TOTAL = OFF_CS + (size_t)DEC_B * HIST * 512;
static_assert(OUT_TOTAL == 37648384, "output size");
namespace pg8 {
#define PG8_LAS __attribute__((address_space(3)))
typedef unsigned short bf16_t;
typedef short bf16x8 __attribute__((ext_vector_type(8)));
typedef float f32x4 __attribute__((ext_vector_type(4)));
typedef unsigned u32x4 __attribute__((ext_vector_type(4)));
constexpr int BM = 256, BK = 64, HALF = 128, HTB = HALF * BK * 2  , STAGE_BYTES = 8 * HTB, NXCD = 8, WGM = 8;

__host__ __device__ __forceinline__ int lds_byte(int r, int c) { const int st = (r >> 4) * 2 + (c >> 5), rr = r & 15, cc = c & 31, ob = rr * 64 + cc * 2; return st * 1024 + (ob ^ (((ob >> 9) & 1) << 5)); }
__host__ __device__ __forceinline__ void stage_rc(int b, int& R, int& C) { const int st = b / 1024, sb = b % 1024, swz = sb ^ (((sb >> 9) & 1) << 5); R = (st >> 1) * 16 + swz / 64; C = (st & 1) * 32 + (swz % 64) / 2; }
__host__ __device__ __forceinline__ int perm32(int rho) { const int n = rho >> 4, i = rho & 15; return 8 * (i >> 2) + 4 * n + (i & 3); }

struct Unit { int pm, pn; };
struct Gemm { const bf16_t* A; const bf16_t* Bt; int M, N, K; };

struct StaticOrder {
    int nM, nN, nwg, G, c;
    __host__ __device__ void init(int M, int N, int G_, int c_) { nM = M / BM; nN = N / BM; nwg = nM * nN; G = G_; c = c_; }
    __host__ __device__ bool next(int i, Unit& u) const {
        const long L = (long)i * G + c; if (L >= nwg) return false;
        int wgid = (int)L; { const int q = nwg / NXCD, r = nwg % NXCD, xcd = wgid % NXCD, off = wgid / NXCD; wgid = (xcd < r ? xcd * (q + 1) : r * (q + 1) + (xcd - r) * q) + off; }
        const int nig = WGM * nN, gid = wgid / nig, fm = gid * WGM, gsz = (nM - fm) < WGM ? (nM - fm) : WGM;
        u.pm = fm + ((wgid % nig) % gsz); u.pn = (wgid % nig) / gsz; return true;
    }
    __device__ __forceinline__ void a_ready(const Unit&) const {}
    __device__ __forceinline__ void done(const Unit&) const {}
};
__device__ __forceinline__ unsigned cvt_pk_bf16(float lo, float hi) { unsigned r; asm volatile("v_cvt_pk_bf16_f32 %0, %1, %2" : "=v"(r) : "v"(lo), "v"(hi)); return r; }
typedef float f32x2 __attribute__((ext_vector_type(2)));
__device__ __forceinline__ float sigm_f(float x) { return __builtin_amdgcn_rcpf(1.0f + __builtin_amdgcn_exp2f(-LOG2E * x)); }
__device__ __forceinline__ float silu_f(float x) { return x * sigm_f(x); }
__device__ __forceinline__ u32x4 pack8(const f32x4 v0, const f32x4 v1) { u32x4 w; w.x = cvt_pk_bf16(v0[0], v0[1]); w.y = cvt_pk_bf16(v0[2], v0[3]); w.z = cvt_pk_bf16(v1[0], v1[1]); w.w = cvt_pk_bf16(v1[2], v1[3]); return w; }
struct EpiIn {
    static constexpr bool PERM = true, AFTER_DRAIN = false;
    bf16_t *Qb, *Kb, *Vb, *GAb, *GCb; float* U; float* out;
    __device__ __forceinline__ void operator()(const f32x4 (&acc)[2][2][4][2], const Unit& u, int wr, int wc, int fr, int fq) const {
        const int row0 = u.pm * BM + wr * 64 + fr, pn = u.pn, cw = wc * 32 + 8 * fq;
        if (pn < 2 || pn == 6 || pn == 7 || pn >= 12) {
            bf16_t* base; int mode;
            if (pn < 2) { base = Qb + pn * 256; mode = 0; } else if (pn < 8) { base = GAb + (pn - 6) * 256; mode = 1; } else { base = GCb + (pn - 12) * 256; mode = 2; }
#pragma unroll
            for (int ai = 0; ai < 2; ++ai)
#pragma unroll
                for (int m = 0; m < 4; ++m) { bf16_t* rowp = base + (size_t)(row0 + ai * HALF + m * 16) * 512 + cw;
#pragma unroll
                    for (int bj = 0; bj < 2; ++bj) { f32x4 v0 = acc[ai][bj][m][0], v1 = acc[ai][bj][m][1];
                        if (mode == 0) { v0 = v0 * QSCALE; v1 = v1 * QSCALE; }
                        else { const float sc = mode == 1 ? 0.8f : 1.0f;
#pragma unroll
                            for (int i = 0; i < 4; ++i) { v0[i] = silu_f(v0[i]) * sc; v1[i] = silu_f(v1[i]) * sc; } }
                        *(u32x4*)(rowp + bj * HALF) = pack8(v0, v1); } }
        } else if (pn < 6) {
            const int t = (pn - 2) >> 1, cb = ((pn - 2) & 1) * 256 + cw; const bool smp = u.pm >= MP / BM;
            bf16_t* bb = (t ? Vb : Kb) + cb;
            float* fb = out + (smp ? (t ? OFF_VS : OFF_KS) - (size_t)MP * 512 : (t ? OFF_VP : OFF_KP)) + cb;
#pragma unroll
            for (int ai = 0; ai < 2; ++ai)
#pragma unroll
                for (int m = 0; m < 4; ++m) { const size_t ro = (size_t)(row0 + ai * HALF + m * 16) * 512;
#pragma unroll
                    for (int bj = 0; bj < 2; ++bj) { const f32x4 v0 = acc[ai][bj][m][0], v1 = acc[ai][bj][m][1];
                        *(f32x4*)(fb + ro + bj * HALF) = v0; *(f32x4*)(fb + ro + bj * HALF + 4) = v1; *(u32x4*)(bb + ro + bj * HALF) = pack8(v0, v1); } }
        } else {
            float* ub = U + 128 * (pn - 8) + cw;
#pragma unroll
            for (int ai = 0; ai < 2; ++ai)
#pragma unroll
                for (int m = 0; m < 4; ++m) { const size_t ro = (size_t)(row0 + ai * HALF + m * 16) * 512;
#pragma unroll
                    for (int n = 0; n < 2; ++n) { const f32x4 a = acc[ai][0][m][n], b = acc[ai][1][m][n]; f32x4 o;
#pragma unroll
                        for (int i = 0; i < 4; ++i) o[i] = a[i] * sigm_f(b[i]);
                        *(f32x4*)(ub + ro + 4 * n) = o; } }
        }
    }
};
struct EpiPw2 {
    static constexpr bool PERM = true, AFTER_DRAIN = false;
    const float* bias; const bf16_t* GCb; bf16_t* Mb;
    __device__ __forceinline__ void operator()(const f32x4 (&acc)[2][2][4][2], const Unit& u, int wr, int wc, int fr, int fq) const {
        const int row0 = u.pm * BM + wr * 64 + fr, c0 = u.pn * BM + wc * 32 + 8 * fq;
        f32x4 bv[2][2];
#pragma unroll
        for (int bj = 0; bj < 2; ++bj)
#pragma unroll
            for (int n = 0; n < 2; ++n) bv[bj][n] = *(const f32x4*)(bias + c0 + bj * HALF + 4 * n);
#pragma unroll
        for (int ai = 0; ai < 2; ++ai)
#pragma unroll
            for (int m = 0; m < 4; ++m) { const size_t r = (size_t)(row0 + ai * HALF + m * 16);
#pragma unroll
                for (int bj = 0; bj < 2; ++bj) { const u32x4 gw = *(const u32x4*)(GCb + r * 512 + c0 + bj * HALF);
                    f32x4 g0, g1; g0[0] = __uint_as_float(gw.x << 16); g0[1] = __uint_as_float(gw.x & 0xffff0000u); g0[2] = __uint_as_float(gw.y << 16); g0[3] = __uint_as_float(gw.y & 0xffff0000u);
                    g1[0] = __uint_as_float(gw.z << 16); g1[1] = __uint_as_float(gw.z & 0xffff0000u); g1[2] = __uint_as_float(gw.w << 16); g1[3] = __uint_as_float(gw.w & 0xffff0000u);
                    const f32x4 v0 = (acc[ai][bj][m][0] + bv[bj][0]) * g0, v1 = (acc[ai][bj][m][1] + bv[bj][1]) * g1;
                    *(u32x4*)(Mb + r * 1024 + 512 + c0 + bj * HALF) = pack8(v0, v1); } }
    }
};
struct EpiOut {
    static constexpr bool PERM = true, AFTER_DRAIN = false;
    const float* xp; const float* xs; float* out; float* rowss;
    __device__ __forceinline__ void operator()(const f32x4 (&acc)[2][2][4][2], const Unit& u, int wr, int wc, int fr, int fq) const {
        const int row0 = u.pm * BM + wr * 64 + fr, c0 = u.pn * BM + wc * 32 + 8 * fq;
        const bool smp = u.pm >= MP / BM; const float* xb = smp ? xs : xp; const size_t rsub = smp ? (size_t)MP : 0;
#pragma unroll
        for (int ai = 0; ai < 2; ++ai)
#pragma unroll
            for (int m = 0; m < 4; ++m) { const size_t r = (size_t)(row0 + ai * HALF + m * 16); float ss = 0.f;
#pragma unroll
                for (int bj = 0; bj < 2; ++bj)
#pragma unroll
                    for (int n = 0; n < 2; ++n) { const size_t o = r * D_MODEL + c0 + bj * HALF + 4 * n; const f32x4 y = *(const f32x4*)(xb + o - rsub * D_MODEL) + acc[ai][bj][m][n];
                        ss += (y[0] * y[0] + y[1] * y[1]) + (y[2] * y[2] + y[3] * y[3]); *(f32x4*)(out + o) = y; }
                ss += __shfl_xor(ss, 16); ss += __shfl_xor(ss, 32);
                if (fq == 0) rowss[r * 16 + u.pn * 4 + wc] = ss; }
    }
};
template <class Epi, class Sched, bool ALIGN_EPI = false, bool SP2 = false>
__device__ __forceinline__ void gemm_phase(PG8_LAS unsigned char* lds, const Gemm g, const Sched& S, const Epi& E) {
    int tid = threadIdx.x; asm volatile("" : "+v"(tid));
    const int wid = __builtin_amdgcn_readfirstlane(tid >> 6), lane = tid & 63, wr = wid >> 2, wc = wid & 3, fr = lane & 15, fq = lane >> 4;
    const int K = g.K, nt = K / BK;
    unsigned voffA[2], voffB[2];
#pragma unroll
    for (int i = 0; i < 2; ++i) { int R, C; stage_rc(tid * 16 + i * 8192, R, C); const int Rb = Epi::PERM ? ((R & ~31) + perm32(R & 31)) : R;
        voffA[i] = (unsigned)(R * K + C) * 2u; voffB[i] = (unsigned)(Rb * K + C) * 2u; }
    const size_t kstep = (size_t)(BK * 2);
    const size_t hstep = (size_t)HALF * K * 2;
    const size_t tstep = 2 * hstep;
    const unsigned ldsw = (unsigned)wid * 1024u;
    const int aoff = lds_byte(wr * 64 + fr, fq * 8), boff = lds_byte(wc * 32 + fr, fq * 8);
#define PG8_SA(b, h) (((b) * 2 + (h)) * HTB)
#define PG8_SB(b, h) ((4 + (b) * 2 + (h)) * HTB)
#define PG8_STAGE(bufoff, gbase, voff) do { _Pragma("unroll") for (int _i = 0; _i < 2; ++_i) \
        __builtin_amdgcn_global_load_lds((const unsigned*)((const char*)(gbase) + (voff)[_i]), (PG8_LAS unsigned*)(lds + (bufoff) + ldsw + _i * 8192), 16, 0, 0); } while (0)
#define PG8_LDA(dst, b, h) do { _Pragma("unroll") for (int m = 0; m < 4; ++m) _Pragma("unroll") for (int k = 0; k < 2; ++k) dst[m][k] = *(const PG8_LAS bf16x8*)(lds + PG8_SA(b, h) + aoff + m * 2048 + k * 1024); } while (0)
#define PG8_LDB(dst, b, h) do { _Pragma("unroll") for (int n = 0; n < 2; ++n) _Pragma("unroll") for (int k = 0; k < 2; ++k) dst[n][k] = *(const PG8_LAS bf16x8*)(lds + PG8_SB(b, h) + boff + n * 2048 + k * 1024); } while (0)
#define PG8_MMA(ai, bj, At, Bt) do { __builtin_amdgcn_s_setprio(1); _Pragma("unroll") for (int m = 0; m < 4; ++m) _Pragma("unroll") for (int n = 0; n < 2; ++n) _Pragma("unroll") for (int k = 0; k < 2; ++k) \
        acc[ai][bj][m][n] = __builtin_amdgcn_mfma_f32_16x16x32_bf16(Bt[n][k], At[m][k], acc[ai][bj][m][n], 0, 0, 0); __builtin_amdgcn_s_setprio(0); } while (0)
#define PG8_WAIT_V(n) asm volatile("s_waitcnt vmcnt(" #n ")" ::: "memory")
#define PG8_WAIT_L(n) asm volatile("s_waitcnt lgkmcnt(" #n ")" ::: "memory")
#define PG8_BAR __builtin_amdgcn_s_barrier()
#define PG8_SCHED __builtin_amdgcn_sched_barrier(0)
    Unit cur, nxt; int ui = 0;
    if (!S.next(0, cur)) return;
    f32x4 acc[2][2][4][2];
#pragma unroll
    for (int a = 0; a < 2; ++a)
#pragma unroll
        for (int b = 0; b < 2; ++b)
#pragma unroll
            for (int m = 0; m < 4; ++m)
#pragma unroll
                for (int n = 0; n < 2; ++n) acc[a][b][m][n] = (f32x4){0.f, 0.f, 0.f, 0.f};
    bf16x8 At[4][2], B0[2][2], B1[2][2];
    const char* cA = (const char*)g.A + (size_t)cur.pm * tstep; const char* cB = (const char*)g.Bt + (size_t)cur.pn * tstep;
    S.a_ready(cur);
    if constexpr (SP2) {
        PG8_STAGE(PG8_SB(0, 0), cB, voffB); PG8_STAGE(PG8_SB(0, 1), cB + hstep, voffB); PG8_STAGE(PG8_SA(0, 0), cA, voffA); PG8_STAGE(PG8_SA(0, 1), cA + hstep, voffA);
        if (wr == 1) PG8_BAR;
        PG8_WAIT_V(2); PG8_BAR;
        PG8_STAGE(PG8_SB(1, 0), cB + kstep, voffB); PG8_STAGE(PG8_SA(1, 0), cA + kstep, voffA); PG8_STAGE(PG8_SB(1, 1), cB + hstep + kstep, voffB);
        PG8_WAIT_V(6); PG8_BAR;
    } else {
        PG8_STAGE(PG8_SB(0, 0), cB, voffB); PG8_STAGE(PG8_SA(0, 0), cA, voffA); PG8_STAGE(PG8_SB(0, 1), cB + hstep, voffB); PG8_STAGE(PG8_SA(0, 1), cA + hstep, voffA);
        if (wr == 1) PG8_BAR;
        PG8_WAIT_V(4); PG8_BAR;
        PG8_STAGE(PG8_SB(1, 0), cB + kstep, voffB); PG8_STAGE(PG8_SA(1, 0), cA + kstep, voffA); PG8_STAGE(PG8_SB(1, 1), cB + hstep + kstep, voffB);
        PG8_WAIT_V(6); PG8_BAR;
    }
    for (;;) {
        const bool has_next = S.next(ui + 1, nxt);
        const char* nA = has_next ? (const char*)g.A + (size_t)nxt.pm * tstep : cA; const char* nB = has_next ? (const char*)g.Bt + (size_t)nxt.pn * tstep : cB;
        for (int t = 0; t < nt; t += 2) {
            const bool last = (t == nt - 2);
            const char* a1 = cA + (size_t)(t + 1) * kstep;
            const char* a2 = last ? nA : cA + (size_t)(t + 2) * kstep; const char* b2 = last ? nB : cB + (size_t)(t + 2) * kstep;
            const char* a3 = a2 + kstep; const char* b3 = b2 + kstep;
            if (last && has_next) S.a_ready(nxt);
            if constexpr (SP2) {
            PG8_LDB(B0, 0, 0); PG8_LDB(B1, 0, 1); PG8_SCHED; PG8_LDA(At, 0, 0); PG8_STAGE(PG8_SA(1, 1), a1 + hstep, voffA);
            PG8_WAIT_V(8); PG8_WAIT_L(0); PG8_BAR; PG8_MMA(0, 0, At, B0); PG8_MMA(0, 1, At, B1); PG8_BAR; PG8_SCHED;
            PG8_LDA(At, 0, 1); PG8_STAGE(PG8_SB(0, 0), b2, voffB); PG8_STAGE(PG8_SB(0, 1), b2 + hstep, voffB); PG8_STAGE(PG8_SA(0, 0), a2, voffA);
            PG8_WAIT_V(8); PG8_WAIT_L(0); PG8_BAR; PG8_MMA(1, 0, At, B0); PG8_MMA(1, 1, At, B1); PG8_BAR; PG8_SCHED;
            PG8_LDB(B0, 1, 0); PG8_LDB(B1, 1, 1); PG8_SCHED; PG8_LDA(At, 1, 0); PG8_STAGE(PG8_SA(0, 1), a2 + hstep, voffA);
            PG8_WAIT_V(8); PG8_WAIT_L(0); PG8_BAR; PG8_MMA(0, 0, At, B0); PG8_MMA(0, 1, At, B1); PG8_BAR; PG8_SCHED;
            PG8_LDA(At, 1, 1); PG8_STAGE(PG8_SB(1, 0), b3, voffB); PG8_STAGE(PG8_SB(1, 1), b3 + hstep, voffB); PG8_STAGE(PG8_SA(1, 0), a3, voffA);
            PG8_WAIT_V(8); PG8_WAIT_L(0); PG8_BAR; PG8_MMA(1, 0, At, B0); PG8_MMA(1, 1, At, B1); PG8_BAR; PG8_SCHED;
            } else {
            PG8_LDB(B0, 0, 0); PG8_SCHED; PG8_LDA(At, 0, 0); PG8_STAGE(PG8_SA(1, 1), a1 + hstep, voffA);
            PG8_WAIT_L(8); PG8_BAR; PG8_WAIT_L(0); PG8_MMA(0, 0, At, B0); PG8_BAR; PG8_SCHED;
            PG8_LDB(B1, 0, 1); PG8_STAGE(PG8_SB(0, 0), b2, voffB);
            PG8_BAR; PG8_WAIT_L(0); PG8_MMA(0, 1, At, B1); PG8_BAR;
            PG8_LDA(At, 0, 1); PG8_STAGE(PG8_SA(0, 0), a2, voffA);
            PG8_BAR; PG8_WAIT_L(0); PG8_MMA(1, 0, At, B0); PG8_BAR; PG8_SCHED;
            PG8_STAGE(PG8_SB(0, 1), b2 + hstep, voffB);
            PG8_WAIT_V(6); PG8_BAR; PG8_MMA(1, 1, At, B1); PG8_BAR;
            PG8_LDB(B0, 1, 0); PG8_SCHED; PG8_LDA(At, 1, 0); PG8_STAGE(PG8_SA(0, 1), a2 + hstep, voffA);
            PG8_WAIT_L(8); PG8_BAR; PG8_WAIT_L(0); PG8_MMA(0, 0, At, B0); PG8_BAR; PG8_SCHED;
            PG8_LDB(B1, 1, 1); PG8_STAGE(PG8_SB(1, 0), b3, voffB);
            PG8_BAR; PG8_WAIT_L(0); PG8_MMA(0, 1, At, B1); PG8_BAR;
            PG8_LDA(At, 1, 1); PG8_STAGE(PG8_SA(1, 0), a3, voffA);
            PG8_BAR; PG8_WAIT_L(0); PG8_MMA(1, 0, At, B0); PG8_BAR; PG8_SCHED;
            PG8_STAGE(PG8_SB(1, 1), b3 + hstep, voffB);
            PG8_WAIT_V(6); PG8_BAR; PG8_MMA(1, 1, At, B1); PG8_BAR;
            }
        }
        if constexpr (ALIGN_EPI) { if (wr == 0) PG8_BAR; }
        if constexpr (!Epi::AFTER_DRAIN) { E(acc, cur, wr, wc, fr, fq); S.done(cur); }
        if (!has_next) break;
#pragma unroll
        for (int a = 0; a < 2; ++a)
#pragma unroll
            for (int b = 0; b < 2; ++b)
#pragma unroll
                for (int m = 0; m < 4; ++m)
#pragma unroll
                    for (int n = 0; n < 2; ++n) acc[a][b][m][n] = (f32x4){0.f, 0.f, 0.f, 0.f};
        cur = nxt; cA = nA; cB = nB; ++ui;
        if constexpr (ALIGN_EPI) { if (wr == 1) PG8_BAR; }
    }
    PG8_WAIT_V(0);
    if constexpr (!ALIGN_EPI) { if (wr == 0) PG8_BAR; }
    PG8_BAR;
    if constexpr (Epi::AFTER_DRAIN) { E.fused(acc, cur, wr, wc, fr, fq, lds, wid, lane); S.done(cur); }
#undef PG8_SA
#undef PG8_SB
#undef PG8_STAGE
#undef PG8_LDA
#undef PG8_LDB
#undef PG8_MMA
#undef PG8_WAIT_V
#undef PG8_WAIT_L
#undef PG8_BAR
#undef PG8_SCHED
}
}
#ifndef PG8_SP2
#define PG8_SP2 true
#endif
#ifndef PG8_ALIGN
#define PG8_ALIGN true
#endif
#include <hip/hip_bf16.h>
#include <cmath>
namespace attn_body {
using bf16=__hip_bfloat16;
using bf16x8=__attribute__((ext_vector_type(8)))short;
using s16x4=__attribute__((ext_vector_type(4)))short;
using f32x16=__attribute__((ext_vector_type(16)))float;
using u32x4=__attribute__((ext_vector_type(4)))unsigned;
constexpr int BATCH=2,NHEAD=16,SEQ=8192,D=64,DM=512;
constexpr int NW=8,QBLK=32,QB=QBLK*NW,KVBLK=64,NQB=SEQ/QB;
constexpr int ATTN_PITCH=DM, ATTN_UNIT_ROWS=QB;
__device__ __forceinline__ int crow(int r,int hi){return (r&3)+8*(r>>2)+4*hi;}
#define SBAR() __builtin_amdgcn_sched_barrier(0)
__device__ __forceinline__ void cmask(f32x16&p0,f32x16&p1,int jb,int qrel,int hi){
  const float NEG=-INFINITY; int kb=64*jb+4*hi;
  #pragma unroll
  for(int r=0;r<16;++r){int kv=kb+(r&3)+8*(r>>2); if(kv>qrel)p0[r]=NEG; if(kv+32>qrel)p1[r]=NEG;}
}

constexpr int NSLOT=3, SLOTB=8192;
constexpr int LDS_K=0, LDS_V=NSLOT*SLOTB, LDS_WS=2*NSLOT*SLOTB, LDS_OST=LDS_WS+NW*64*4, LDS_BYTES=LDS_OST+NW*4096;
constexpr float C2=0.125f*1.4426950408889634f;
__device__ __forceinline__ void glds16(const void*gsrc,unsigned lds_dst){unsigned keep;
  asm volatile("s_mov_b32 %0, m0\n\ts_mov_b32 m0, %2\n\ts_nop 0\n\tglobal_load_lds_dwordx4 %1, off\n\ts_mov_b32 m0, %0":"=&s"(keep):"v"(gsrc),"s"(lds_dst):"memory");}
__device__ __forceinline__ float max3f(float a,float b,float c){float r;asm("v_max3_f32 %0, %1, %2, %3":"=v"(r):"v"(a),"v"(b),"v"(c));return r;}
__device__ __forceinline__ float max2f(float a,float b){float r;asm("v_max_f32_e32 %0, %1, %2":"=v"(r):"v"(a),"v"(b));return r;}
__device__ __forceinline__ float fadd_s(float a,float b){float r;asm("v_add_f32_e32 %0, %1, %2":"=v"(r):"v"(a),"v"(b));return r;}
__device__ __forceinline__ float fsub_s(float a,float b){float r;asm("v_sub_f32_e32 %0, %1, %2":"=v"(r):"v"(a),"v"(b));return r;}
typedef float f32x2_t __attribute__((ext_vector_type(2))); typedef __bf16 bf16x2_t __attribute__((ext_vector_type(2)));
__device__ __forceinline__ unsigned cvtpk_s(float lo,float hi){f32x2_t v={lo,hi};bf16x2_t b=__builtin_convertvector(v,bf16x2_t);return __builtin_bit_cast(unsigned,b);}
#define WAIT_BAR(N) asm volatile("s_waitcnt vmcnt(" #N ") lgkmcnt(0)\n\ts_barrier":::"memory")

__device__ __forceinline__ void qkt(f32x16&p0,f32x16&p1,const char*Kslot,const bf16x8*qr,const f32x16&negm,int r32,int hi){
  const char*kb=Kslot+hi*1024+r32*16;
  #pragma unroll
  for(int d0=0;d0<4;++d0){
    const bf16x8 b0=*reinterpret_cast<const bf16x8*>(kb+d0*2048);
    const bf16x8 b1=*reinterpret_cast<const bf16x8*>(kb+d0*2048+512);
    if(d0==0){p0=__builtin_amdgcn_mfma_f32_32x32x16_bf16(b0,qr[0],negm,0,0,0);p1=__builtin_amdgcn_mfma_f32_32x32x16_bf16(b1,qr[0],negm,0,0,0);}
    else{p0=__builtin_amdgcn_mfma_f32_32x32x16_bf16(b0,qr[d0],p0,0,0,0);p1=__builtin_amdgcn_mfma_f32_32x32x16_bf16(b1,qr[d0],p1,0,0,0);}}
}
typedef __attribute__((address_space(3))) const char* lds_cptr;
typedef short v4i16_t __attribute__((ext_vector_type(4)));
__device__ __forceinline__ void kload8(bf16x8*kf,lds_cptr kp){
  kf[0]=*(const __attribute__((address_space(3))) bf16x8*)(kp);      kf[1]=*(const __attribute__((address_space(3))) bf16x8*)(kp+512);
  kf[2]=*(const __attribute__((address_space(3))) bf16x8*)(kp+2048); kf[3]=*(const __attribute__((address_space(3))) bf16x8*)(kp+2560);
  kf[4]=*(const __attribute__((address_space(3))) bf16x8*)(kp+4096); kf[5]=*(const __attribute__((address_space(3))) bf16x8*)(kp+4608);
  kf[6]=*(const __attribute__((address_space(3))) bf16x8*)(kp+6144); kf[7]=*(const __attribute__((address_space(3))) bf16x8*)(kp+6656);
}
__device__ __forceinline__ void kload2(bf16x8*kf,lds_cptr kp,int j){ kf[2*j]=*(const __attribute__((address_space(3))) bf16x8*)(kp+j*2048); kf[2*j+1]=*(const __attribute__((address_space(3))) bf16x8*)(kp+j*2048+512); }
__device__ __forceinline__ s16x4 vtr(lds_cptr p){ return __builtin_bit_cast(s16x4,__builtin_amdgcn_ds_read_tr16_b64_v4i16((__attribute__((address_space(3))) v4i16_t*)p)); }
__device__ __forceinline__ float rowmax(const f32x16&p0,const f32x16&p1){
  float a=max3f(p0[0],p0[1],p1[0]),b=max3f(p0[2],p0[3],p1[1]);a=max3f(a,p1[2],p1[3]);
  #pragma unroll
  for(int r=4;r<16;r+=4){a=max3f(a,p0[r],p0[r+1]);b=max3f(b,p0[r+2],p0[r+3]);a=max3f(a,p1[r],p1[r+1]);b=max3f(b,p1[r+2],p1[r+3]);}
  const float m=max2f(a,b);
  auto rr=__builtin_amdgcn_permlane32_swap(__float_as_uint(m),__float_as_uint(m),false,false);
  return max2f(__uint_as_float(rr[0]),__uint_as_float(rr[1]));
}
__device__ __forceinline__ void pv(f32x16*o,int vb,bf16x8 pa0,bf16x8 pa1,bf16x8 pa2,bf16x8 pa3){
  #pragma unroll
  for(int d0=0;d0<2;++d0){s16x4 lo[4],hi[4];
    #pragma unroll
    for(int ks=0;ks<4;++ks){
      asm volatile("ds_read_b64_tr_b16 %0,%1 offset:%c2":"=&v"(lo[ks]):"v"(vb),"i"(d0*4096+ks*1024):"memory");
      asm volatile("ds_read_b64_tr_b16 %0,%1 offset:%c2":"=&v"(hi[ks]):"v"(vb),"i"(d0*4096+ks*1024+512):"memory");}
    asm volatile("s_waitcnt lgkmcnt(0)":::"memory");SBAR();
    #define PK(k) (bf16x8){lo[k][0],lo[k][1],lo[k][2],lo[k][3],hi[k][0],hi[k][1],hi[k][2],hi[k][3]}
    o[d0]=__builtin_amdgcn_mfma_f32_32x32x16_bf16(pa0,PK(0),o[d0],0,0,0);
    o[d0]=__builtin_amdgcn_mfma_f32_32x32x16_bf16(pa1,PK(1),o[d0],0,0,0);
    o[d0]=__builtin_amdgcn_mfma_f32_32x32x16_bf16(pa2,PK(2),o[d0],0,0,0);
    o[d0]=__builtin_amdgcn_mfma_f32_32x32x16_bf16(pa3,PK(3),o[d0],0,0,0);
    #undef PK
  }
}

#ifndef ATTN_STORE16
#define ATTN_STORE16(p,v) (*(u32x4*)(p)=(v))
#endif
template<int THRL> __device__ __forceinline__ void attn_unit(int b,int qcol,int vcol,int qb,const bf16*Q,const bf16*__restrict__ K,const bf16*__restrict__ V,bf16*O,char*shm){
  const int tid=threadIdx.x,lane=tid&63,r32=lane&31,hi=lane>>5; const int wid=__builtin_amdgcn_readfirstlane(tid>>6);
  const long rowbase=(long)b*SEQ; const int q0=qb*QB;
  const bf16*Qw=Q+(rowbase+q0+wid*QBLK)*DM+qcol;
  const bf16*Kh=K+rowbase*DM+qcol,*Vh=V+rowbase*DM+vcol;
  const unsigned lds0=(unsigned)(uintptr_t)shm;
  float*wsf=(float*)(shm+LDS_WS)+wid*64;
  const bf16*ksrc=Kh+(long)lane*DM+wid*8;
  const bf16*vsrc=Vh+(long)(16*(wid&3)+(lane>>2))*DM+(wid>>2)*32+(lane&3)*8;
  const unsigned kdst=lds0+LDS_K+wid*1024, vdst=lds0+LDS_V+wid*1024;
  #define DMA_K(t,slot) glds16(ksrc+(long)(t)*KVBLK*DM,(unsigned)__builtin_amdgcn_readfirstlane(kdst+(slot)))
  #define DMA_V(t,slot) glds16(vsrc+(long)(t)*KVBLK*DM,(unsigned)__builtin_amdgcn_readfirstlane(vdst+(slot)))
  const int vb0=(int)(lds0+LDS_V)+((lane>>4)&1)*32+(lane&3)*8+(4*hi+((lane&15)>>2))*64;
  const char*Kbase=shm+LDS_K; bf16x8 kf[8];
  const lds_cptr shm3=(lds_cptr)shm; const lds_cptr kp0=shm3+LDS_K+hi*1024+r32*16; const lds_cptr vp0=shm3+LDS_V+((lane>>4)&1)*32+(lane&3)*8+(4*hi+((lane&15)>>2))*64;
  const int NT=(q0+QB)/KVBLK;
  DMA_K(0,0);DMA_V(0,0);DMA_K(1,SLOTB);
  bf16x8 qr[4];
  #pragma unroll
  for(int d0=0;d0<4;++d0)qr[d0]=*reinterpret_cast<const bf16x8*>(&Qw[(long)r32*DM+d0*16+hi*8]);
  float mhat=0.f,l_reg=0.f;f32x16 o[2];o[0]=f32x16{};o[1]=f32x16{};f32x16 negm=f32x16{};asm volatile("":"+v"(negm));
  const int qrel=wid*QBLK+r32;
  #define CMASK(P0,P1,t) do{int jb_=(t)-(NT-4); if(jb_>=0)cmask(P0,P1,jb_,qrel,hi);}while(0)
  bool resc=false;
  #define START(P0,P1) do{ const float rm=rowmax(P0,P1); resc=false; \
    { const float dl=rm; mhat=fadd_s(mhat,dl); \
      _Pragma("unroll") for(int r=0;r<16;++r){P0[r]=fsub_s(P0[r],dl);P1[r]=fsub_s(P1[r],dl);} \
      _Pragma("unroll") for(int r=0;r<16;++r)negm[r]=-mhat; asm volatile("":"+v"(negm)); } \
    _Pragma("unroll") for(int r=0;r<16;++r)P0[r]=__builtin_amdgcn_exp2f(P0[r]); }while(0)
  #define RESC() do{ if(resc){ asm volatile("s_waitcnt lgkmcnt(0)":::"memory"); \
      _Pragma("unroll") for(int d_=0;d_<2;++d_) _Pragma("unroll") for(int r=0;r<16;++r)o[d_][r]*=wsf[crow(r,hi)]; } }while(0)
  f32x16 pA0,pA1,pB0,pB1;
  int sl_prev=0,sl_cur=0,sl_next=SLOTB;
  #define ROT() do{sl_prev=sl_cur;sl_cur=sl_next;sl_next=(sl_next==(NSLOT-1)*SLOTB)?0:sl_next+SLOTB;}while(0)
  DMA_K(2,2*SLOTB);
  WAIT_BAR(3);
  qkt(pA0,pA1,Kbase,qr,negm,r32,hi);asm volatile("s_nop 15\n\ts_nop 7":"+v"(pA0),"+v"(pA1));CMASK(pA0,pA1,0);
  START(pA0,pA1);
  _Pragma("unroll") for(int r=0;r<16;++r)pA1[r]=__builtin_amdgcn_exp2f(pA1[r]);
  WAIT_BAR(0);
  DMA_K(3,0);DMA_V(1,SLOTB);
  ROT();
  kload8(kf,kp0+sl_cur);
  WAIT_BAR(2);
  s16x4 vlo[8],vhi[8]; u32x4 pw0,pw1,pw2,pw3;
  #define PKW(P,B) cvtpk_s(P[B],P[B+1])
  #define PAF(k) __builtin_bit_cast(bf16x8,pw##k)
  #define VFR(i) (bf16x8){vlo[i][0],vlo[i][1],vlo[i][2],vlo[i][3],vhi[i][0],vhi[i][1],vhi[i][2],vhi[i][3]}
  #define PIN(x) asm volatile("":"+v"(x))
  #define MX3(a,b,c) __builtin_fmaxf(__builtin_fmaxf((a),(b)),(c))
  #define GAPA(MF,A0,A1,A2,A3,W0,W1,PW) do{ MF; sacc+=A0; sacc+=A1; sacc+=A2; sacc+=A3; PIN(sacc); W0; W1; PIN(PW); SBAR(); }while(0)
  #define EX(v) __builtin_amdgcn_exp2f(v)
  #define GAPB(MF,X,B) do{ MF; X[B]=EX(X[B]); X[B+1]=EX(X[B+1]); X[B+2]=EX(X[B+2]); X[B+3]=EX(X[B+3]); PIN(X); SBAR(); }while(0)
  #define VRD(i) do{ vlo[i]=vtr(vp_+(((i)>>2)*4096+((i)&3)*1024)); vhi[i]=vtr(vp_+(((i)>>2)*4096+((i)&3)*1024+512)); }while(0)
  #define KRD(G,j) do{ if(G){ kload2(kf,kp0+sl_next,j); SBAR(); } }while(0)
  #define STEP(C0,C1,P0,P1,t,GK,GV,GL) do{ SBAR(); \
    const lds_cptr vp_=vp0+sl_prev; \
    VRD(0); SBAR(); float sacc=(P0[0]+P0[1]); \
    GAPA(C0=__builtin_amdgcn_mfma_f32_32x32x16_bf16(kf[0],qr[0],negm,0,0,0), P0[2],P0[3],P0[4],P0[5],     pw0[0]=PKW(P0,0), pw0[1]=PKW(P0,2), pw0); \
    VRD(4); SBAR(); GAPA(C1=__builtin_amdgcn_mfma_f32_32x32x16_bf16(kf[1],qr[0],negm,0,0,0), P0[6],P0[7],P0[8],P0[9],     pw0[2]=PKW(P0,4), pw0[3]=PKW(P0,6), pw0); \
    VRD(1); SBAR(); GAPA(C0=__builtin_amdgcn_mfma_f32_32x32x16_bf16(kf[2],qr[1],C0,0,0,0),   P0[10],P0[11],P0[12],P0[13], pw1[0]=PKW(P0,8), pw1[1]=PKW(P0,10), pw1); \
    VRD(5); SBAR(); GAPA(C1=__builtin_amdgcn_mfma_f32_32x32x16_bf16(kf[3],qr[1],C1,0,0,0),   P0[14],P0[15],P1[0],P1[1],   pw1[2]=PKW(P0,12),pw1[3]=PKW(P0,14), pw1); \
    VRD(2); SBAR(); GAPA(C0=__builtin_amdgcn_mfma_f32_32x32x16_bf16(kf[4],qr[2],C0,0,0,0),   P1[2],P1[3],P1[4],P1[5],     pw2[0]=PKW(P1,0), pw2[1]=PKW(P1,2), pw2); \
    VRD(6); SBAR(); GAPA(C1=__builtin_amdgcn_mfma_f32_32x32x16_bf16(kf[5],qr[2],C1,0,0,0),   P1[6],P1[7],P1[8],P1[9],     pw2[2]=PKW(P1,4), pw2[3]=PKW(P1,6), pw2); \
    VRD(3); SBAR(); GAPA(C0=__builtin_amdgcn_mfma_f32_32x32x16_bf16(kf[6],qr[3],C0,0,0,0),   P1[10],P1[11],P1[12],P1[13], pw3[0]=PKW(P1,8), pw3[1]=PKW(P1,10), pw3); \
    VRD(7); SBAR(); GAPA(C1=__builtin_amdgcn_mfma_f32_32x32x16_bf16(kf[7],qr[3],C1,0,0,0),   P1[14],P1[15],0.f,0.f,       pw3[2]=PKW(P1,12),pw3[3]=PKW(P1,14), pw3); \
    l_reg+=sacc; \
    if(GK){DMA_K((t)+3,sl_cur);} if(GV){DMA_V((t)+1,sl_next);} \
    CMASK(C0,C1,t); \
    { float a=MX3(C0[0],C0[1],C1[0]),b=MX3(C0[2],C0[3],C1[1]); a=MX3(a,C1[2],C1[3]); \
      _Pragma("unroll") for(int r=4;r<16;r+=4){a=MX3(a,C0[r],C0[r+1]);b=MX3(b,C0[r+2],C0[r+3]);a=MX3(a,C1[r],C1[r+1]);b=MX3(b,C1[r+2],C1[r+3]);} \
      float rm=__builtin_fmaxf(a,b); { auto rr=__builtin_amdgcn_permlane32_swap(__float_as_uint(rm),__float_as_uint(rm),false,false); rm=__builtin_fmaxf(__uint_as_float(rr[0]),__uint_as_float(rr[1])); } \
      resc=false; \
      if(__builtin_expect(__any(rm>(float)THRL),0)){ const float dl=__builtin_fmaxf(rm,0.f); mhat+=dl; \
        _Pragma("unroll") for(int r=0;r<16;++r){C0[r]-=dl;C1[r]-=dl;} \
        _Pragma("unroll") for(int r=0;r<16;++r)negm[r]=-mhat; asm volatile("":"+v"(negm)); \
        const float f=__builtin_amdgcn_exp2f(-dl); l_reg*=f; if(hi==0)wsf[r32]=f; resc=true; } } \
    SBAR(); \
    GAPB(o[0]=__builtin_amdgcn_mfma_f32_32x32x16_bf16(PAF(0),VFR(0),o[0],0,0,0), C0,0); \
    GAPB(o[1]=__builtin_amdgcn_mfma_f32_32x32x16_bf16(PAF(0),VFR(4),o[1],0,0,0), C0,4); \
    KRD(GL,0); GAPB(o[0]=__builtin_amdgcn_mfma_f32_32x32x16_bf16(PAF(1),VFR(1),o[0],0,0,0), C0,8); \
    KRD(GL,1); GAPB(o[1]=__builtin_amdgcn_mfma_f32_32x32x16_bf16(PAF(1),VFR(5),o[1],0,0,0), C0,12); \
    KRD(GL,2); GAPB(o[0]=__builtin_amdgcn_mfma_f32_32x32x16_bf16(PAF(2),VFR(2),o[0],0,0,0), C1,0); \
    KRD(GL,3); GAPB(o[1]=__builtin_amdgcn_mfma_f32_32x32x16_bf16(PAF(2),VFR(6),o[1],0,0,0), C1,4); \
    GAPB(o[0]=__builtin_amdgcn_mfma_f32_32x32x16_bf16(PAF(3),VFR(3),o[0],0,0,0), C1,8); \
    GAPB(o[1]=__builtin_amdgcn_mfma_f32_32x32x16_bf16(PAF(3),VFR(7),o[1],0,0,0), C1,12); \
    }while(0)
  int t=1;
  #undef CMASK
  #define CMASK(P0,P1,t) do{}while(0)
  for(;t+5<NT;t+=2){
    STEP(pB0,pB1,pA0,pA1,t,true,true,true);     WAIT_BAR(2); RESC(); ROT();
    STEP(pA0,pA1,pB0,pB1,t+1,true,true,true);   WAIT_BAR(2); RESC(); ROT();
  }
  #undef CMASK
  #define CMASK(P0,P1,t) do{int jb_=(t)-(NT-4); if(jb_>=0)cmask(P0,P1,jb_,qrel,hi);}while(0)
  #define ENDW(tt) do{ if((tt)+3<NT){WAIT_BAR(2);} else if((tt)+2<NT){WAIT_BAR(1);} else {WAIT_BAR(0);} }while(0)
  for(;t+1<NT;t+=2){
    STEP(pB0,pB1,pA0,pA1,t,(t+3<NT),(t+1<NT),(t+1<NT));       ENDW(t);   RESC(); ROT();
    STEP(pA0,pA1,pB0,pB1,t+1,(t+4<NT),(t+2<NT),(t+2<NT));     ENDW(t+1); RESC(); ROT();
  }
  STEP(pB0,pB1,pA0,pA1,NT-1,false,false,false); RESC();
  { float sacc=pB0[0]+pB0[1]; _Pragma("unroll") for(int r=2;r<16;++r)sacc+=pB0[r]; _Pragma("unroll") for(int r=0;r<16;++r)sacc+=pB1[r]; l_reg+=sacc;
    pw0=(u32x4){PKW(pB0,0),PKW(pB0,2),PKW(pB0,4),PKW(pB0,6)};pw1=(u32x4){PKW(pB0,8),PKW(pB0,10),PKW(pB0,12),PKW(pB0,14)};pw2=(u32x4){PKW(pB1,0),PKW(pB1,2),PKW(pB1,4),PKW(pB1,6)};pw3=(u32x4){PKW(pB1,8),PKW(pB1,10),PKW(pB1,12),PKW(pB1,14)};
    SBAR(); pv(o,vb0+sl_cur,PAF(0),PAF(1),PAF(2),PAF(3)); }
  #undef PKW
  #undef PAF
  #undef VFR
  #undef PIN
  #undef MX3
  #undef GAPA
  #undef GAPB
  #undef EX
  #undef VRD
  #undef KRD
  #undef STEP
  #undef ENDW
  {auto rr=__builtin_amdgcn_permlane32_swap(__float_as_uint(l_reg),__float_as_uint(l_reg),false,false);l_reg=__uint_as_float(rr[0])+__uint_as_float(rr[1]);}
  if(hi==0)wsf[32+r32]=l_reg;asm volatile("s_waitcnt lgkmcnt(0)":::"memory");
  float rli[16];
  #pragma unroll
  for(int r=0;r<16;++r)rli[r]=__builtin_amdgcn_rcpf(wsf[32+crow(r,hi)]);
  bf16*Ow=O+(rowbase+q0+wid*QBLK)*DM+vcol;
  { bf16*stg=(bf16*)(shm+LDS_OST)+wid*2048;
    #pragma unroll
    for(int r=0;r<16;++r){const int orow=crow(r,hi);
      #pragma unroll
      for(int d0=0;d0<2;++d0)stg[orow*64+d0*32+r32]=__float2bfloat16(o[d0][r]*rli[r]);}
    asm volatile("s_waitcnt lgkmcnt(0)":::"memory");
    #pragma unroll
    for(int i=0;i<4;++i){const int row=i*8+(lane>>3),ch=lane&7; const u32x4 v=*(const u32x4*)(stg+row*64+ch*8); ATTN_STORE16(Ow+(long)row*DM+ch*8,v);} }
  asm volatile("s_waitcnt lgkmcnt(0)\n\ts_barrier":::"memory");
  #undef DMA_K
  #undef DMA_V
  #undef CMASK
  #undef START
  #undef RESC
  #undef ROT
}
constexpr int ATTN_LDS_BYTES=LDS_BYTES;
struct AttnTensors { const bf16* Q; const bf16* K; const bf16* V; bf16* O1; bf16* O2; };
struct AttnUnit { int bh; int qb; };
struct StaticOrder {
  int vcu;
  __device__ __forceinline__ explicit StaticOrder(int grid,int block):vcu((block%8)*(grid/8)+block/8){}
  __device__ __forceinline__ bool next(int i,AttnUnit&u)const{ if(i>=4)return false; const int s=vcu&7; u.bh=vcu>>3; u.qb=(i==0)?s:(i==1)?15-s:(i==2)?16+s:31-s; return true; }
  __device__ __forceinline__ void a_ready(const AttnUnit&)const{}
  __device__ __forceinline__ void done(const AttnUnit&)const{}
};
template<class Sched,int THRL=8> __device__ __forceinline__ void attn_phase(char*lds,const AttnTensors&T,const Sched&S){
  AttnUnit u;
  for(int i=0;S.next(i,u);++i){ S.a_ready(u); const int ph=u.bh%NHEAD,hh=ph>>2,mp=(ph>>1)&1,vh=ph&1;
    attn_unit<THRL>(u.bh/NHEAD,hh*128+mp*64,hh*128+vh*64,u.qb,T.Q,T.K,T.V,mp?T.O2:T.O1,lds); S.done(u); }
}
#undef SBAR
#undef WAIT_BAR
}
#define GAS __attribute__((address_space(1)))
#define LAS __attribute__((address_space(3)))
typedef unsigned short bf16;
typedef unsigned v4u __attribute__((ext_vector_type(4)));
typedef float f32x4 __attribute__((ext_vector_type(4)));
typedef short bf16x8 __attribute__((ext_vector_type(8)));
typedef GAS unsigned gu32;
typedef GAS unsigned long long gu64;
#define RLX_AGENT __ATOMIC_RELAXED, __HIP_MEMORY_SCOPE_AGENT
#define LDS_WAIT() asm volatile("s_waitcnt lgkmcnt(0)" ::: "memory")
#define VM_WAIT() asm volatile("s_waitcnt vmcnt(0)" ::: "memory")
__device__ __forceinline__ unsigned long long rt() { return __builtin_amdgcn_s_memrealtime(); }
__device__ __forceinline__ unsigned f2bf(float f) { unsigned u = __builtin_bit_cast(unsigned, f); return (u + 0x7fffu + ((u >> 16) & 1u)) >> 16; }
__device__ __forceinline__ unsigned pk2(float lo, float hi) { return f2bf(lo) | (f2bf(hi) << 16); }
#define XB_TMO      128
#define XB_XCNT(j)  (256  + 64 * (j))
#define XB_XSUB(j)  (1280 + 64 * (j))
#define XB_XGEN(j)  (2304 + 64 * (j))
#define XB_TOP      3328
#define XB_TOPGEN   3392
#define XCD_BAR_WORDS 3456
#define XB_SPIN_CAP (1u << 18)

__device__ __forceinline__ unsigned xb_ld(unsigned* p)              { return __hip_atomic_load(p, __ATOMIC_RELAXED, __HIP_MEMORY_SCOPE_AGENT); }
__device__ __forceinline__ unsigned xb_add(unsigned* p, unsigned v) { return __hip_atomic_fetch_add(p, v, __ATOMIC_RELAXED, __HIP_MEMORY_SCOPE_AGENT); }
__device__ __forceinline__ unsigned xb_xcc_id() { return (unsigned)__builtin_amdgcn_s_getreg((3 << 11) | 20) & 0xFu; }
#define XB_SPIN(cond, bar) do { unsigned _sp = 0; while (cond) { __builtin_amdgcn_s_sleep(1); \
    if ((++_sp & 255u) == 0u) { if (xb_ld(&(bar)[XB_TMO])) break; if (_sp > XB_SPIN_CAP) { atomicAdd(&(bar)[XB_TMO], 1u); break; } } } } while (0)

struct XcdBarrier {
    unsigned* bar; unsigned x;
    volatile LAS unsigned* st;
};

__device__ __forceinline__ XcdBarrier xcd_barrier_post(unsigned* bar, volatile LAS unsigned* st) {
    XcdBarrier b; b.bar = bar; b.x = xb_xcc_id(); b.st = st;
    if (threadIdx.x == 0) (void)xb_add(&bar[XB_XCNT(b.x)], 1u);
    return b;
}
__device__ __forceinline__ void xcd_barrier_complete(unsigned* bar, unsigned x, unsigned& nloc, unsigned& nx) {
    const unsigned G = gridDim.x * gridDim.y * gridDim.z;
    unsigned sum, cnt, mine, sp = 0u;
    for (;;) {
        sum = 0u; cnt = 0u; mine = 0u;
#pragma unroll
        for (unsigned j = 0; j < 16; ++j) { const unsigned c = xb_ld(&bar[XB_XCNT(j)]); sum += c; cnt += (c > 0u) ? 1u : 0u; mine = (j == x) ? c : mine; }
        if (sum == G) break;
        __builtin_amdgcn_s_sleep(1);
        if ((++sp & 255u) == 0u) { if (xb_ld(&bar[XB_TMO])) break; if (sp > XB_SPIN_CAP) { atomicAdd(&bar[XB_TMO], 1u); break; } }
    }
    nloc = mine > 0u ? mine : 1u; nx = cnt > 0u ? cnt : 1u;
}

__device__ __forceinline__ void xcd_barrier(const XcdBarrier& b) {
    asm volatile("s_waitcnt vmcnt(0)" ::: "memory");
    __syncthreads();
    if (threadIdx.x == 0) {
        unsigned* bar = b.bar;
        __builtin_amdgcn_s_waitcnt(0);
        unsigned nloc = b.st[0], nx = b.st[1];
        if (nloc == 0u) { xcd_barrier_complete(bar, b.x, nloc, nx); b.st[0] = nloc; b.st[1] = nx; }
        const unsigned old = xb_add(&bar[XB_XSUB(b.x)], 1u);
        const unsigned gen = old / nloc;
        if (old + 1u == (gen + 1u) * nloc) {
            __builtin_amdgcn_fence(__ATOMIC_RELEASE, "agent");
            asm volatile("s_waitcnt vmcnt(0)" ::: "memory");
            const unsigned og = xb_add(&bar[XB_TOP], 1u);
            const unsigned tg = og / nx;
            if (og + 1u == (tg + 1u) * nx) xb_add(&bar[XB_TOPGEN], 1u);
            else XB_SPIN(xb_ld(&bar[XB_TOPGEN]) == tg, bar);
            __builtin_amdgcn_fence(__ATOMIC_ACQUIRE, "agent");
            xb_add(&bar[XB_XGEN(b.x)], 1u);
            asm volatile("s_waitcnt vmcnt(0)" ::: "memory");
        } else {
            XB_SPIN(xb_ld(&bar[XB_XGEN(b.x)]) == gen, bar);
            __builtin_amdgcn_fence(__ATOMIC_ACQUIRE, "agent");
            asm volatile("s_waitcnt vmcnt(0)" ::: "memory");
        }
    }
    __syncthreads();
}
constexpr size_t MiB = 1u << 20;
constexpr size_t WS_CTL = 0, CTL_ZERO_BYTES = 64 * 1024;
constexpr size_t WS_WIN = 2 * MiB;
constexpr size_t WS_WPW = 10 * MiB;
constexpr size_t WS_WOUT = 11 * MiB;
constexpr size_t WS_RSS = 14 * MiB;
constexpr size_t WS_XN = 16 * MiB;
constexpr size_t WS_Q = 52 * MiB, WS_K = 70 * MiB, WS_V = 88 * MiB, WS_GA = 106 * MiB, WS_GC = 124 * MiB;
constexpr size_t WS_U = 142 * MiB;
constexpr size_t WS_C = 178 * MiB;
constexpr size_t WS_O1 = 196 * MiB, WS_O2 = 212 * MiB;
constexpr size_t WS_M = 228 * MiB;
constexpr size_t WS_END = 264 * MiB;
static_assert(WS_XN + (size_t)MT * 1024 * 2 <= WS_Q && WS_Q + (size_t)MT * 512 * 2 <= WS_K && WS_U + (size_t)MT * 512 * 4 <= WS_C && WS_C + (size_t)MT * 512 * 2 <= WS_O1 && WS_M + (size_t)MT * 1024 * 2 <= WS_END && WS_RSS + (size_t)MT * 64 <= WS_XN, "d_ws map");
constexpr int CW_BAR = 1024;
constexpr int NWAVES = 8;
constexpr int RING_OFF = 0, RING_BYTES = 131072;
constexpr int LDSCTL_OFF = RING_BYTES, MISC_OFF = LDSCTL_OFF + 320;
constexpr int LDS_BYTES = 147456;

struct Frame {
    LAS unsigned char* lds;
    volatile LAS unsigned* MISC;
    gu32* ctl;
    int tid, lane, wave;
    int vcu, G;
};
struct Args { const float* in[21]; float* out; unsigned char* ws; };
#define WSP(T, off) ((T*)(A.ws + (off)))
__device__ __forceinline__ float wave_sum(float v) {
#pragma unroll
    for (int o = 1; o < 64; o <<= 1) v += __shfl_xor(v, o);
    return v;
}
__device__ __forceinline__ void p0_transpose_item(const float* W, int K, int N, bf16* WT, int k0, int n0, int dst0, LAS float* scr, int lane) {
#pragma unroll 8
    for (int i = 0; i < 32; ++i) { const int kk = 2 * i + (lane >> 5); scr[kk * 33 + (lane & 31)] = W[(size_t)(k0 + kk) * N + n0 + (lane & 31)]; }
    LDS_WAIT(); asm volatile("" ::: "memory");
    const int c = lane & 7;
#pragma unroll
    for (int j = 0; j < 4; ++j) { const int n = (lane >> 3) + 8 * j; const LAS float* s = scr + (8 * c) * 33 + n;
        v4u o; o.x = pk2(s[0 * 33], s[1 * 33]); o.y = pk2(s[2 * 33], s[3 * 33]); o.z = pk2(s[4 * 33], s[5 * 33]); o.w = pk2(s[6 * 33], s[7 * 33]);
        *(GAS v4u*)(WT + (size_t)(dst0 + n) * K + k0 + 8 * c) = o; }
    LDS_WAIT(); asm volatile("" ::: "memory");
}
__device__ __forceinline__ int win_dst_row(int n0) {
    if (n0 < 2048 || n0 >= 3072) return n0;
    int j = n0 - 2048; const int isb = j >= 512; if (isb) j -= 512;
    return 2048 + 256 * (j >> 7) + 128 * isb + (j & 127);
}
__device__ __forceinline__ void rms_row_to_bf16(const float* xrow, const f32x4 (&gv)[4], bf16* orow, int lane) {
    const GAS f32x4* xr = (const GAS f32x4*)xrow + lane;
    f32x4 v[4]; float s = 0.f;
#pragma unroll
    for (int j = 0; j < 4; ++j) { v[j] = xr[64 * j]; s += (v[j].x * v[j].x + v[j].y * v[j].y) + (v[j].z * v[j].z + v[j].w * v[j].w); }
    const float rs = 1.0f / sqrtf(wave_sum(s) * (1.f / D_MODEL) + EPS);
    GAS unsigned long long* o8 = (GAS unsigned long long*)orow + lane;
#pragma unroll
    for (int j = 0; j < 4; ++j) o8[64 * j] = (unsigned long long)pk2(v[j].x * rs * gv[j].x, v[j].y * rs * gv[j].y) | ((unsigned long long)pk2(v[j].z * rs * gv[j].z, v[j].w * rs * gv[j].w) << 32);
}
__device__ __forceinline__ void p0_prologue(Frame& F, const Args& A) {
    const float *w_in = A.in[7], *w_pw2 = A.in[17], *w_out = A.in[19], *xp = A.in[0], *xs = A.in[1]; bf16 *Win_t = WSP(bf16, WS_WIN), *Wpw_t = WSP(bf16, WS_WPW), *Wout_t = WSP(bf16, WS_WOUT), *XN = WSP(bf16, WS_XN);
    LAS float* scr = (LAS float*)(F.lds + RING_OFF + F.wave * 16384);
    const int gw = F.vcu * NWAVES + F.wave, NGW = F.G * NWAVES;
    constexpr int I_IN = (1024 / 64) * (D_IN / 32), I_PW = (512 / 64) * (512 / 32), I_OUT = (1024 / 64) * (1024 / 32);
    for (int it = gw; it < I_IN + I_PW + I_OUT; it += NGW) {
        int r = it;
        if (r < I_IN) { const int nblk = D_IN / 32, kb = r / nblk, nb = r % nblk; p0_transpose_item(w_in, 1024, D_IN, Win_t, 64 * kb, 32 * nb, win_dst_row(32 * nb), scr, F.lane); continue; } r -= I_IN;
        if (r < I_PW) { const int kb = r / 16, nb = r % 16; p0_transpose_item(w_pw2, 512, 512, Wpw_t, 64 * kb, 32 * nb, 32 * nb, scr, F.lane); continue; } r -= I_PW;
        { const int kb = r / 32, nb = r % 32; p0_transpose_item(w_out, 1024, 1024, Wout_t, 64 * kb, 32 * nb, 32 * nb, scr, F.lane); }
    }
    f32x4 gv[4];
#pragma unroll
    for (int j = 0; j < 4; ++j) gv[j] = *((const f32x4*)A.in[6] + F.lane + 64 * j);
    for (int m = gw; m < MT; m += NGW) rms_row_to_bf16(m < MP ? xp + (size_t)m * D_MODEL : xs + (size_t)(m - MP) * D_MODEL, gv, XN + (size_t)m * D_MODEL, F.lane);
}
__device__ __forceinline__ float compute_lam(Frame& F, const Args& A) {
    const float a = wave_sum(A.in[8][F.lane] * A.in[9][F.lane]), b = wave_sum(A.in[10][F.lane] * A.in[11][F.lane]);
    return __builtin_bit_cast(float, __builtin_amdgcn_readfirstlane(__builtin_bit_cast(int, expf(a) - expf(b) + 0.2f)));
}
__device__ __forceinline__ void conv_phase(Frame& F, const Args& A) {
    int tid_ = threadIdx.x; asm volatile("" : "+v"(tid_)); const int ch = tid_, cwave = __builtin_amdgcn_readfirstlane(tid_ >> 6), clane = tid_ & 63; const float *state = A.in[4], *U = WSP(float, WS_U); float* out = A.out; bf16* Cb = WSP(bf16, WS_C);
    float w[CONV_W];
#pragma unroll
    for (int j = 0; j < CONV_W; ++j) w[j] = A.in[13][j * 512 + ch];
    const float cb = A.in[14][ch], lg = A.in[15][ch], lb = A.in[16][ch];
    LAS float* red = (LAS float*)(F.lds + RING_OFF);
    int par = 0;
    for (int blk = F.vcu; blk < MP / 8 + DEC_B; blk += F.G, par ^= 1) {
        const bool smp = blk >= MP / 8;
        int t0, rowbase; const float* hist = state;
        if (!smp) { const int b = blk >> 10; t0 = (blk & 1023) * 8; rowbase = b * SEQ; }
        else { const int b = blk - MP / 8; t0 = 0; rowbase = MP + b * 8; hist = state + (size_t)b * HIST * 512; }
        const float* up = U + (size_t)rowbase * 512 + ch;
        float a[8];
#pragma unroll
        for (int r = 0; r < 8; ++r) a[r] = cb;
#pragma unroll
        for (int s = 0; s < 38; ++s) {
            const int t = t0 - HIST + s;
            float uv;
            if (t >= 0) uv = up[(size_t)t * 512]; else uv = smp ? hist[s * 512 + ch] : 0.f;
#pragma unroll
            for (int r = 0; r < 8; ++r) { const int j = s - r; if (j >= 0 && j < CONV_W) a[r] = fmaf(w[j], uv, a[r]); }
        }
#pragma unroll
        for (int r = 0; r < 8; ++r) { const float s1 = wave_sum(a[r]), s2 = wave_sum(a[r] * a[r]);
            if (clane == 0) { red[((par * 8 + r) * 8 + cwave) * 2] = s1; red[((par * 8 + r) * 8 + cwave) * 2 + 1] = s2; } }
        __syncthreads();
#pragma unroll
        for (int r = 0; r < 8; ++r) { float s1 = 0.f, s2 = 0.f;
#pragma unroll
            for (int q = 0; q < 4; ++q) { const f32x4 p = *(const LAS f32x4*)(red + ((par * 8 + r) * 8) * 2 + 4 * q); s1 += p.x + p.z; s2 += p.y + p.w; }
            const float mean = s1 * (1.f / 512.f), var = fmaxf(s2 * (1.f / 512.f) - mean * mean, 0.f), rstd = 1.0f / sqrtf(var + EPS);
            const float y = (a[r] - mean) * rstd * lg + lb, z = y / (1.0f + __expf(-y));
            Cb[(size_t)(rowbase + t0 + r) * 512 + ch] = (bf16)f2bf(z); }
    }
    const int gt = F.vcu * 512 + tid_, GT = F.G * 512;
    for (int i = gt; i < NBATCH * HIST * 512; i += GT) { const int b = i / (HIST * 512), rem = i - b * (HIST * 512), r = rem >> 9, c = rem & 511;
        out[OFF_CP + i] = U[(size_t)(b * SEQ + SEQ - HIST + r) * 512 + c]; }
    for (int i = gt; i < DEC_B * HIST * 512; i += GT) { const int b = i / (HIST * 512), rem = i - b * (HIST * 512), r = rem >> 9, c = rem & 511;
        out[OFF_CS + i] = r < HIST - DEC_S ? state[(size_t)(b * HIST + r + DEC_S) * 512 + c] : U[(size_t)(MP + b * DEC_S + r - (HIST - DEC_S)) * 512 + c]; }
}
typedef float f32x4v __attribute__((ext_vector_type(4))); typedef float f32x2w __attribute__((ext_vector_type(2)));
constexpr float DEC_THR = 8.0f;
__device__ __forceinline__ void decode_phase(Frame& F, const Args& A) {
    const float lam = compute_lam(F, A);
    const float *ck = A.in[2], *cv = A.in[3], *subln = A.in[12]; const int* pt = (const int*)A.in[5]; const float* outf = A.out; const bf16 *Qb = WSP(bf16, WS_Q), *GAb = WSP(bf16, WS_GA); bf16* Mb = WSP(bf16, WS_M);
    int tid_ = threadIdx.x; asm volatile("" : "+v"(tid_)); const int lane = tid_ & 63, wave = __builtin_amdgcn_readfirstlane(tid_ >> 6), c16 = lane & 15, g = lane >> 4;
    LAS float* Om = (LAS float*)(F.lds + RING_OFF);
    LAS float* ML = (LAS float*)(F.lds + RING_OFF + 65536);
    for (int item = F.vcu; item < DEC_B * 4; item += F.G) {
        const int b = item >> 2, h = item & 3;
        bf16x8 qf[4];
        { const int qi = c16 & 7, mp = c16 >> 3; const bf16* qrow = Qb + (size_t)(MP + b * DEC_S + qi) * 512 + h * 128 + mp * 64 + 4 * g;
            typedef unsigned u32x2 __attribute__((ext_vector_type(2)));
            const u32x2 a0 = *(const u32x2*)(qrow), a1 = *(const u32x2*)(qrow + 16), b0 = *(const u32x2*)(qrow + 32), b1 = *(const u32x2*)(qrow + 48);
            const v4u fa = {a0.x, a0.y, a1.x, a1.y}, fb = {b0.x, b0.y, b1.x, b1.y}, z = {0u, 0u, 0u, 0u};
            qf[0] = __builtin_bit_cast(bf16x8, mp ? z : fa); qf[1] = __builtin_bit_cast(bf16x8, mp ? z : fb);
            qf[2] = __builtin_bit_cast(bf16x8, mp ? fa : z); qf[3] = __builtin_bit_cast(bf16x8, mp ? fb : z); }
        const int ph0 = __builtin_amdgcn_readfirstlane(pt[b * NPAGES + 2 * wave]), ph1 = __builtin_amdgcn_readfirstlane(pt[b * NPAGES + 2 * wave + 1]);
        f32x4v acc[2][4];
#pragma unroll
        for (int jj = 0; jj < 2; ++jj)
#pragma unroll
            for (int rr = 0; rr < 4; ++rr) acc[jj][rr] = (f32x4v){0.f, 0.f, 0.f, 0.f};
        float mref = -INFINITY, lsum = 0.f;
        f32x4v Kn[8], Vn[8];
#define DEC_ISSUE(tt_) do { const int pg_ = (tt_) < 8 ? ph0 : ph1; const size_t tb_ = ((size_t)pg_ * 128 + ((tt_) & 7) * 16) * 512 + h * 128; \
        const float* kp_ = ck + tb_ + (size_t)c16 * 512 + 4 * g; const float* vp_ = cv + tb_ + (size_t)(4 * g) * 512 + 4 * c16; \
        _Pragma("unroll") for (int j_ = 0; j_ < 8; ++j_) Kn[j_] = __builtin_nontemporal_load((const f32x4v*)(kp_ + 16 * j_)); \
        _Pragma("unroll") for (int r_ = 0; r_ < 4; ++r_) { Vn[2 * r_] = __builtin_nontemporal_load((const f32x4v*)(vp_ + r_ * 512)); Vn[2 * r_ + 1] = __builtin_nontemporal_load((const f32x4v*)(vp_ + r_ * 512 + 64)); } } while (0)
#define DEC_TILE(MASKED) do { \
        bf16x8 ka_[4]; \
        _Pragma("unroll") for (int kk_ = 0; kk_ < 4; ++kk_) { const v4u w_ = {pg8::cvt_pk_bf16(Kc[2 * kk_][0], Kc[2 * kk_][1]), pg8::cvt_pk_bf16(Kc[2 * kk_][2], Kc[2 * kk_][3]), pg8::cvt_pk_bf16(Kc[2 * kk_ + 1][0], Kc[2 * kk_ + 1][1]), pg8::cvt_pk_bf16(Kc[2 * kk_ + 1][2], Kc[2 * kk_ + 1][3])}; ka_[kk_] = __builtin_bit_cast(bf16x8, w_); } \
        f32x4v s_ = {0.f, 0.f, 0.f, 0.f}; \
        _Pragma("unroll") for (int kk_ = 0; kk_ < 4; ++kk_) s_ = __builtin_amdgcn_mfma_f32_16x16x32_bf16(ka_[kk_], qf[kk_], s_, 0, 0, 0); \
        if (MASKED) { const int qi_ = c16 & 7; _Pragma("unroll") for (int r_ = 0; r_ < 4; ++r_) if (4 * g + r_ > qi_) s_[r_] = -INFINITY; } \
        float tm_ = fmaxf(fmaxf(s_[0], s_[1]), fmaxf(s_[2], s_[3])); tm_ = fmaxf(tm_, __shfl_xor(tm_, 16)); tm_ = fmaxf(tm_, __shfl_xor(tm_, 32)); \
        if (__any(tm_ > mref + DEC_THR)) { const float mn_ = fmaxf(mref, tm_), al_ = __builtin_amdgcn_exp2f(mref - mn_); mref = mn_; lsum *= al_; \
            _Pragma("unroll") for (int i_ = 0; i_ < 4; ++i_) { const float ai_ = __shfl(al_, 4 * g + i_); \
                _Pragma("unroll") for (int jj_ = 0; jj_ < 2; ++jj_) _Pragma("unroll") for (int rr_ = 0; rr_ < 4; ++rr_) acc[jj_][rr_][i_] *= ai_; } } \
        float p_[4]; \
        _Pragma("unroll") for (int r_ = 0; r_ < 4; ++r_) { p_[r_] = __builtin_amdgcn_exp2f(s_[r_] - mref); lsum += p_[r_]; } \
        _Pragma("unroll") for (int r_ = 0; r_ < 4; ++r_) _Pragma("unroll") for (int jj_ = 0; jj_ < 2; ++jj_) _Pragma("unroll") for (int rr_ = 0; rr_ < 4; ++rr_) \
            acc[jj_][rr_] = __builtin_amdgcn_mfma_f32_16x16x4f32(p_[r_], Vc[2 * r_ + jj_][rr_], acc[jj_][rr_], 0, 0, 0); } while (0)
        DEC_ISSUE(0);
        for (int tt = 0; tt < 16; ++tt) {
            f32x4v Kc[8], Vc[8];
#pragma unroll
            for (int j = 0; j < 8; ++j) { Kc[j] = Kn[j]; Vc[j] = Vn[j]; }
            if (tt + 1 < 16) DEC_ISSUE(tt + 1);
            DEC_TILE(false);
        }
        if (wave == 7) {
            f32x4v Kc[8], Vc[8];
            const float* kp = outf + OFF_KS + (size_t)(b * DEC_S + (c16 < 7 ? c16 : 7)) * 512 + h * 128 + 4 * g;
#pragma unroll
            for (int j = 0; j < 8; ++j) Kc[j] = *(const f32x4v*)(kp + 16 * j);
#pragma unroll
            for (int r = 0; r < 4; ++r) { const int key = 4 * g + r < 7 ? 4 * g + r : 7; const float* vp = outf + OFF_VS + (size_t)(b * DEC_S + key) * 512 + h * 128 + 4 * c16;
                Vc[2 * r] = *(const f32x4v*)(vp); Vc[2 * r + 1] = *(const f32x4v*)(vp + 64); }
            DEC_TILE(true);
        }
#undef DEC_ISSUE
#undef DEC_TILE
        float lt = lsum; lt += __shfl_xor(lt, 16); lt += __shfl_xor(lt, 32);
        if (g == 0) { ML[(wave * 16 + c16) * 2] = mref; ML[(wave * 16 + c16) * 2 + 1] = lt; }
#pragma unroll
        for (int jj = 0; jj < 2; ++jj)
#pragma unroll
            for (int i = 0; i < 4; ++i) *(LAS f32x4v*)(Om + (size_t)((wave * 16 + 4 * g + i) * 128 + 64 * jj + 4 * c16)) = (f32x4v){acc[jj][0][i], acc[jj][1][i], acc[jj][2][i], acc[jj][3][i]};
        __syncthreads();
        { const int qi = wave; float on[2][2];
#pragma unroll
            for (int mp = 0; mp < 2; ++mp) { const int col = mp * 8 + qi; float M = -INFINITY;
#pragma unroll
                for (int w = 0; w < 8; ++w) M = fmaxf(M, ML[(w * 16 + col) * 2]);
                float L = 0.f, o0 = 0.f, o1 = 0.f;
#pragma unroll
                for (int w = 0; w < 8; ++w) { const float wt = __builtin_amdgcn_exp2f(ML[(w * 16 + col) * 2] - M); L = fmaf(wt, ML[(w * 16 + col) * 2 + 1], L);
                    const f32x2w ov = *(const LAS f32x2w*)(Om + (size_t)((w * 16 + col) * 128 + 2 * lane)); o0 = fmaf(wt, ov.x, o0); o1 = fmaf(wt, ov.y, o1); }
                const float inv = 1.0f / L; on[mp][0] = o0 * inv; on[mp][1] = o1 * inv; }
            const float d0 = on[0][0] - lam * on[1][0], d1 = on[0][1] - lam * on[1][1];
            const float rs = 1.0f / sqrtf(wave_sum(d0 * d0 + d1 * d1) * (1.f / 128.f) + EPS);
            const size_t row = (size_t)(MP + b * DEC_S + qi); const int cc = h * 128 + 2 * lane;
            const unsigned gaw = *(const unsigned*)(GAb + row * 512 + cc);
            const float y0 = d0 * rs * subln[2 * lane] * __uint_as_float(gaw << 16), y1 = d1 * rs * subln[2 * lane + 1] * __uint_as_float(gaw & 0xffff0000u);
            *(unsigned*)(Mb + row * 1024 + cc) = pk2(y0, y1); }
        __syncthreads();
    }
}
__device__ __forceinline__ void attn_post(Frame& F, const Args& A) {
    const float lam = compute_lam(F, A);
    const float* subln = A.in[12]; const bf16 *O1b = WSP(bf16, WS_O1), *O2b = WSP(bf16, WS_O2), *GAb = WSP(bf16, WS_GA); bf16* Mb = WSP(bf16, WS_M);
    int tid_ = threadIdx.x; asm volatile("" : "+v"(tid_)); const int lane = tid_ & 63, gw = F.vcu * NWAVES + __builtin_amdgcn_readfirstlane(tid_ >> 6), NGW = F.G * NWAVES;
    const f32x4 sg0 = *(const f32x4*)(subln + (8 * lane & 127)), sg1 = *(const f32x4*)(subln + (8 * lane & 127) + 4);
    for (int row = gw; row < MP; row += NGW) {
        const v4u a = *(const v4u*)(O1b + (size_t)row * 512 + 8 * lane), b = *(const v4u*)(O2b + (size_t)row * 512 + 8 * lane), gq = *(const v4u*)(GAb + (size_t)row * 512 + 8 * lane);
        float o[8], gg[8]; float ss = 0.f;
#pragma unroll
        for (int i = 0; i < 4; ++i) { const unsigned aw = a[i], bw = b[i], gw_ = gq[i];
            o[2 * i] = __uint_as_float(aw << 16) - lam * __uint_as_float(bw << 16); o[2 * i + 1] = __uint_as_float(aw & 0xffff0000u) - lam * __uint_as_float(bw & 0xffff0000u);
            gg[2 * i] = __uint_as_float(gw_ << 16); gg[2 * i + 1] = __uint_as_float(gw_ & 0xffff0000u);
            ss += o[2 * i] * o[2 * i] + o[2 * i + 1] * o[2 * i + 1]; }
        ss += __shfl_xor(ss, 1); ss += __shfl_xor(ss, 2); ss += __shfl_xor(ss, 4); ss += __shfl_xor(ss, 8);
        const float rs = 1.0f / sqrtf(ss * (1.f / 128.f) + EPS);
        v4u w; w.x = pk2(o[0] * rs * sg0[0] * gg[0], o[1] * rs * sg0[1] * gg[1]); w.y = pk2(o[2] * rs * sg0[2] * gg[2], o[3] * rs * sg0[3] * gg[3]);
        w.z = pk2(o[4] * rs * sg1[0] * gg[4], o[5] * rs * sg1[1] * gg[5]); w.w = pk2(o[6] * rs * sg1[2] * gg[6], o[7] * rs * sg1[3] * gg[7]);
        *(v4u*)(Mb + (size_t)row * 1024 + 8 * lane) = w;
    }
}
__device__ __forceinline__ void final_norm(Frame& F, const Args& A) {
    const float* RSS = WSP(float, WS_RSS); float* out = A.out;
    int tid_ = threadIdx.x; asm volatile("" : "+v"(tid_)); const int lane = tid_ & 63, gw = F.vcu * NWAVES + __builtin_amdgcn_readfirstlane(tid_ >> 6), NGW = F.G * NWAVES;
    f32x4 gv[4];
#pragma unroll
    for (int j = 0; j < 4; ++j) gv[j] = *((const f32x4*)A.in[20] + lane + 64 * j);
    for (int row = gw; row < MT; row += NGW) {
        float ss = (lane < 16) ? RSS[(size_t)row * 16 + lane] : 0.f;
        ss += __shfl_xor(ss, 1); ss += __shfl_xor(ss, 2); ss += __shfl_xor(ss, 4); ss += __shfl_xor(ss, 8);
        ss = __shfl(ss, 0);
        const float rs = 1.0f / sqrtf(ss * (1.f / D_MODEL) + EPS);
        f32x4* yr = (f32x4*)(out + (size_t)row * D_MODEL) + lane;
#pragma unroll
        for (int j = 0; j < 4; ++j) { const f32x4 y = yr[64 * j]; yr[64 * j] = y * rs * gv[j]; }
    }
}

__global__ void __launch_bounds__(NWAVES * 64, 2) hymba_fwd(Args args) {
    extern __shared__ __attribute__((aligned(16))) unsigned char lds[];
    Frame F;
    F.lds = (LAS unsigned char*)lds;
    F.MISC = (volatile LAS unsigned*)(F.lds + MISC_OFF);
    F.tid = threadIdx.x; F.lane = F.tid & 63; F.wave = __builtin_amdgcn_readfirstlane(F.tid >> 6);
    F.G = gridDim.x; { const int bx = blockIdx.x; F.vcu = (F.G % 8 == 0) ? (bx % 8) * (F.G / 8) + bx / 8 : bx; }
    const Args& A = args;
    F.ctl = (gu32*)(A.ws + WS_CTL);
    for (int u = F.tid; u < (LDS_BYTES - LDSCTL_OFF) / 4; u += NWAVES * 64) ((LAS unsigned*)(F.lds + LDSCTL_OFF))[u] = 0u;
    __syncthreads();
    XcdBarrier bar = xcd_barrier_post((unsigned*)(F.ctl + CW_BAR), F.MISC + 8);

#ifndef SKIP_P0
    p0_prologue(F, A);
#endif
    xcd_barrier(bar);
#ifndef SKIP_G1
    { pg8::Gemm g{WSP(bf16, WS_XN), WSP(bf16, WS_WIN), MT, D_IN, D_MODEL}; pg8::StaticOrder S; S.init(MT, D_IN, F.G, (int)blockIdx.x);
      pg8::EpiIn E{WSP(bf16, WS_Q), WSP(bf16, WS_K), WSP(bf16, WS_V), WSP(bf16, WS_GA), WSP(bf16, WS_GC), WSP(float, WS_U), A.out};
      pg8::gemm_phase<pg8::EpiIn, pg8::StaticOrder, PG8_ALIGN, PG8_SP2>(F.lds + RING_OFF, g, S, E); }
#endif
    xcd_barrier(bar);
#ifndef SKIP_CONV
    conv_phase(F, A);
#endif
    __syncthreads();
#ifndef SKIP_ATTN
    { const attn_body::AttnTensors AT{WSP(const attn_body::bf16, WS_Q), WSP(const attn_body::bf16, WS_K), WSP(const attn_body::bf16, WS_V), WSP(attn_body::bf16, WS_O1), WSP(attn_body::bf16, WS_O2)};
      const attn_body::StaticOrder S((int)F.G, (int)blockIdx.x);
      attn_body::attn_phase<attn_body::StaticOrder>((char*)lds + RING_OFF, AT, S); }
#endif
#ifndef SKIP_DEC
    decode_phase(F, A);
#endif
    xcd_barrier(bar);
    { pg8::Gemm g{WSP(bf16, WS_C), WSP(bf16, WS_WPW), MT, 512, 512}; pg8::StaticOrder S; S.init(MT, 512, F.G, (int)blockIdx.x);
      pg8::EpiPw2 E{A.in[18], WSP(bf16, WS_GC), WSP(bf16, WS_M)};
      pg8::gemm_phase<pg8::EpiPw2, pg8::StaticOrder, PG8_ALIGN, PG8_SP2>(F.lds + RING_OFF, g, S, E); }
#ifndef SKIP_POST
    attn_post(F, A);
#endif
    xcd_barrier(bar);
    { pg8::Gemm g{WSP(bf16, WS_M), WSP(bf16, WS_WOUT), MT, D_MODEL, D_MODEL}; pg8::StaticOrder S; S.init(MT, D_MODEL, F.G, (int)blockIdx.x);
      pg8::EpiOut E{A.in[0], A.in[1], A.out, WSP(float, WS_RSS)};
      pg8::gemm_phase<pg8::EpiOut, pg8::StaticOrder, PG8_ALIGN, PG8_SP2>(F.lds + RING_OFF, g, S, E); }
    xcd_barrier(bar);
#ifndef SKIP_FIN
    final_norm(F, A);
#endif
}

extern "C" void kernel_launch(void* const* d_in, const int* in_sizes, int n_in, void* d_out, int out_size, void* d_ws, size_t ws_size, hipStream_t stream) {
    static int grid = 0;
    if (grid == 0) {
        if (n_in != 21 || in_sizes[0] != MP * D_MODEL || (size_t)out_size != OUT_TOTAL || ws_size < WS_END) { fprintf(stderr, "kernel_launch: unexpected problem (n_in %d, in0 %d, out %d, ws %zu); nothing launched\n", n_in, n_in > 0 ? in_sizes[0] : -1, out_size, ws_size); grid = -1; return; }
        int dev = 0, cus = 0, per_cu = 0;
        if (hipGetDevice(&dev) != hipSuccess || hipDeviceGetAttribute(&cus, hipDeviceAttributeMultiprocessorCount, dev) != hipSuccess) { fprintf(stderr, "kernel_launch: device query failed\n"); grid = -1; return; }
        if (hipFuncSetAttribute((const void*)hymba_fwd, hipFuncAttributeMaxDynamicSharedMemorySize, LDS_BYTES) != hipSuccess) { fprintf(stderr, "kernel_launch: hipFuncSetAttribute failed\n"); grid = -1; return; }
        if (hipOccupancyMaxActiveBlocksPerMultiprocessor(&per_cu, (const void*)hymba_fwd, NWAVES * 64, LDS_BYTES) != hipSuccess || per_cu < 1)
            fprintf(stderr, "kernel_launch: note: occupancy query reports %d workgroups per CU\n", per_cu);
        (void)hipGetLastError();
        grid = cus;
        if (grid != 256) fprintf(stderr, "kernel_launch: %d CUs; the attention unit deal is written for 256\n", grid);
    }
    if (grid < 0) return;
    if (hipMemsetAsync((char*)d_ws + WS_CTL, 0, CTL_ZERO_BYTES, stream) != hipSuccess) { fprintf(stderr, "kernel_launch: memset failed\n"); return; }
    Args a{};
    for (int i = 0; i < 21; ++i) a.in[i] = (const float*)d_in[i];
    a.out = (float*)d_out; a.ws = (unsigned char*)d_ws;
    hipLaunchKernelGGL(hymba_fwd, dim3(grid), dim3(NWAVES * 64), LDS_BYTES, stream, a);
    const hipError_t le = hipPeekAtLastError();
    if (le != hipSuccess) fprintf(stderr, "kernel_launch: launch failed: %s\n", hipGetErrorName(le));
}
```

```cpp
#include <hip/hip_runtime.h>
#include <cstdio>
#include <cstdint>
constexpr int D_MODEL = 1024, SEQ = 8192, NBATCH = 2, MP = NBATCH * SEQ;
constexpr int DEC_B = 128, DEC_S = 8, MS = DEC_B * DEC_S;
constexpr int MT = MP + MS;
constexpr int D_IN = 3584, CONV_W = 31, HIST = 30, NPAGES = 16;
constexpr float EPS = 1e-5f, LOG2E = 1.4426950408889634f;
constexpr float QSCALE = 0.125f * LOG2E;
constexpr size_t OFF_YP = 0, OFF_YS = OFF_YP + (size_t)MP * D_MODEL, OFF_KP = OFF_YS + (size_t)MS * D_MODEL, OFF_VP = OFF_KP + (size_t)MP * 512, OFF_CP = OFF_VP + (size_t)MP * 512,
    OFF_KS = OFF_CP + (size_t)NBATCH * HIST * 512, OFF_VS = OFF_KS + (size_t)MS * 512, OFF_CS = OFF_VS + (size_t)MS * 512, OUT_TOTAL = OFF_CS + (size_t)DEC_B * HIST * 512;
static_assert(OUT_TOTAL == 37648384, "output size");
constexpr int UP_SEQ = SEQ + HIST, USMP0 = NBATCH * UP_SEQ, US_SEQ = HIST + DEC_S, U_ROWS = USMP0 + DEC_B * US_SEQ;
__host__ __device__ __forceinline__ int u_row(int row) { return row < MP ? row + HIST * ((row >> 13) + 1) : USMP0 + ((row - MP) >> 3) * US_SEQ + HIST + ((row - MP) & 7); }
__device__ __forceinline__ int lane_id() { int l; asm volatile("v_mbcnt_lo_u32_b32 %0, -1, 0\n\tv_mbcnt_hi_u32_b32 %0, -1, %0" : "=v"(l)); return l; }
namespace pg8 {
#define PG8_LAS __attribute__((address_space(3)))
typedef unsigned short bf16_t;
typedef short bf16x8 __attribute__((ext_vector_type(8)));
typedef float f32x4 __attribute__((ext_vector_type(4)));
typedef unsigned u32x4 __attribute__((ext_vector_type(4)));
constexpr int BM = 256, BK = 64, HALF = 128, HTB = HALF * BK * 2  , STAGE_BYTES = 8 * HTB, NXCD = 8, WGM = 8;

__host__ __device__ __forceinline__ int lds_byte(int r, int c) { const int st = (r >> 4) * 2 + (c >> 5), rr = r & 15, cc = c & 31, ob = rr * 64 + cc * 2; return st * 1024 + (ob ^ (((ob >> 9) & 1) << 5)); }
__host__ __device__ __forceinline__ void stage_rc(int b, int& R, int& C) { const int st = b / 1024, sb = b % 1024, swz = sb ^ (((sb >> 9) & 1) << 5); R = (st >> 1) * 16 + swz / 64; C = (st & 1) * 32 + (swz % 64) / 2; }
__host__ __device__ __forceinline__ int perm32(int rho) { const int n = rho >> 4, i = rho & 15; return 8 * (i >> 2) + 4 * n + (i & 3); }

struct Unit { int pm, pn; };
struct Gemm { const bf16_t* A; const bf16_t* Bt; int M, N, K, ld; };

struct StaticOrder {
    int nM, nN, nwg, G, c;
    __host__ __device__ void init(int M, int N, int G_, int c_) { nM = M / BM; nN = N / BM; nwg = nM * nN; G = G_; c = c_; }
    __host__ __device__ bool next(int i, Unit& u) const {
        const long L = (long)i * G + c; if (L >= nwg) return false;
        int wgid = (int)L; { const int q = nwg / NXCD, r = nwg % NXCD, xcd = wgid % NXCD, off = wgid / NXCD; wgid = (xcd < r ? xcd * (q + 1) : r * (q + 1) + (xcd - r) * q) + off; }
        const int nig = WGM * nN, gid = wgid / nig, fm = gid * WGM, gsz = (nM - fm) < WGM ? (nM - fm) : WGM;
        u.pm = fm + ((wgid % nig) % gsz); u.pn = (wgid % nig) / gsz; return true;
    }
    __device__ __forceinline__ void a_ready(const Unit&) const {}
    __device__ __forceinline__ void done(const Unit&) const {}
};
__device__ __forceinline__ unsigned cvt_pk_bf16(float lo, float hi) { unsigned r; asm volatile("v_cvt_pk_bf16_f32 %0, %1, %2" : "=v"(r) : "v"(lo), "v"(hi)); return r; }
typedef float f32x2 __attribute__((ext_vector_type(2)));
__device__ __forceinline__ float sigm_f(float x) { return __builtin_amdgcn_rcpf(1.0f + __builtin_amdgcn_exp2f(-LOG2E * x)); }
__device__ __forceinline__ float silu_f(float x) { return x * sigm_f(x); }
__device__ __forceinline__ u32x4 pack8(const f32x4 v0, const f32x4 v1) { u32x4 w; w.x = cvt_pk_bf16(v0[0], v0[1]); w.y = cvt_pk_bf16(v0[2], v0[3]); w.z = cvt_pk_bf16(v1[0], v1[1]); w.w = cvt_pk_bf16(v1[2], v1[3]); return w; }
#define ST16_WT(p, v) asm volatile("global_store_dwordx4 %0, %1, off sc1\n\ts_nop 1" :: "v"(p), "v"(v) : "memory")
struct EpiIn {
    static constexpr bool PERM = true, AFTER_DRAIN = false;
    bf16_t *Qb, *Kb, *Vb, *GAb, *GCb; bf16_t* U; float* out;
    __device__ __forceinline__ void operator()(const f32x4 (&acc)[2][2][4][2], const Unit& u, int wr, int wc, int fr, int fq) const {
        const int row0 = u.pm * BM + wr * 64 + fr, pn = u.pn, cw = wc * 32 + 8 * fq;
        if (pn < 2 || pn == 6 || pn == 7 || pn >= 12) {
            bf16_t* base; int mode;
            if (pn < 2) { base = Qb + pn * 256; mode = 0; } else if (pn < 8) { base = GAb + (pn - 6) * 256; mode = 1; } else { base = GCb + (pn - 12) * 256; mode = 2; }
#pragma unroll
            for (int ai = 0; ai < 2; ++ai)
#pragma unroll
                for (int m = 0; m < 4; ++m) { bf16_t* rowp = base + (size_t)(row0 + ai * HALF + m * 16) * 512 + cw;
#pragma unroll
                    for (int bj = 0; bj < 2; ++bj) { f32x4 v0 = acc[ai][bj][m][0], v1 = acc[ai][bj][m][1];
                        if (mode == 0) { v0 = v0 * QSCALE; v1 = v1 * QSCALE; }
                        else { const float sc = mode == 1 ? 0.8f : 1.0f;
#pragma unroll
                            for (int i = 0; i < 4; ++i) { v0[i] = silu_f(v0[i]) * sc; v1[i] = silu_f(v1[i]) * sc; } }
                        *(u32x4*)(rowp + bj * HALF) = pack8(v0, v1); } }
        } else if (pn < 6) {
            const int t = (pn - 2) >> 1, cb = ((pn - 2) & 1) * 256 + cw; const bool smp = u.pm >= MP / BM;
            bf16_t* bb = (t ? Vb : Kb) + cb;
            float* fb = out + (smp ? (t ? OFF_VS : OFF_KS) - (size_t)MP * 512 : (t ? OFF_VP : OFF_KP)) + cb;
#pragma unroll
            for (int ai = 0; ai < 2; ++ai)
#pragma unroll
                for (int m = 0; m < 4; ++m) { const size_t ro = (size_t)(row0 + ai * HALF + m * 16) * 512;
#pragma unroll
                    for (int bj = 0; bj < 2; ++bj) { const f32x4 v0 = acc[ai][bj][m][0], v1 = acc[ai][bj][m][1];
                        *(f32x4*)(fb + ro + bj * HALF) = v0; *(f32x4*)(fb + ro + bj * HALF + 4) = v1; *(u32x4*)(bb + ro + bj * HALF) = pack8(v0, v1); } }
        } else {
            bf16_t* ub = U + 128 * (pn - 8) + cw; const int ccol = 128 * (pn - 8) + cw;
            const bool outs = (u.pm & 31) == 31 || u.pm >= MP / BM;
#pragma unroll
            for (int ai = 0; ai < 2; ++ai)
#pragma unroll
                for (int m = 0; m < 4; ++m) { const int row = row0 + ai * HALF + m * 16; const size_t ro = (size_t)u_row(row) * 512; f32x4 o[2];
#pragma unroll
                    for (int n = 0; n < 2; ++n) { const f32x4 a = acc[ai][0][m][n], b = acc[ai][1][m][n];
#pragma unroll
                        for (int i = 0; i < 4; ++i) o[n][i] = a[i] * sigm_f(b[i]); }
                    *(u32x4*)(ub + ro) = pack8(o[0], o[1]);
                    if (outs) { long od = -1;
                        if (row < MP) { const int t = row & (SEQ - 1); if (t >= SEQ - HIST) od = (long)OFF_CP + ((long)(row >> 13) * HIST + (t - (SEQ - HIST))) * 512; }
                        else { const int rs = row - MP; od = (long)OFF_CS + ((long)(rs >> 3) * HIST + (HIST - DEC_S) + (rs & 7)) * 512; }
                        if (od >= 0) { *(f32x4*)(out + od + ccol) = o[0]; *(f32x4*)(out + od + ccol + 4) = o[1]; } } }
        }
    }
};
struct EpiPw2 {
    static constexpr bool PERM = true, AFTER_DRAIN = false;
    const float* bias; const bf16_t* GCb; bf16_t* Mb;
    __device__ __forceinline__ void operator()(const f32x4 (&acc)[2][2][4][2], const Unit& u, int wr, int wc, int fr, int fq) const {
        const int row0 = u.pm * BM + wr * 64 + fr, c0 = u.pn * BM + wc * 32 + 8 * fq;
        f32x4 bv[2][2];
#pragma unroll
        for (int bj = 0; bj < 2; ++bj)
#pragma unroll
            for (int n = 0; n < 2; ++n) bv[bj][n] = *(const f32x4*)(bias + c0 + bj * HALF + 4 * n);
#pragma unroll
        for (int ai = 0; ai < 2; ++ai)
#pragma unroll
            for (int m = 0; m < 4; ++m) { const size_t r = (size_t)(row0 + ai * HALF + m * 16);
#pragma unroll
                for (int bj = 0; bj < 2; ++bj) { const u32x4 gw = *(const u32x4*)(GCb + r * 512 + c0 + bj * HALF);
                    f32x4 g0, g1; g0[0] = __uint_as_float(gw.x << 16); g0[1] = __uint_as_float(gw.x & 0xffff0000u); g0[2] = __uint_as_float(gw.y << 16); g0[3] = __uint_as_float(gw.y & 0xffff0000u);
                    g1[0] = __uint_as_float(gw.z << 16); g1[1] = __uint_as_float(gw.z & 0xffff0000u); g1[2] = __uint_as_float(gw.w << 16); g1[3] = __uint_as_float(gw.w & 0xffff0000u);
                    const f32x4 v0 = (acc[ai][bj][m][0] + bv[bj][0]) * g0, v1 = (acc[ai][bj][m][1] + bv[bj][1]) * g1;
                    { const u32x4 pw_ = pack8(v0, v1); ST16_WT(Mb + r * 1024 + 512 + c0 + bj * HALF, pw_); } } }
    }
};
struct EpiOut {
    static constexpr bool PERM = true, AFTER_DRAIN = false;
    bf16_t* mix;
    __device__ __forceinline__ void operator()(const f32x4 (&acc)[2][2][4][2], const Unit& u, int wr, int wc, int fr, int fq) const {
        const int row0 = u.pm * BM + wr * 64 + fr, c0 = u.pn * BM + wc * 32 + 8 * fq;
#pragma unroll
        for (int ai = 0; ai < 2; ++ai)
#pragma unroll
            for (int m = 0; m < 4; ++m) { bf16_t* rowp = mix + (size_t)(row0 + ai * HALF + m * 16) * D_MODEL + c0;
#pragma unroll
                for (int bj = 0; bj < 2; ++bj) *(u32x4*)(rowp + bj * HALF) = pack8(acc[ai][bj][m][0], acc[ai][bj][m][1]); }
    }
};
struct EpiPart {
    static constexpr bool PERM = true, AFTER_DRAIN = false;
    float* part;
    __device__ __forceinline__ void operator()(const f32x4 (&acc)[2][2][4][2], const Unit& u, int wr, int wc, int fr, int fq) const {
        const int row0 = (u.pm - MP / BM) * BM + wr * 64 + fr, c0 = u.pn * BM + wc * 32 + 8 * fq;
#pragma unroll
        for (int ai = 0; ai < 2; ++ai)
#pragma unroll
            for (int m = 0; m < 4; ++m) { const size_t r = (size_t)(row0 + ai * HALF + m * 16);
#pragma unroll
                for (int bj = 0; bj < 2; ++bj)
#pragma unroll
                    for (int n = 0; n < 2; ++n) *(f32x4*)(part + r * D_MODEL + c0 + bj * HALF + 4 * n) = acc[ai][bj][m][n]; }
    }
};
struct SampleOrder {
    int c;
    __device__ __forceinline__ bool next(int i, Unit& u) const { if (i > 0 || c >= 64) return false; u.pm = MP / BM + (c >> 4); u.pn = (c >> 2) & 3; return true; }
    __device__ __forceinline__ void a_ready(const Unit&) const {}
    __device__ __forceinline__ void done(const Unit&) const {}
};
struct TicketOrder {
    int t;
    __device__ __forceinline__ bool next(int i, Unit& u) const { if (i > 0 || t >= (MT / BM) * 2) return false; u.pm = t >> 1; u.pn = t & 1; return true; }
    __device__ __forceinline__ void a_ready(const Unit&) const {}
    __device__ __forceinline__ void done(const Unit&) const {}
};
struct OneUnit {
    int pm, pn;
    __device__ __forceinline__ bool next(int i, Unit& u) const { if (i > 0) return false; u.pm = pm; u.pn = pn; return true; }
    __device__ __forceinline__ void a_ready(const Unit&) const {}
    __device__ __forceinline__ void done(const Unit&) const {}
};
template <class Epi, class Sched, bool ALIGN_EPI = false, bool SP2 = false>
__device__ __forceinline__ void gemm_phase(PG8_LAS unsigned char* lds, const Gemm g, const Sched& S, const Epi& E, const int g_wave) {
    int tid = g_wave * 64 + lane_id(); asm volatile("" : "+v"(tid));
    const int wid = __builtin_amdgcn_readfirstlane(tid >> 6), lane = tid & 63, wr = wid >> 2, wc = wid & 3, fr = lane & 15, fq = lane >> 4;
    const int K = g.K, LD = g.ld, nt = K / BK;
    unsigned voffA[2], voffB[2];
#pragma unroll
    for (int i = 0; i < 2; ++i) { int R, C; stage_rc(tid * 16 + i * 8192, R, C); const int Rb = Epi::PERM ? ((R & ~31) + perm32(R & 31)) : R;
        voffA[i] = (unsigned)(R * LD + C) * 2u; voffB[i] = (unsigned)(Rb * LD + C) * 2u; }
    const size_t kstep = (size_t)(BK * 2);
    const size_t hstep = (size_t)HALF * LD * 2;
    const size_t tstep = 2 * hstep;
    const unsigned ldsw = (unsigned)wid * 1024u;
    const int aoff = lds_byte(wr * 64 + fr, fq * 8), boff = lds_byte(wc * 32 + fr, fq * 8);
#define PG8_SA(b, h) (((b) * 2 + (h)) * HTB)
#define PG8_SB(b, h) ((4 + (b) * 2 + (h)) * HTB)
#define PG8_STAGE(bufoff, gbase, voff) do { _Pragma("unroll") for (int _i = 0; _i < 2; ++_i) \
        __builtin_amdgcn_global_load_lds((const unsigned*)((const char*)(gbase) + (voff)[_i]), (PG8_LAS unsigned*)(lds + (bufoff) + ldsw + _i * 8192), 16, 0, 0); } while (0)
#define PG8_LDA(dst, b, h) do { _Pragma("unroll") for (int m = 0; m < 4; ++m) _Pragma("unroll") for (int k = 0; k < 2; ++k) dst[m][k] = *(const PG8_LAS bf16x8*)(lds + PG8_SA(b, h) + aoff + m * 2048 + k * 1024); } while (0)
#define PG8_LDB(dst, b, h) do { _Pragma("unroll") for (int n = 0; n < 2; ++n) _Pragma("unroll") for (int k = 0; k < 2; ++k) dst[n][k] = *(const PG8_LAS bf16x8*)(lds + PG8_SB(b, h) + boff + n * 2048 + k * 1024); } while (0)
#define PG8_MMA(ai, bj, At, Bt) do { __builtin_amdgcn_s_setprio(1); _Pragma("unroll") for (int m = 0; m < 4; ++m) _Pragma("unroll") for (int n = 0; n < 2; ++n) _Pragma("unroll") for (int k = 0; k < 2; ++k) \
        acc[ai][bj][m][n] = __builtin_amdgcn_mfma_f32_16x16x32_bf16(Bt[n][k], At[m][k], acc[ai][bj][m][n], 0, 0, 0); __builtin_amdgcn_s_setprio(0); } while (0)
#define PG8_WAIT_V(n) asm volatile("s_waitcnt vmcnt(" #n ")" ::: "memory")
#define PG8_WAIT_L(n) asm volatile("s_waitcnt lgkmcnt(" #n ")" ::: "memory")
#define PG8_BAR __builtin_amdgcn_s_barrier()
#define PG8_SCHED __builtin_amdgcn_sched_barrier(0)
    Unit cur, nxt; int ui = 0;
    if (!S.next(0, cur)) return;
    f32x4 acc[2][2][4][2];
#pragma unroll
    for (int a = 0; a < 2; ++a)
#pragma unroll
        for (int b = 0; b < 2; ++b)
#pragma unroll
            for (int m = 0; m < 4; ++m)
#pragma unroll
                for (int n = 0; n < 2; ++n) acc[a][b][m][n] = (f32x4){0.f, 0.f, 0.f, 0.f};
    bf16x8 At[4][2], B0[2][2], B1[2][2];
    const char* cA = (const char*)g.A + (size_t)cur.pm * tstep; const char* cB = (const char*)g.Bt + (size_t)cur.pn * tstep;
    S.a_ready(cur);
    if constexpr (SP2) {
        PG8_STAGE(PG8_SB(0, 0), cB, voffB); PG8_STAGE(PG8_SB(0, 1), cB + hstep, voffB); PG8_STAGE(PG8_SA(0, 0), cA, voffA); PG8_STAGE(PG8_SA(0, 1), cA + hstep, voffA);
        if (wr == 1) PG8_BAR;
        PG8_WAIT_V(2); PG8_BAR;
        PG8_STAGE(PG8_SB(1, 0), cB + kstep, voffB); PG8_STAGE(PG8_SA(1, 0), cA + kstep, voffA); PG8_STAGE(PG8_SB(1, 1), cB + hstep + kstep, voffB);
        PG8_WAIT_V(6); PG8_BAR;
    } else {
        PG8_STAGE(PG8_SB(0, 0), cB, voffB); PG8_STAGE(PG8_SA(0, 0), cA, voffA); PG8_STAGE(PG8_SB(0, 1), cB + hstep, voffB); PG8_STAGE(PG8_SA(0, 1), cA + hstep, voffA);
        if (wr == 1) PG8_BAR;
        PG8_WAIT_V(4); PG8_BAR;
        PG8_STAGE(PG8_SB(1, 0), cB + kstep, voffB); PG8_STAGE(PG8_SA(1, 0), cA + kstep, voffA); PG8_STAGE(PG8_SB(1, 1), cB + hstep + kstep, voffB);
        PG8_WAIT_V(6); PG8_BAR;
    }
    for (;;) {
        const bool has_next = S.next(ui + 1, nxt);
        const char* nA = has_next ? (const char*)g.A + (size_t)nxt.pm * tstep : cA; const char* nB = has_next ? (const char*)g.Bt + (size_t)nxt.pn * tstep : cB;
        for (int t = 0; t < nt; t += 2) {
            const bool last = (t == nt - 2);
            const char* a1 = cA + (size_t)(t + 1) * kstep;
            const char* a2 = last ? nA : cA + (size_t)(t + 2) * kstep; const char* b2 = last ? nB : cB + (size_t)(t + 2) * kstep;
            const char* a3 = a2 + kstep; const char* b3 = b2 + kstep;
            if (last && has_next) S.a_ready(nxt);
            if constexpr (SP2) {
            PG8_LDB(B0, 0, 0); PG8_LDB(B1, 0, 1); PG8_SCHED; PG8_LDA(At, 0, 0); PG8_STAGE(PG8_SA(1, 1), a1 + hstep, voffA);
            PG8_WAIT_V(8); PG8_WAIT_L(0); PG8_BAR; PG8_MMA(0, 0, At, B0); PG8_MMA(0, 1, At, B1); PG8_BAR; PG8_SCHED;
            PG8_LDA(At, 0, 1); PG8_STAGE(PG8_SB(0, 0), b2, voffB); PG8_STAGE(PG8_SB(0, 1), b2 + hstep, voffB); PG8_STAGE(PG8_SA(0, 0), a2, voffA);
            PG8_WAIT_V(8); PG8_WAIT_L(0); PG8_BAR; PG8_MMA(1, 0, At, B0); PG8_MMA(1, 1, At, B1); PG8_BAR; PG8_SCHED;
            PG8_LDB(B0, 1, 0); PG8_LDB(B1, 1, 1); PG8_SCHED; PG8_LDA(At, 1, 0); PG8_STAGE(PG8_SA(0, 1), a2 + hstep, voffA);
            PG8_WAIT_V(8); PG8_WAIT_L(0); PG8_BAR; PG8_MMA(0, 0, At, B0); PG8_MMA(0, 1, At, B1); PG8_BAR; PG8_SCHED;
            PG8_LDA(At, 1, 1); PG8_STAGE(PG8_SB(1, 0), b3, voffB); PG8_STAGE(PG8_SB(1, 1), b3 + hstep, voffB); PG8_STAGE(PG8_SA(1, 0), a3, voffA);
            PG8_WAIT_V(8); PG8_WAIT_L(0); PG8_BAR; PG8_MMA(1, 0, At, B0); PG8_MMA(1, 1, At, B1); PG8_BAR; PG8_SCHED;
            } else {
            PG8_LDB(B0, 0, 0); PG8_SCHED; PG8_LDA(At, 0, 0); PG8_STAGE(PG8_SA(1, 1), a1 + hstep, voffA);
            PG8_WAIT_L(8); PG8_BAR; PG8_WAIT_L(0); PG8_MMA(0, 0, At, B0); PG8_BAR; PG8_SCHED;
            PG8_LDB(B1, 0, 1); PG8_STAGE(PG8_SB(0, 0), b2, voffB);
            PG8_BAR; PG8_WAIT_L(0); PG8_MMA(0, 1, At, B1); PG8_BAR;
            PG8_LDA(At, 0, 1); PG8_STAGE(PG8_SA(0, 0), a2, voffA);
            PG8_BAR; PG8_WAIT_L(0); PG8_MMA(1, 0, At, B0); PG8_BAR; PG8_SCHED;
            PG8_STAGE(PG8_SB(0, 1), b2 + hstep, voffB);
            PG8_WAIT_V(6); PG8_BAR; PG8_MMA(1, 1, At, B1); PG8_BAR;
            PG8_LDB(B0, 1, 0); PG8_SCHED; PG8_LDA(At, 1, 0); PG8_STAGE(PG8_SA(0, 1), a2 + hstep, voffA);
            PG8_WAIT_L(8); PG8_BAR; PG8_WAIT_L(0); PG8_MMA(0, 0, At, B0); PG8_BAR; PG8_SCHED;
            PG8_LDB(B1, 1, 1); PG8_STAGE(PG8_SB(1, 0), b3, voffB);
            PG8_BAR; PG8_WAIT_L(0); PG8_MMA(0, 1, At, B1); PG8_BAR;
            PG8_LDA(At, 1, 1); PG8_STAGE(PG8_SA(1, 0), a3, voffA);
            PG8_BAR; PG8_WAIT_L(0); PG8_MMA(1, 0, At, B0); PG8_BAR; PG8_SCHED;
            PG8_STAGE(PG8_SB(1, 1), b3 + hstep, voffB);
            PG8_WAIT_V(6); PG8_BAR; PG8_MMA(1, 1, At, B1); PG8_BAR;
            }
        }
        if constexpr (ALIGN_EPI) { if (wr == 0) PG8_BAR; }
        if constexpr (!Epi::AFTER_DRAIN) { E(acc, cur, wr, wc, fr, fq); S.done(cur); }
        if (!has_next) break;
#pragma unroll
        for (int a = 0; a < 2; ++a)
#pragma unroll
            for (int b = 0; b < 2; ++b)
#pragma unroll
                for (int m = 0; m < 4; ++m)
#pragma unroll
                    for (int n = 0; n < 2; ++n) acc[a][b][m][n] = (f32x4){0.f, 0.f, 0.f, 0.f};
        cur = nxt; cA = nA; cB = nB; ++ui;
        if constexpr (ALIGN_EPI) { if (wr == 1) PG8_BAR; }
    }
    PG8_WAIT_V(0);
    if constexpr (!ALIGN_EPI) { if (wr == 0) PG8_BAR; }
    PG8_BAR;
    if constexpr (Epi::AFTER_DRAIN) { E.fused(acc, cur, wr, wc, fr, fq, lds, wid, lane); S.done(cur); }
#undef PG8_SA
#undef PG8_SB
#undef PG8_STAGE
#undef PG8_LDA
#undef PG8_LDB
#undef PG8_MMA
#undef PG8_WAIT_V
#undef PG8_WAIT_L
#undef PG8_BAR
#undef PG8_SCHED
}
}
#ifndef PG8_SP2
#define PG8_SP2 true
#endif
#ifndef PG8_ALIGN
#define PG8_ALIGN true
#endif
#include <hip/hip_bf16.h>
#include <cmath>
namespace attn128 {
using bf16=__hip_bfloat16;
using bf16x8=__attribute__((ext_vector_type(8)))short;
using s16x4=__attribute__((ext_vector_type(4)))short;
using f32x16=__attribute__((ext_vector_type(16)))float;
using u32x4=__attribute__((ext_vector_type(4)))unsigned;
constexpr int BATCH=2,NHEAD=8,SEQ=8192,D=64,DV=128,DM=512;
constexpr int NW=8,QBLK=32,QB=QBLK*NW,KVBLK=64,NQB=SEQ/QB;
constexpr int ATTN_PITCH=DM, ATTN_UNIT_ROWS=QB;
__device__ __forceinline__ int crow(int r,int hi){return (r&3)+8*(r>>2)+4*hi;}
#define SBAR() __builtin_amdgcn_sched_barrier(0)
__device__ __forceinline__ void cmask(f32x16&p0,f32x16&p1,int jb,int qrel,int hi){
  const float NEG=-INFINITY; int kb=64*jb+4*hi;
  #pragma unroll
  for(int r=0;r<16;++r){int kv=kb+(r&3)+8*(r>>2); if(kv>qrel)p0[r]=NEG; if(kv+32>qrel)p1[r]=NEG;}
}

constexpr int NSLOT=3, SLOTB=8192;
constexpr int LDS_K=0, LDS_V=NSLOT*SLOTB, LDS_WS=3*NSLOT*SLOTB, LDS_OST=LDS_WS+NW*64*4, LDS_BYTES=LDS_OST+NW*4096;
constexpr float C2=0.125f*1.4426950408889634f;
__device__ __forceinline__ void glds16(const void*gsrc,unsigned lds_dst){unsigned keep;
  asm volatile("s_mov_b32 %0, m0\n\ts_mov_b32 m0, %2\n\ts_nop 0\n\tglobal_load_lds_dwordx4 %1, off\n\ts_mov_b32 m0, %0":"=&s"(keep):"v"(gsrc),"s"(lds_dst):"memory");}
__device__ __forceinline__ float max3f(float a,float b,float c){float r;asm("v_max3_f32 %0, %1, %2, %3":"=v"(r):"v"(a),"v"(b),"v"(c));return r;}
__device__ __forceinline__ float max2f(float a,float b){float r;asm("v_max_f32_e32 %0, %1, %2":"=v"(r):"v"(a),"v"(b));return r;}
__device__ __forceinline__ float fadd_s(float a,float b){float r;asm("v_add_f32_e32 %0, %1, %2":"=v"(r):"v"(a),"v"(b));return r;}
__device__ __forceinline__ float fsub_s(float a,float b){float r;asm("v_sub_f32_e32 %0, %1, %2":"=v"(r):"v"(a),"v"(b));return r;}
typedef float f32x2_t __attribute__((ext_vector_type(2))); typedef __bf16 bf16x2_t __attribute__((ext_vector_type(2)));
__device__ __forceinline__ unsigned cvtpk_s(float lo,float hi){f32x2_t v={lo,hi};bf16x2_t b=__builtin_convertvector(v,bf16x2_t);return __builtin_bit_cast(unsigned,b);}
#define WAIT_BAR(N) asm volatile("s_waitcnt vmcnt(" #N ") lgkmcnt(0)\n\ts_barrier":::"memory")

__device__ __forceinline__ void qkt(f32x16&p0,f32x16&p1,const char*Kslot,const bf16x8*qr,int r32,int hi){
  const char*kb=Kslot+hi*1024+r32*16;
  #pragma unroll
  for(int d0=0;d0<4;++d0){
    const bf16x8 b0=*reinterpret_cast<const bf16x8*>(kb+d0*2048);
    const bf16x8 b1=*reinterpret_cast<const bf16x8*>(kb+d0*2048+512);
    if(d0==0){p0=__builtin_amdgcn_mfma_f32_32x32x16_bf16(b0,qr[0],f32x16{},0,0,0);p1=__builtin_amdgcn_mfma_f32_32x32x16_bf16(b1,qr[0],f32x16{},0,0,0);}
    else{p0=__builtin_amdgcn_mfma_f32_32x32x16_bf16(b0,qr[d0],p0,0,0,0);p1=__builtin_amdgcn_mfma_f32_32x32x16_bf16(b1,qr[d0],p1,0,0,0);}}
}
typedef __attribute__((address_space(3))) const char* lds_cptr;
typedef short v4i16_t __attribute__((ext_vector_type(4)));
__device__ __forceinline__ void kload8(bf16x8*kf,lds_cptr kp){
  kf[0]=*(const __attribute__((address_space(3))) bf16x8*)(kp);      kf[1]=*(const __attribute__((address_space(3))) bf16x8*)(kp+512);
  kf[2]=*(const __attribute__((address_space(3))) bf16x8*)(kp+2048); kf[3]=*(const __attribute__((address_space(3))) bf16x8*)(kp+2560);
  kf[4]=*(const __attribute__((address_space(3))) bf16x8*)(kp+4096); kf[5]=*(const __attribute__((address_space(3))) bf16x8*)(kp+4608);
  kf[6]=*(const __attribute__((address_space(3))) bf16x8*)(kp+6144); kf[7]=*(const __attribute__((address_space(3))) bf16x8*)(kp+6656);
}
__device__ __forceinline__ void kload2(bf16x8*kf,lds_cptr kp,int j){ kf[2*j]=*(const __attribute__((address_space(3))) bf16x8*)(kp+j*2048); kf[2*j+1]=*(const __attribute__((address_space(3))) bf16x8*)(kp+j*2048+512); }
__device__ __forceinline__ s16x4 vtr(lds_cptr p){ return __builtin_bit_cast(s16x4,__builtin_amdgcn_ds_read_tr16_b64_v4i16((__attribute__((address_space(3))) v4i16_t*)p)); }
__device__ __forceinline__ float rowmax(const f32x16&p0,const f32x16&p1){
  float a=max3f(p0[0],p0[1],p1[0]),b=max3f(p0[2],p0[3],p1[1]);a=max3f(a,p1[2],p1[3]);
  #pragma unroll
  for(int r=4;r<16;r+=4){a=max3f(a,p0[r],p0[r+1]);b=max3f(b,p0[r+2],p0[r+3]);a=max3f(a,p1[r],p1[r+1]);b=max3f(b,p1[r+2],p1[r+3]);}
  const float m=max2f(a,b);
  auto rr=__builtin_amdgcn_permlane32_swap(__float_as_uint(m),__float_as_uint(m),false,false);
  return max2f(__uint_as_float(rr[0]),__uint_as_float(rr[1]));
}
__device__ __forceinline__ void pv(f32x16*o,int vb,bf16x8 pa0,bf16x8 pa1,bf16x8 pa2,bf16x8 pa3){
  #pragma unroll
  for(int d0=0;d0<4;++d0){s16x4 lo[4],hi[4];
    #pragma unroll
    for(int ks=0;ks<4;++ks){
      asm volatile("ds_read_b64_tr_b16 %0,%1 offset:%c2":"=&v"(lo[ks]):"v"(vb),"i"(d0*4096+ks*1024):"memory");
      asm volatile("ds_read_b64_tr_b16 %0,%1 offset:%c2":"=&v"(hi[ks]):"v"(vb),"i"(d0*4096+ks*1024+512):"memory");}
    asm volatile("s_waitcnt lgkmcnt(0)":::"memory");SBAR();
    #define PK(k) (bf16x8){lo[k][0],lo[k][1],lo[k][2],lo[k][3],hi[k][0],hi[k][1],hi[k][2],hi[k][3]}
    o[d0]=__builtin_amdgcn_mfma_f32_32x32x16_bf16(pa0,PK(0),o[d0],0,0,0);
    o[d0]=__builtin_amdgcn_mfma_f32_32x32x16_bf16(pa1,PK(1),o[d0],0,0,0);
    o[d0]=__builtin_amdgcn_mfma_f32_32x32x16_bf16(pa2,PK(2),o[d0],0,0,0);
    o[d0]=__builtin_amdgcn_mfma_f32_32x32x16_bf16(pa3,PK(3),o[d0],0,0,0);
    #undef PK
  }
}

#ifndef ATTN_STORE16
#define ATTN_STORE16(p,v) asm volatile("global_store_dwordx4 %0, %1, off sc1\n\ts_nop 1" :: "v"(p), "v"(v) : "memory")
#endif
template<int THRL,bool FAST> __device__ __forceinline__ bool attn_unit(int b,int qcol,int vcol,int qb,const bf16*Q,const bf16*__restrict__ K,const bf16*__restrict__ V,bf16*O,char*shm,const int g_wave){
  const int tid=g_wave*64+lane_id(),lane=tid&63,r32=lane&31,hi=lane>>5; const int wid=__builtin_amdgcn_readfirstlane(tid>>6);
  const long rowbase=(long)b*SEQ; const int q0=qb*QB;
  const bf16*Qw=Q+(rowbase+q0+wid*QBLK)*DM+qcol;
  const bf16*Kh=K+rowbase*DM+qcol,*Vh=V+rowbase*DM+vcol;
  const unsigned lds0=(unsigned)(uintptr_t)shm;
  float*wsf=(float*)(shm+LDS_WS)+wid*64;
  const bf16*ksrc=Kh+(long)lane*DM+wid*8;
  const bf16*vsrc=Vh+(long)(16*(wid&3)+(lane>>2))*DM+(wid>>2)*32+(lane&3)*8;
  const unsigned kdst=lds0+LDS_K+wid*1024, vdst=lds0+LDS_V+wid*1024;
  #define DMA_K(t,slot) glds16(ksrc+(long)(t)*KVBLK*DM,(unsigned)__builtin_amdgcn_readfirstlane(kdst+(slot)))
  #define DMA_V(t,slot) do{ glds16(vsrc+(long)(t)*KVBLK*DM,(unsigned)__builtin_amdgcn_readfirstlane(vdst+2*(slot))); glds16(vsrc+(long)(t)*KVBLK*DM+64,(unsigned)__builtin_amdgcn_readfirstlane(vdst+2*(slot)+8192)); }while(0)
  const int vb0=(int)(lds0+LDS_V)+((lane>>4)&1)*32+(lane&3)*8+(4*hi+((lane&15)>>2))*64;
  const char*Kbase=shm+LDS_K; bf16x8 kf[8];
  const lds_cptr shm3=(lds_cptr)shm; const lds_cptr kp0=shm3+LDS_K+hi*1024+r32*16; const lds_cptr vp0=shm3+LDS_V+((lane>>4)&1)*32+(lane&3)*8+(4*hi+((lane&15)>>2))*64;
  const int NT=(q0+QB)/KVBLK;
  volatile __attribute__((address_space(3))) unsigned*redo=(volatile __attribute__((address_space(3))) unsigned*)((__attribute__((address_space(3))) char*)shm+LDS_BYTES);
  if(FAST&&wid==0&&lane==0)*redo=0u;
  DMA_K(0,0);DMA_V(0,0);DMA_K(1,SLOTB);
  bf16x8 qr[4];
  #pragma unroll
  for(int d0=0;d0<4;++d0)qr[d0]=*reinterpret_cast<const bf16x8*>(&Qw[(long)r32*DM+d0*16+hi*8]);
  float mhat=0.f,l_reg=0.f;f32x16 o[4];o[0]=f32x16{};o[1]=f32x16{};o[2]=f32x16{};o[3]=f32x16{};
  const int qrel=wid*QBLK+r32;
  #define CMASK(P0,P1,t) do{int jb_=(t)-(NT-4); if(jb_>=0)cmask(P0,P1,jb_,qrel,hi);}while(0)
  bool resc=false;
  #define START(P0,P1) do{ resc=false; \
    if constexpr(!FAST){ const float rm=rowmax(P0,P1); const float dl=rm; mhat=fadd_s(mhat,dl); \
      _Pragma("unroll") for(int r=0;r<16;++r){P0[r]=fsub_s(P0[r],dl);P1[r]=fsub_s(P1[r],dl);} \
      } \
    _Pragma("unroll") for(int r=0;r<16;++r)P0[r]=__builtin_amdgcn_exp2f(P0[r]); }while(0)
  #define RESC() do{ if constexpr(!FAST) if(resc){ asm volatile("s_waitcnt lgkmcnt(0)":::"memory"); \
      _Pragma("unroll") for(int d_=0;d_<4;++d_) _Pragma("unroll") for(int r=0;r<16;++r)o[d_][r]*=wsf[crow(r,hi)]; } }while(0)
  f32x16 pA0,pA1,pB0,pB1;
  int sl_prev=0,sl_cur=0,sl_next=SLOTB;
  #define ROT() do{sl_prev=sl_cur;sl_cur=sl_next;sl_next=(sl_next==(NSLOT-1)*SLOTB)?0:sl_next+SLOTB;}while(0)
  DMA_K(2,2*SLOTB);
  WAIT_BAR(4);
  qkt(pA0,pA1,Kbase,qr,r32,hi);asm volatile("s_nop 15\n\ts_nop 7":"+v"(pA0),"+v"(pA1));CMASK(pA0,pA1,0);
  START(pA0,pA1);
  _Pragma("unroll") for(int r=0;r<16;++r)pA1[r]=__builtin_amdgcn_exp2f(pA1[r]);
  WAIT_BAR(0);
  DMA_K(3,0);DMA_V(1,SLOTB);
  ROT();
  kload8(kf,kp0+sl_cur);
  WAIT_BAR(3);
  s16x4 vlo[8],vhi[8]; u32x4 pw0,pw1,pw2,pw3;
  #define PKW(P,B) cvtpk_s(P[B],P[B+1])
  #define PAF(k) __builtin_bit_cast(bf16x8,pw##k)
  #define VFR(i) (bf16x8){vlo[(i)&7][0],vlo[(i)&7][1],vlo[(i)&7][2],vlo[(i)&7][3],vhi[(i)&7][0],vhi[(i)&7][1],vhi[(i)&7][2],vhi[(i)&7][3]}
  #define PIN(x) asm volatile("":"+v"(x))
  #define MX3(a,b,c) __builtin_fmaxf(__builtin_fmaxf((a),(b)),(c))
  #define GAPA(MF,A0,A1,A2,A3,W0,W1,PW) do{ MF; sacc+=A0; sacc+=A1; sacc+=A2; sacc+=A3; PIN(sacc); W0; W1; PIN(PW); SBAR(); }while(0)
  #define EX(v) __builtin_amdgcn_exp2f(v)
  #define GAPB(MF,X,B) do{ MF; if constexpr(FAST){ X[B]=EX(X[B]); X[B+1]=EX(X[B+1]); } else { X[B]=EX(X[B]-mhat); X[B+1]=EX(X[B+1]-mhat); } PIN(X); SBAR(); }while(0)
  #define VRD(i) do{ vlo[(i)&7]=vtr(vp_+(((i)>>2)*4096+((i)&3)*1024)); vhi[(i)&7]=vtr(vp_+(((i)>>2)*4096+((i)&3)*1024+512)); }while(0)
  #define VRDB(i) do{ VRD(i); SBAR(); }while(0)
  #define KRD(G,j) do{ if(G){ kload2(kf,kp0+sl_next,j); SBAR(); } }while(0)
  #define STEP(C0,C1,P0,P1,t,GK,GV,GL) do{ SBAR(); \
    const lds_cptr vp_=vp0+2*sl_prev; \
    VRD(0); SBAR(); float sacc=(P0[0]+P0[1]); \
    GAPA(C0=__builtin_amdgcn_mfma_f32_32x32x16_bf16(kf[0],qr[0],f32x16{},0,0,0), P0[2],P0[3],P0[4],P0[5],     pw0[0]=PKW(P0,0), pw0[1]=PKW(P0,2), pw0); \
    GAPA(C1=__builtin_amdgcn_mfma_f32_32x32x16_bf16(kf[1],qr[0],f32x16{},0,0,0), P0[6],P0[7],P0[8],P0[9],     pw0[2]=PKW(P0,4), pw0[3]=PKW(P0,6), pw0); \
    VRD(1); SBAR(); GAPA(C0=__builtin_amdgcn_mfma_f32_32x32x16_bf16(kf[2],qr[1],C0,0,0,0),   P0[10],P0[11],P0[12],P0[13], pw1[0]=PKW(P0,8), pw1[1]=PKW(P0,10), pw1); \
    GAPA(C1=__builtin_amdgcn_mfma_f32_32x32x16_bf16(kf[3],qr[1],C1,0,0,0),   P0[14],P0[15],P1[0],P1[1],   pw1[2]=PKW(P0,12),pw1[3]=PKW(P0,14), pw1); \
    VRD(2); SBAR(); GAPA(C0=__builtin_amdgcn_mfma_f32_32x32x16_bf16(kf[4],qr[2],C0,0,0,0),   P1[2],P1[3],P1[4],P1[5],     pw2[0]=PKW(P1,0), pw2[1]=PKW(P1,2), pw2); \
    GAPA(C1=__builtin_amdgcn_mfma_f32_32x32x16_bf16(kf[5],qr[2],C1,0,0,0),   P1[6],P1[7],P1[8],P1[9],     pw2[2]=PKW(P1,4), pw2[3]=PKW(P1,6), pw2); \
    VRD(3); SBAR(); GAPA(C0=__builtin_amdgcn_mfma_f32_32x32x16_bf16(kf[6],qr[3],C0,0,0,0),   P1[10],P1[11],P1[12],P1[13], pw3[0]=PKW(P1,8), pw3[1]=PKW(P1,10), pw3); \
    GAPA(C1=__builtin_amdgcn_mfma_f32_32x32x16_bf16(kf[7],qr[3],C1,0,0,0),   P1[14],P1[15],0.f,0.f,       pw3[2]=PKW(P1,12),pw3[3]=PKW(P1,14), pw3); \
    l_reg+=sacc; \
    if(GK){DMA_K((t)+3,sl_cur);} if(GV){DMA_V((t)+1,sl_next);} \
    CMASK(C0,C1,t); \
    if constexpr(!FAST){ float a=MX3(C0[0],C0[1],C1[0]),b=MX3(C0[2],C0[3],C1[1]); a=MX3(a,C1[2],C1[3]); \
      _Pragma("unroll") for(int r=4;r<16;r+=4){a=MX3(a,C0[r],C0[r+1]);b=MX3(b,C0[r+2],C0[r+3]);a=MX3(a,C1[r],C1[r+1]);b=MX3(b,C1[r+2],C1[r+3]);} \
      float rm=__builtin_fmaxf(a,b); { auto rr=__builtin_amdgcn_permlane32_swap(__float_as_uint(rm),__float_as_uint(rm),false,false); rm=__builtin_fmaxf(__uint_as_float(rr[0]),__uint_as_float(rr[1])); } \
      resc=false; const float rel_=rm-mhat;     \
      if(__builtin_expect(__any(rel_>(float)THRL),0)){ const float dl=__builtin_fmaxf(rel_,0.f); mhat+=dl; \
        const float f=__builtin_amdgcn_exp2f(-dl); l_reg*=f; if(hi==0)wsf[r32]=f; resc=true; } } \
    SBAR(); \
      \
    GAPB(o[0]=__builtin_amdgcn_mfma_f32_32x32x16_bf16(PAF(0),VFR(0),o[0],0,0,0), C0,0);   VRDB(4); \
    GAPB(o[0]=__builtin_amdgcn_mfma_f32_32x32x16_bf16(PAF(1),VFR(1),o[0],0,0,0), C0,2);   VRDB(5); \
    GAPB(o[0]=__builtin_amdgcn_mfma_f32_32x32x16_bf16(PAF(2),VFR(2),o[0],0,0,0), C0,4);   VRDB(6); \
    GAPB(o[0]=__builtin_amdgcn_mfma_f32_32x32x16_bf16(PAF(3),VFR(3),o[0],0,0,0), C0,6);   VRDB(7); \
    GAPB(o[1]=__builtin_amdgcn_mfma_f32_32x32x16_bf16(PAF(0),VFR(4),o[1],0,0,0), C0,8);   VRDB(8); \
    GAPB(o[1]=__builtin_amdgcn_mfma_f32_32x32x16_bf16(PAF(1),VFR(5),o[1],0,0,0), C0,10);  VRDB(9); \
    GAPB(o[1]=__builtin_amdgcn_mfma_f32_32x32x16_bf16(PAF(2),VFR(6),o[1],0,0,0), C0,12);  VRDB(10); \
    GAPB(o[1]=__builtin_amdgcn_mfma_f32_32x32x16_bf16(PAF(3),VFR(7),o[1],0,0,0), C0,14);  VRDB(11); \
    GAPB(o[2]=__builtin_amdgcn_mfma_f32_32x32x16_bf16(PAF(0),VFR(8),o[2],0,0,0), C1,0);   VRDB(12); \
    GAPB(o[2]=__builtin_amdgcn_mfma_f32_32x32x16_bf16(PAF(1),VFR(9),o[2],0,0,0), C1,2);   VRDB(13); \
    GAPB(o[2]=__builtin_amdgcn_mfma_f32_32x32x16_bf16(PAF(2),VFR(10),o[2],0,0,0), C1,4);  VRDB(14); \
    GAPB(o[2]=__builtin_amdgcn_mfma_f32_32x32x16_bf16(PAF(3),VFR(11),o[2],0,0,0), C1,6);  VRDB(15); \
    KRD(GL,0); GAPB(o[3]=__builtin_amdgcn_mfma_f32_32x32x16_bf16(PAF(0),VFR(12),o[3],0,0,0), C1,8); \
    KRD(GL,1); GAPB(o[3]=__builtin_amdgcn_mfma_f32_32x32x16_bf16(PAF(1),VFR(13),o[3],0,0,0), C1,10); \
    KRD(GL,2); GAPB(o[3]=__builtin_amdgcn_mfma_f32_32x32x16_bf16(PAF(2),VFR(14),o[3],0,0,0), C1,12); \
    KRD(GL,3); GAPB(o[3]=__builtin_amdgcn_mfma_f32_32x32x16_bf16(PAF(3),VFR(15),o[3],0,0,0), C1,14); \
    }while(0)
  int t=1;
  #undef CMASK
  #define CMASK(P0,P1,t) do{}while(0)
  for(;t+5<NT;t+=2){
    STEP(pB0,pB1,pA0,pA1,t,true,true,true);     WAIT_BAR(3); RESC(); ROT();
    STEP(pA0,pA1,pB0,pB1,t+1,true,true,true);   WAIT_BAR(3); RESC(); ROT();
  }
  #undef CMASK
  #define CMASK(P0,P1,t) do{int jb_=(t)-(NT-4); if(jb_>=0)cmask(P0,P1,jb_,qrel,hi);}while(0)
  #define ENDW(tt) do{ if((tt)+3<NT){WAIT_BAR(3);} else if((tt)+2<NT){WAIT_BAR(2);} else {WAIT_BAR(0);} }while(0)
  for(;t+1<NT;t+=2){
    STEP(pB0,pB1,pA0,pA1,t,(t+3<NT),(t+1<NT),(t+1<NT));       ENDW(t);   RESC(); ROT();
    STEP(pA0,pA1,pB0,pB1,t+1,(t+4<NT),(t+2<NT),(t+2<NT));     ENDW(t+1); RESC(); ROT();
  }
  STEP(pB0,pB1,pA0,pA1,NT-1,false,false,false); RESC();
  { float sacc=pB0[0]+pB0[1]; _Pragma("unroll") for(int r=2;r<16;++r)sacc+=pB0[r]; _Pragma("unroll") for(int r=0;r<16;++r)sacc+=pB1[r]; l_reg+=sacc;
    pw0=(u32x4){PKW(pB0,0),PKW(pB0,2),PKW(pB0,4),PKW(pB0,6)};pw1=(u32x4){PKW(pB0,8),PKW(pB0,10),PKW(pB0,12),PKW(pB0,14)};pw2=(u32x4){PKW(pB1,0),PKW(pB1,2),PKW(pB1,4),PKW(pB1,6)};pw3=(u32x4){PKW(pB1,8),PKW(pB1,10),PKW(pB1,12),PKW(pB1,14)};
    SBAR(); pv(o,vb0+2*sl_cur,PAF(0),PAF(1),PAF(2),PAF(3)); }
  #undef PKW
  #undef PAF
  #undef VFR
  #undef PIN
  #undef MX3
  #undef GAPA
  #undef GAPB
  #undef EX
  #undef VRD
  #undef VRDB
  #undef KRD
  #undef STEP
  #undef ENDW
  {auto rr=__builtin_amdgcn_permlane32_swap(__float_as_uint(l_reg),__float_as_uint(l_reg),false,false);l_reg=__uint_as_float(rr[0])+__uint_as_float(rr[1]);}
  if(FAST){ if(__any(!(l_reg>1e-30f&&l_reg<1e30f))&&lane==0)*redo=1u; }
  if(hi==0)wsf[32+r32]=l_reg;asm volatile("s_waitcnt lgkmcnt(0)":::"memory");
  float rli[16];
  #pragma unroll
  for(int r=0;r<16;++r)rli[r]=__builtin_amdgcn_rcpf(wsf[32+crow(r,hi)]);
  bf16*Ow=O+(rowbase+q0+wid*QBLK)*DM+vcol;
  { bf16*stg=(bf16*)(shm+LDS_OST)+wid*2048;
    #pragma unroll
    for(int ps=0;ps<2;++ps){
      #pragma unroll
      for(int r=0;r<16;++r){const int orow=crow(r,hi);
        #pragma unroll
        for(int d0=0;d0<2;++d0)stg[orow*64+d0*32+r32]=__float2bfloat16(o[2*ps+d0][r]*rli[r]);}
      asm volatile("s_waitcnt lgkmcnt(0)":::"memory");
      #pragma unroll
      for(int i=0;i<4;++i){const int row=i*8+(lane>>3),ch=lane&7; const u32x4 v=*(const u32x4*)(stg+row*64+ch*8); ATTN_STORE16(Ow+(long)row*DM+ps*64+ch*8,v);}
      asm volatile("s_waitcnt lgkmcnt(0)":::"memory"); } }
  asm volatile("s_waitcnt lgkmcnt(0)\n\ts_barrier":::"memory");
  bool again=false;
  if(FAST){ again=(*redo!=0u); asm volatile("s_waitcnt lgkmcnt(0)\n\ts_barrier":::"memory"); }
  #undef DMA_K
  #undef DMA_V
  #undef CMASK
  #undef START
  #undef RESC
  #undef ROT
  return again;
}
constexpr int ATTN_LDS_BYTES=LDS_BYTES;
struct AttnTensors { const bf16* Q; const bf16* K; const bf16* V; bf16* O1; bf16* O2; };
#undef SBAR
#undef WAIT_BAR
}
#define GAS __attribute__((address_space(1)))
#define LAS __attribute__((address_space(3)))
typedef unsigned short bf16;
typedef unsigned v4u __attribute__((ext_vector_type(4)));
typedef float f32x4 __attribute__((ext_vector_type(4)));
typedef short bf16x8 __attribute__((ext_vector_type(8)));
typedef GAS unsigned gu32;
typedef GAS unsigned long long gu64;
#define RLX_AGENT __ATOMIC_RELAXED, __HIP_MEMORY_SCOPE_AGENT
#define LDS_WAIT() asm volatile("s_waitcnt lgkmcnt(0)" ::: "memory")
#define VM_WAIT() asm volatile("s_waitcnt vmcnt(0)" ::: "memory")
__device__ __forceinline__ unsigned long long rt() { return __builtin_amdgcn_s_memrealtime(); }
__device__ __forceinline__ unsigned f2bf(float f) { unsigned u = __builtin_bit_cast(unsigned, f); return (u + 0x7fffu + ((u >> 16) & 1u)) >> 16; }
__device__ __forceinline__ unsigned pk2(float lo, float hi) { return f2bf(lo) | (f2bf(hi) << 16); }
#define XB_TMO      128
#define XB_XCNT(j)  (256  + 64 * (j))
#define XB_XSUB(j)  (1280 + 64 * (j))
#define XB_XGEN(j)  (2304 + 64 * (j))
#define XB_TOP      3328
#define XB_TOPGEN   3392
#define XCD_BAR_WORDS 3456
#define XB_SPIN_CAP (1u << 18)

__device__ __forceinline__ unsigned xb_ld(unsigned* p)              { return __hip_atomic_load(p, __ATOMIC_RELAXED, __HIP_MEMORY_SCOPE_AGENT); }
__device__ __forceinline__ unsigned xb_add(unsigned* p, unsigned v) { return __hip_atomic_fetch_add(p, v, __ATOMIC_RELAXED, __HIP_MEMORY_SCOPE_AGENT); }
__device__ __forceinline__ unsigned xb_xcc_id() { return (unsigned)__builtin_amdgcn_s_getreg((3 << 11) | 20) & 0xFu; }
#define XB_SPIN(cond, bar) do { unsigned _sp = 0; while (cond) { __builtin_amdgcn_s_sleep(1); \
    if ((++_sp & 255u) == 0u) { if (xb_ld(&(bar)[XB_TMO])) break; if (_sp > XB_SPIN_CAP) { atomicAdd(&(bar)[XB_TMO], 1u); break; } } } } while (0)

struct XcdBarrier {
    unsigned* bar; unsigned x; int wave;
    volatile LAS unsigned* st;
};

__device__ __forceinline__ XcdBarrier xcd_barrier_post(unsigned* bar, volatile LAS unsigned* st, const int g_wave) {
    XcdBarrier b; b.bar = bar; b.x = xb_xcc_id(); b.st = st; b.wave = g_wave;
    if (g_wave == 0 && lane_id() == 0) (void)xb_add(&bar[XB_XCNT(b.x)], 1u);
    return b;
}
__device__ __forceinline__ void xcd_barrier_complete(unsigned* bar, unsigned x, unsigned& nloc, unsigned& nx) {
    const unsigned G = gridDim.x * gridDim.y * gridDim.z;
    unsigned sum, cnt, mine, sp = 0u;
    for (;;) {
        sum = 0u; cnt = 0u; mine = 0u;
#pragma unroll
        for (unsigned j = 0; j < 16; ++j) { const unsigned c = xb_ld(&bar[XB_XCNT(j)]); sum += c; cnt += (c > 0u) ? 1u : 0u; mine = (j == x) ? c : mine; }
        if (sum == G) break;
        __builtin_amdgcn_s_sleep(1);
        if ((++sp & 255u) == 0u) { if (xb_ld(&bar[XB_TMO])) break; if (sp > XB_SPIN_CAP) { atomicAdd(&bar[XB_TMO], 1u); break; } }
    }
    nloc = mine > 0u ? mine : 1u; nx = cnt > 0u ? cnt : 1u;
}

__device__ __forceinline__ void xcd_barrier(const XcdBarrier& b) {
    asm volatile("s_waitcnt vmcnt(0)" ::: "memory");
    __syncthreads();
    if (b.wave == 0 && lane_id() == 0) {
        unsigned* bar = b.bar;
        __builtin_amdgcn_s_waitcnt(0);
        unsigned nloc = b.st[0], nx = b.st[1];
        if (nloc == 0u) { xcd_barrier_complete(bar, b.x, nloc, nx); b.st[0] = nloc; b.st[1] = nx; }
        const unsigned old = xb_add(&bar[XB_XSUB(b.x)], 1u);
        const unsigned gen = old / nloc;
        if (old + 1u == (gen + 1u) * nloc) {
            __builtin_amdgcn_fence(__ATOMIC_RELEASE, "agent");
            asm volatile("s_waitcnt vmcnt(0)" ::: "memory");
            const unsigned og = xb_add(&bar[XB_TOP], 1u);
            const unsigned tg = og / nx;
            if (og + 1u == (tg + 1u) * nx) xb_add(&bar[XB_TOPGEN], 1u);
            else XB_SPIN(xb_ld(&bar[XB_TOPGEN]) == tg, bar);
            __builtin_amdgcn_fence(__ATOMIC_ACQUIRE, "agent");
            xb_add(&bar[XB_XGEN(b.x)], 1u);
            asm volatile("s_waitcnt vmcnt(0)" ::: "memory");
        } else {
            XB_SPIN(xb_ld(&bar[XB_XGEN(b.x)]) == gen, bar);
            __builtin_amdgcn_fence(__ATOMIC_ACQUIRE, "agent");
            asm volatile("s_waitcnt vmcnt(0)" ::: "memory");
        }
    }
    __syncthreads();
}
__device__ __forceinline__ void xcd_arrive(unsigned* ctl, const int wstage, const int wtotal, const unsigned x, const unsigned nloc) {
    const unsigned old = xb_add(ctl + wstage + 64 * x, 1u);
    if (old + 1u == nloc) { __builtin_amdgcn_fence(__ATOMIC_RELEASE, "agent"); asm volatile("s_waitcnt vmcnt(0)" ::: "memory"); (void)xb_add(ctl + wtotal, nloc); }
}
constexpr size_t MiB = 1u << 20;
constexpr size_t WS_CTL = 0, CTL_ZERO_BYTES = 64 * 1024;
constexpr size_t WS_WIN = 2 * MiB;
constexpr size_t WS_WPW = 10 * MiB;
constexpr size_t WS_WOUT = 11 * MiB;
constexpr size_t WS_XN = 16 * MiB;
constexpr size_t WS_Q = 52 * MiB, WS_K = 70 * MiB, WS_V = 88 * MiB, WS_GA = 106 * MiB, WS_GC = 124 * MiB;
constexpr size_t WS_U = 142 * MiB;
constexpr size_t WS_C = 186 * MiB;
constexpr size_t WS_O1 = 204 * MiB, WS_O2 = 220 * MiB;
constexpr size_t WS_M = 236 * MiB;
constexpr size_t WS_PART = 272 * MiB;
constexpr size_t WS_MIX = 288 * MiB;
constexpr size_t WS_END = 320 * MiB;
static_assert(WS_XN + (size_t)MT * 1024 * 2 <= WS_Q && WS_Q + (size_t)MT * 512 * 2 <= WS_K && WS_U + (size_t)U_ROWS * 512 * 4 <= WS_C && WS_C + (size_t)MT * 512 * 2 <= WS_O1 && WS_M + (size_t)MT * 1024 * 2 <= WS_END, "d_ws map");
constexpr int CW_XCONV = 8192 + 64 * 8, CW_XATTN = 8192 + 64 * 24;
constexpr int CW_CONV = 8192 + 64 * 4, CW_ATTN = 8192 + 64 * 5, CW_TICKET = 8192 + 64 * 6;
constexpr int CW_PCNT = 6656, CW_PQ = 0, CW_PTAIL = 8192 + 64 * 62, CW_PHEAD = 8192 + 64 * 63;
constexpr int CW_PAIR = 12288;
constexpr int CW_QUEUE = 4608, CW_QTAIL = 8192 + 64 * 60, CW_QHEAD = 8192 + 64 * 61;
constexpr int CW_SROW = 8192;
constexpr int CW_BAR = 1024;
__device__ __forceinline__ void panel_post(unsigned* ctl, const int pm) {
    if (xb_add(ctl + CW_PCNT + 16 * pm, 1u) == 5u) { const unsigned j = xb_add(ctl + CW_PTAIL, 4u);
#pragma unroll
        for (unsigned pn = 0; pn < 4; ++pn) __hip_atomic_store(ctl + CW_PQ + 4 * ((j + pn) & 255u), (unsigned)pm * 4u + pn + 1u, RLX_AGENT); }
}
constexpr int NWAVES = 8;
constexpr int RING_OFF = 0, RING_BYTES = 131072;
constexpr int LDSCTL_OFF = RING_BYTES, MISC_OFF = LDSCTL_OFF + 320;
constexpr int LDS_BYTES = 147456;

struct Frame {
    LAS unsigned char* lds;
    volatile LAS unsigned* MISC;
    gu32* ctl;
    int wave;
    int vcu, G;
};
struct Args { const float* in[21]; float* out; unsigned char* ws; };
#define WSP(T, off) ((T*)(A.ws + (off)))
template <int CTRL> __device__ __forceinline__ float dppf(float x) { return __builtin_bit_cast(float, __builtin_amdgcn_mov_dpp(__builtin_bit_cast(int, x), CTRL, 0xf, 0xf, true)); }
__device__ __forceinline__ float xrow_sum(float x) {
    auto a = __builtin_amdgcn_permlane16_swap(__float_as_uint(x), __float_as_uint(x), false, false); x = __uint_as_float(a[0]) + __uint_as_float(a[1]);
    auto b = __builtin_amdgcn_permlane32_swap(__float_as_uint(x), __float_as_uint(x), false, false); return __uint_as_float(b[0]) + __uint_as_float(b[1]); }
__device__ __forceinline__ float xrow_max(float x) {
    auto a = __builtin_amdgcn_permlane16_swap(__float_as_uint(x), __float_as_uint(x), false, false); x = fmaxf(__uint_as_float(a[0]), __uint_as_float(a[1]));
    auto b = __builtin_amdgcn_permlane32_swap(__float_as_uint(x), __float_as_uint(x), false, false); return fmaxf(__uint_as_float(b[0]), __uint_as_float(b[1])); }
__device__ __forceinline__ float row16_sum(float v) {
    v += dppf<0xB1>(v); v += dppf<0x4E>(v); v += dppf<0x141>(v); v += dppf<0x140>(v); return v; }
__device__ __forceinline__ float wave_sum(float v) { return xrow_sum(row16_sum(v)); }
__device__ __forceinline__ void p0_transpose_item(const float* W, int K, int N, bf16* WT, int k0, int n0, int dst0, LAS float* scr, int lane) {
#pragma unroll 8
    for (int i = 0; i < 32; ++i) { const int kk = 2 * i + (lane >> 5); scr[kk * 33 + (lane & 31)] = W[(size_t)(k0 + kk) * N + n0 + (lane & 31)]; }
    LDS_WAIT(); asm volatile("" ::: "memory");
    const int c = lane & 7;
#pragma unroll
    for (int j = 0; j < 4; ++j) { const int n = (lane >> 3) + 8 * j; const LAS float* s = scr + (8 * c) * 33 + n;
        v4u o; o.x = pk2(s[0 * 33], s[1 * 33]); o.y = pk2(s[2 * 33], s[3 * 33]); o.z = pk2(s[4 * 33], s[5 * 33]); o.w = pk2(s[6 * 33], s[7 * 33]);
        *(GAS v4u*)(WT + (size_t)(dst0 + n) * K + k0 + 8 * c) = o; }
    LDS_WAIT(); asm volatile("" ::: "memory");
}
__device__ __forceinline__ int win_dst_row(int n0) {
    if (n0 < 2048 || n0 >= 3072) return n0;
    int j = n0 - 2048; const int isb = j >= 512; if (isb) j -= 512;
    return 2048 + 256 * (j >> 7) + 128 * isb + (j & 127);
}
__device__ __forceinline__ void rms_row_to_bf16(const float* xrow, const f32x4 (&gv)[4], bf16* orow, int lane) {
    const GAS f32x4* xr = (const GAS f32x4*)xrow + lane;
    f32x4 v[4]; float s = 0.f;
#pragma unroll
    for (int j = 0; j < 4; ++j) { v[j] = xr[64 * j]; s += (v[j].x * v[j].x + v[j].y * v[j].y) + (v[j].z * v[j].z + v[j].w * v[j].w); }
    const float rs = 1.0f / sqrtf(wave_sum(s) * (1.f / D_MODEL) + EPS);
    GAS unsigned long long* o8 = (GAS unsigned long long*)orow + lane;
#pragma unroll
    for (int j = 0; j < 4; ++j) o8[64 * j] = (unsigned long long)pk2(v[j].x * rs * gv[j].x, v[j].y * rs * gv[j].y) | ((unsigned long long)pk2(v[j].z * rs * gv[j].z, v[j].w * rs * gv[j].w) << 32);
}
__device__ __forceinline__ void p0_prologue(Frame& F, const Args& A) {
    const float *w_in = A.in[7], *w_pw2 = A.in[17], *w_out = A.in[19], *xp = A.in[0], *xs = A.in[1]; bf16 *Win_t = WSP(bf16, WS_WIN), *Wpw_t = WSP(bf16, WS_WPW), *Wout_t = WSP(bf16, WS_WOUT), *XN = WSP(bf16, WS_XN);
    LAS float* scr = (LAS float*)(F.lds + RING_OFF + F.wave * 16384);
    const int gw = F.vcu * NWAVES + F.wave, NGW = F.G * NWAVES;
    constexpr int I_IN = (1024 / 64) * (D_IN / 32), I_PW = (512 / 64) * (512 / 32), I_OUT = (1024 / 64) * (1024 / 32);
    f32x4 gv[4];
#pragma unroll
    for (int j = 0; j < 4; ++j) gv[j] = *((const f32x4*)A.in[6] + lane_id() + 64 * j);
#pragma nounroll
    for (int ph = 0; ph < 2; ++ph) {
    if (((F.wave & 1) != 0) == (ph != 0)) {
    for (int it = gw; it < I_IN + I_PW + I_OUT; it += NGW) {
        int r = it;
        if (r < I_IN) { const int nblk = D_IN / 32, kb = r / nblk, nb = r % nblk; p0_transpose_item(w_in, 1024, D_IN, Win_t, 64 * kb, 32 * nb, win_dst_row(32 * nb), scr, lane_id()); continue; } r -= I_IN;
        if (r < I_PW) { const int kb = r / 16, nb = r % 16; p0_transpose_item(w_pw2, 512, 512, Wpw_t, 64 * kb, 32 * nb, 32 * nb, scr, lane_id()); continue; } r -= I_PW;
        { const int kb = r / 32, nb = r % 32; p0_transpose_item(w_out, 1024, 1024, Wout_t, 64 * kb, 32 * nb, 32 * nb, scr, lane_id()); }
    }
    { bf16* U = WSP(bf16, WS_U); const float* state = A.in[4];
      for (int r = gw; r < NBATCH * HIST + DEC_B * HIST; r += NGW) { f32x4 v0 = {0.f, 0.f, 0.f, 0.f}, v1 = v0; size_t dst;
          if (r < NBATCH * HIST) dst = (size_t)((r / HIST) * UP_SEQ + r % HIST) * 512;
          else { const int q = r - NBATCH * HIST, b = q / HIST, i = q % HIST; dst = (size_t)(USMP0 + b * US_SEQ + i) * 512; v0 = *(const f32x4*)(state + (size_t)q * 512 + 8 * lane_id()); v1 = *(const f32x4*)(state + (size_t)q * 512 + 8 * lane_id() + 4); }
          v4u w; w.x = pk2(v0[0], v0[1]); w.y = pk2(v0[2], v0[3]); w.z = pk2(v1[0], v1[1]); w.w = pk2(v1[2], v1[3]);
          *(v4u*)(U + dst + 8 * lane_id()) = w; } }
    } else
    { const int lane = lane_id();
      for (int grp = NGW - 1 - gw; grp < MT / 4; grp += NGW) {
          const int m0 = 4 * grp; const float* xb = m0 < MP ? xp + (size_t)m0 * D_MODEL : xs + (size_t)(m0 - MP) * D_MODEL;
          f32x4 v[4][4];
#pragma unroll
          for (int r = 0; r < 4; ++r)
#pragma unroll
              for (int j = 0; j < 4; ++j) v[r][j] = *((const GAS f32x4*)(xb + (size_t)r * D_MODEL) + lane + 64 * j);
#pragma unroll
          for (int r = 0; r < 4; ++r) { float ss = 0.f;
#pragma unroll
              for (int j = 0; j < 4; ++j) ss += (v[r][j].x * v[r][j].x + v[r][j].y * v[r][j].y) + (v[r][j].z * v[r][j].z + v[r][j].w * v[r][j].w);
              const float rs = 1.0f / sqrtf(wave_sum(ss) * (1.f / D_MODEL) + EPS);
              GAS unsigned long long* o8 = (GAS unsigned long long*)(XN + (size_t)(m0 + r) * D_MODEL) + lane;
#pragma unroll
              for (int j = 0; j < 4; ++j) o8[64 * j] = (unsigned long long)pk2(v[r][j].x * rs * gv[j].x, v[r][j].y * rs * gv[j].y) | ((unsigned long long)pk2(v[r][j].z * rs * gv[j].z, v[r][j].w * rs * gv[j].w) << 32); } } }
    }
}
__device__ __forceinline__ float compute_lam(Frame& F, const Args& A) {
    const float a = wave_sum(A.in[8][lane_id()] * A.in[9][lane_id()]), b = wave_sum(A.in[10][lane_id()] * A.in[11][lane_id()]);
    return __builtin_bit_cast(float, __builtin_amdgcn_readfirstlane(__builtin_bit_cast(int, expf(a) - expf(b) + 0.2f)));
}
__device__ __forceinline__ void conv_phase(Frame& F, const Args& A) {
    int tid_ = F.wave * 64 + lane_id(); asm volatile("" : "+v"(tid_)); const int lane = tid_ & 63, wave = __builtin_amdgcn_readfirstlane(tid_ >> 6);
    const bf16* U = WSP(bf16, WS_U); float* out = A.out; bf16* Cb = WSP(bf16, WS_C);
    LAS float* wl = (LAS float*)(F.lds + RING_OFF);
    for (int i = tid_; i < CONV_W * 512; i += NWAVES * 64) wl[i] = A.in[13][i];
    __syncthreads();
    const int gw = F.vcu * NWAVES + wave, NGW = F.G * NWAVES;
    for (int k = 0; k < 3; ++k) {
        const int task = k < 2 ? gw + k * NGW : (wave == 0 ? MP / 4 + F.vcu : MP / 4 + 2 * DEC_B);
        if (task >= (k < 2 ? MP / 4 : MP / 4 + 2 * DEC_B)) continue;
        int rowbase, urow0;
        if (task < MP / 4) { const int b = task >> 11, t0 = (task & 2047) * 4; rowbase = b * SEQ + t0; urow0 = b * UP_SEQ + t0; }
        else { const int q = task - MP / 4, b = q >> 1, hf = q & 1; rowbase = MP + b * 8 + 4 * hf; urow0 = USMP0 + b * US_SEQ + 4 * hf; }
        const bf16* up = U + (size_t)urow0 * 512; const int lo = 8 * lane;
        f32x4 acc[4][2];
        { const f32x4 c0 = *(const f32x4*)(A.in[14] + 8 * lane), c1 = *(const f32x4*)(A.in[14] + 8 * lane + 4);
#pragma unroll
            for (int r = 0; r < 4; ++r) { acc[r][0] = c0; acc[r][1] = c1; } }
        f32x4 W[4][2]; v4u ubuf[4][4];
#define CONV_NS 34
#define CONV_LOAD(dst, s_) do { if ((s_) < CONV_NS) { const bf16* src_ = up + (size_t)(s_) * 512;   (dst) = *(const v4u*)(src_ + lo); } } while (0)
#define CONV_FMA(s_, r_, uu) do { if ((s_) - (r_) >= 0 && (s_) - (r_) < CONV_W) { acc[r_][0] += W[((s_) - (r_)) & 3][0] * (uu)[0]; acc[r_][1] += W[((s_) - (r_)) & 3][1] * (uu)[1]; } } while (0)
#define CONV_STEP(s_, uw) do { if ((s_) < CONV_NS) { f32x4 uu[2]; uu[0][0] = __uint_as_float((uw).x << 16); uu[0][1] = __uint_as_float((uw).x & 0xffff0000u); uu[0][2] = __uint_as_float((uw).y << 16); uu[0][3] = __uint_as_float((uw).y & 0xffff0000u); \
        uu[1][0] = __uint_as_float((uw).z << 16); uu[1][1] = __uint_as_float((uw).z & 0xffff0000u); uu[1][2] = __uint_as_float((uw).w << 16); uu[1][3] = __uint_as_float((uw).w & 0xffff0000u); if ((s_) < CONV_W) { W[(s_) & 3][0] = *(const LAS f32x4*)(wl + (s_) * 512 + 8 * lane); W[(s_) & 3][1] = *(const LAS f32x4*)(wl + (s_) * 512 + 8 * lane + 4); } \
        CONV_FMA(s_, 0, uu); CONV_FMA(s_, 1, uu); CONV_FMA(s_, 2, uu); CONV_FMA(s_, 3, uu); } } while (0)
#define CONV_GROUP(gq) do { CONV_LOAD(ubuf[((gq) + 3) & 3][0], 4 * (gq) + 12); CONV_LOAD(ubuf[((gq) + 3) & 3][1], 4 * (gq) + 13); CONV_LOAD(ubuf[((gq) + 3) & 3][2], 4 * (gq) + 14); CONV_LOAD(ubuf[((gq) + 3) & 3][3], 4 * (gq) + 15); \
        CONV_STEP(4 * (gq), ubuf[(gq) & 3][0]); CONV_STEP(4 * (gq) + 1, ubuf[(gq) & 3][1]); CONV_STEP(4 * (gq) + 2, ubuf[(gq) & 3][2]); CONV_STEP(4 * (gq) + 3, ubuf[(gq) & 3][3]); asm volatile("" ::: "memory"); } while (0)
        CONV_LOAD(ubuf[0][0], 0); CONV_LOAD(ubuf[0][1], 1); CONV_LOAD(ubuf[0][2], 2); CONV_LOAD(ubuf[0][3], 3); CONV_LOAD(ubuf[1][0], 4); CONV_LOAD(ubuf[1][1], 5); CONV_LOAD(ubuf[1][2], 6); CONV_LOAD(ubuf[1][3], 7);
        CONV_LOAD(ubuf[2][0], 8); CONV_LOAD(ubuf[2][1], 9); CONV_LOAD(ubuf[2][2], 10); CONV_LOAD(ubuf[2][3], 11);
        CONV_GROUP(0); CONV_GROUP(1); CONV_GROUP(2); CONV_GROUP(3); CONV_GROUP(4); CONV_GROUP(5); CONV_GROUP(6); CONV_GROUP(7); CONV_GROUP(8);
#undef CONV_LOAD
#undef CONV_FMA
#undef CONV_STEP
#undef CONV_GROUP
        const f32x4 lg0 = *(const f32x4*)(A.in[15] + 8 * lane), lg1 = *(const f32x4*)(A.in[15] + 8 * lane + 4), lb0 = *(const f32x4*)(A.in[16] + 8 * lane), lb1 = *(const f32x4*)(A.in[16] + 8 * lane + 4);
#pragma unroll
        for (int r = 0; r < 4; ++r) {
            const f32x4 a0 = acc[r][0], a1 = acc[r][1];
            const float s1 = wave_sum(((a0[0] + a0[1]) + (a0[2] + a0[3])) + ((a1[0] + a1[1]) + (a1[2] + a1[3])));
            const float s2 = wave_sum(((a0[0] * a0[0] + a0[1] * a0[1]) + (a0[2] * a0[2] + a0[3] * a0[3])) + ((a1[0] * a1[0] + a1[1] * a1[1]) + (a1[2] * a1[2] + a1[3] * a1[3])));
            const float mean = s1 * (1.f / 512.f), var = fmaxf(s2 * (1.f / 512.f) - mean * mean, 0.f), rstd = 1.0f / sqrtf(var + EPS);
            f32x4 y0 = (a0 - mean) * rstd * lg0 + lb0, y1 = (a1 - mean) * rstd * lg1 + lb1;
#pragma unroll
            for (int i = 0; i < 4; ++i) { y0[i] = pg8::silu_f(y0[i]); y1[i] = pg8::silu_f(y1[i]); }
            *(pg8::u32x4*)(Cb + (size_t)(rowbase + r) * 512 + 8 * lane) = pg8::pack8(y0, y1);
        }
    }
    const float* state = A.in[4]; const int gt = F.vcu * 512 + tid_, GT = F.G * 512;
    for (int i = gt; i < DEC_B * (HIST - DEC_S) * 512; i += GT) { const int b = i / ((HIST - DEC_S) * 512), rem = i - b * ((HIST - DEC_S) * 512); out[OFF_CS + (size_t)b * HIST * 512 + rem] = state[(size_t)(b * HIST + DEC_S) * 512 + rem]; }
}
typedef float f32x4v __attribute__((ext_vector_type(4))); typedef float f32x2w __attribute__((ext_vector_type(2)));
constexpr float DEC_THR = 8.0f;
__device__ __forceinline__ void decode_items(Frame& F, const Args& A, const int item_first, const int item_end) {
    const GAS float *ck = (const GAS float*)A.in[2], *cv = (const GAS float*)A.in[3], *subln = (const GAS float*)A.in[12]; const GAS int* pt = (const GAS int*)A.in[5]; const GAS float* outf = (const GAS float*)A.out; GAS unsigned char* wsb = (GAS unsigned char*)A.ws;
    asm volatile("" : "+s"(ck), "+s"(cv), "+s"(subln), "+s"(pt), "+s"(outf), "+s"(wsb));
    const GAS bf16 *Qb = (const GAS bf16*)(wsb + WS_Q), *GAb = (const GAS bf16*)(wsb + WS_GA); GAS bf16* Mb = (GAS bf16*)(wsb + WS_M);
    int tid_ = F.wave * 64 + lane_id(); asm volatile("" : "+v"(tid_)); const int lane = tid_ & 63, wave = __builtin_amdgcn_readfirstlane(tid_ >> 6), c16 = lane & 15, g = lane >> 4;
    LAS float* Om = (LAS float*)(F.lds + RING_OFF);
    LAS float* ML = (LAS float*)(F.lds + RING_OFF + 65536);
    for (int item = item_first; item < item_end; item += F.G) {
        const int b = item >> 2, h = item & 3;
        bf16x8 qf[4];
        { const int qi = c16 & 7, mp = c16 >> 3; const GAS bf16* qrow = Qb + (size_t)(MP + b * DEC_S + qi) * 512 + h * 128 + mp * 64 + 4 * g;
            typedef unsigned u32x2 __attribute__((ext_vector_type(2)));
            const u32x2 a0 = *(const GAS u32x2*)(qrow), a1 = *(const GAS u32x2*)(qrow + 16), b0 = *(const GAS u32x2*)(qrow + 32), b1 = *(const GAS u32x2*)(qrow + 48);
            const v4u fa = {a0.x, a0.y, a1.x, a1.y}, fb = {b0.x, b0.y, b1.x, b1.y}, z = {0u, 0u, 0u, 0u};
            qf[0] = __builtin_bit_cast(bf16x8, mp ? z : fa); qf[1] = __builtin_bit_cast(bf16x8, mp ? z : fb);
            qf[2] = __builtin_bit_cast(bf16x8, mp ? fa : z); qf[3] = __builtin_bit_cast(bf16x8, mp ? fb : z); }
        LAS bf16x8* qlds = (LAS bf16x8*)(F.lds + RING_OFF + 73728 + wave * 4096) + lane;
#pragma unroll
        for (int kk = 0; kk < 4; ++kk) qlds[64 * kk] = qf[kk];
        const int ph0 = __builtin_amdgcn_readfirstlane(pt[b * NPAGES + 2 * wave]), ph1 = __builtin_amdgcn_readfirstlane(pt[b * NPAGES + 2 * wave + 1]);
        f32x4v acc[2][4];
#pragma unroll
        for (int jj = 0; jj < 2; ++jj)
#pragma unroll
            for (int rr = 0; rr < 4; ++rr) acc[jj][rr] = (f32x4v){0.f, 0.f, 0.f, 0.f};
        float mref = -INFINITY, lsum = 0.f;
        const int kperm = 4 * (4 * c16 + g);
        f32x4v KA[8], VA[8], KB[8], VB[8];
#define DEC_ISSUE_K(KX, tt_) do { const int pg_ = (tt_) < 8 ? ph0 : ph1; const size_t tb_ = ((size_t)pg_ * 128 + ((tt_) & 7) * 16) * 512 + h * 128; \
        const GAS float* kp_ = ck + tb_ + (size_t)(lane >> 2) * 512 + 4 * (lane & 3); \
        _Pragma("unroll") for (int j_ = 0; j_ < 8; ++j_) KX[j_] = (*(const GAS f32x4v*)(kp_ + 16 * j_)); } while (0)
#define DEC_ISSUE_V(VX, tt_) do { const int pg_ = (tt_) < 8 ? ph0 : ph1; const size_t tb_ = ((size_t)pg_ * 128 + ((tt_) & 7) * 16) * 512 + h * 128; \
        const GAS float* vp_ = cv + tb_ + (size_t)(4 * g) * 512 + 4 * c16; \
        _Pragma("unroll") for (int r_ = 0; r_ < 4; ++r_) { VX[2 * r_] = (*(const GAS f32x4v*)(vp_ + r_ * 512)); VX[2 * r_ + 1] = (*(const GAS f32x4v*)(vp_ + r_ * 512 + 64)); } } while (0)
#define DEC_TILE(KX, VX, MASKED, NEXT_OK, tn_) do { \
        bf16x8 ka_[4]; \
        _Pragma("unroll") for (int kk_ = 0; kk_ < 4; ++kk_) { const v4u w_ = {attn128::cvtpk_s(KX[2 * kk_][0], KX[2 * kk_][1]), attn128::cvtpk_s(KX[2 * kk_][2], KX[2 * kk_][3]), attn128::cvtpk_s(KX[2 * kk_ + 1][0], KX[2 * kk_ + 1][1]), attn128::cvtpk_s(KX[2 * kk_ + 1][2], KX[2 * kk_ + 1][3])}; v4u x_; _Pragma("unroll") for (int e_ = 0; e_ < 4; ++e_) x_[e_] = (unsigned)__builtin_amdgcn_ds_bpermute(kperm, (int)w_[e_]); ka_[kk_] = __builtin_bit_cast(bf16x8, x_); } \
        if (NEXT_OK) DEC_ISSUE_K(KX, tn_); \
        f32x4v s_ = {0.f, 0.f, 0.f, 0.f}; \
        _Pragma("unroll") for (int kk_ = 0; kk_ < 4; ++kk_) s_ = __builtin_amdgcn_mfma_f32_16x16x32_bf16(ka_[kk_], qlds[64 * kk_], s_, 0, 0, 0); \
        if (MASKED) { const int qi_ = c16 & 7; _Pragma("unroll") for (int r_ = 0; r_ < 4; ++r_) if (4 * g + r_ > qi_) s_[r_] = -INFINITY; } \
        float tm_ = fmaxf(fmaxf(s_[0], s_[1]), fmaxf(s_[2], s_[3])); tm_ = xrow_max(tm_); \
        if (__any(tm_ > mref + DEC_THR)) { const float mn_ = fmaxf(mref, tm_), al_ = __builtin_amdgcn_exp2f(mref - mn_); mref = mn_; lsum *= al_; \
            _Pragma("unroll") for (int jj_ = 0; jj_ < 2; ++jj_) _Pragma("unroll") for (int rr_ = 0; rr_ < 4; ++rr_) acc[jj_][rr_] *= al_; } \
        float p_[4]; \
        _Pragma("unroll") for (int r_ = 0; r_ < 4; ++r_) { p_[r_] = __builtin_amdgcn_exp2f(s_[r_] - mref); lsum += p_[r_]; } \
        const v4u pb_ = {attn128::cvtpk_s(p_[0], p_[1]), attn128::cvtpk_s(p_[2], p_[3]), 0u, 0u}; \
        _Pragma("unroll") for (int jj_ = 0; jj_ < 2; ++jj_) _Pragma("unroll") for (int rr_ = 0; rr_ < 4; ++rr_) { \
            const v4u va_ = {attn128::cvtpk_s(VX[jj_][rr_], VX[2 + jj_][rr_]), attn128::cvtpk_s(VX[4 + jj_][rr_], VX[6 + jj_][rr_]), 0u, 0u}; \
            acc[jj_][rr_] = __builtin_amdgcn_mfma_f32_16x16x32_bf16(__builtin_bit_cast(bf16x8, va_), __builtin_bit_cast(bf16x8, pb_), acc[jj_][rr_], 0, 0, 0); } \
        if (NEXT_OK) DEC_ISSUE_V(VX, tn_); } while (0)
        DEC_ISSUE_K(KA, 0); DEC_ISSUE_V(VA, 0); DEC_ISSUE_K(KB, 1); DEC_ISSUE_V(VB, 1);
        if (wave & 1) __builtin_amdgcn_s_sleep(40);
        for (int tt = 0; tt < 16; tt += 2) {
            DEC_TILE(KA, VA, false, tt + 2 < 16, tt + 2);
            DEC_TILE(KB, VB, false, tt + 3 < 16, tt + 3);
        }
        if (wave == 7) {
            const GAS float* kp = outf + OFF_KS + (size_t)(b * DEC_S + ((lane >> 2) < 7 ? (lane >> 2) : 7)) * 512 + h * 128 + 4 * (lane & 3);
#pragma unroll
            for (int j = 0; j < 8; ++j) KA[j] = *(const GAS f32x4v*)(kp + 16 * j);
#pragma unroll
            for (int r = 0; r < 4; ++r) { const int key = 4 * g + r < 7 ? 4 * g + r : 7; const GAS float* vp = outf + OFF_VS + (size_t)(b * DEC_S + key) * 512 + h * 128 + 4 * c16;
                VA[2 * r] = *(const GAS f32x4v*)(vp); VA[2 * r + 1] = *(const GAS f32x4v*)(vp + 64); }
            DEC_TILE(KA, VA, true, false, 0);
        }
#undef DEC_ISSUE_K
#undef DEC_ISSUE_V
#undef DEC_TILE
        const float lt = xrow_sum(lsum);
        if (g == 0) { ML[(wave * 16 + c16) * 2] = mref; ML[(wave * 16 + c16) * 2 + 1] = lt; }
#pragma unroll
        for (int jj = 0; jj < 2; ++jj)
#pragma unroll
            for (int e = 0; e < 4; ++e) *(LAS f32x4v*)(Om + (size_t)((wave * 16 + c16) * 128 + 64 * jj + 16 * g + 4 * e)) = (f32x4v){acc[jj][0][e], acc[jj][1][e], acc[jj][2][e], acc[jj][3][e]};
        __syncthreads();
        { const int qi = wave; float on[2][2];
#pragma unroll
            for (int mp = 0; mp < 2; ++mp) { const int col = mp * 8 + qi; float M = -INFINITY;
#pragma unroll
                for (int w = 0; w < 8; ++w) M = fmaxf(M, ML[(w * 16 + col) * 2]);
                float L = 0.f, o0 = 0.f, o1 = 0.f;
#pragma unroll
                for (int w = 0; w < 8; ++w) { const float wt = __builtin_amdgcn_exp2f(ML[(w * 16 + col) * 2] - M); L = fmaf(wt, ML[(w * 16 + col) * 2 + 1], L);
                    const f32x2w ov = *(const LAS f32x2w*)(Om + (size_t)((w * 16 + col) * 128 + 2 * lane)); o0 = fmaf(wt, ov.x, o0); o1 = fmaf(wt, ov.y, o1); }
                const float inv = 1.0f / L; on[mp][0] = o0 * inv; on[mp][1] = o1 * inv; }
            const float lam = compute_lam(F, A);
            const float d0 = on[0][0] - lam * on[1][0], d1 = on[0][1] - lam * on[1][1];
            const float rs = 1.0f / sqrtf(wave_sum(d0 * d0 + d1 * d1) * (1.f / 128.f) + EPS);
            const size_t row = (size_t)(MP + b * DEC_S + qi); const int cc = h * 128 + 2 * lane;
            const unsigned gaw = *(const GAS unsigned*)(GAb + row * 512 + cc);
            const float y0 = d0 * rs * subln[2 * lane] * __uint_as_float(gaw << 16), y1 = d1 * rs * subln[2 * lane + 1] * __uint_as_float(gaw & 0xffff0000u);
            *(GAS unsigned*)(Mb + row * 1024 + cc) = pk2(y0, y1); }
        __syncthreads();
    }
}
__device__ __forceinline__ void attn_post(Frame& F, const Args& A, const int blk) {
    const float lam = compute_lam(F, A);
    const float* subln = A.in[12]; const bf16 *O1b = WSP(bf16, WS_O1), *O2b = WSP(bf16, WS_O2), *GAb = WSP(bf16, WS_GA); bf16* Mb = WSP(bf16, WS_M);
    int tid_ = F.wave * 64 + lane_id(); asm volatile("" : "+v"(tid_)); const int lane = tid_ & 63, wv = __builtin_amdgcn_readfirstlane(tid_ >> 6);
    const f32x4 sg0 = *(const f32x4*)(subln + (8 * lane & 127)), sg1 = *(const f32x4*)(subln + (8 * lane & 127) + 4);
    const int row0 = (blk >> 7) * SEQ + (blk & 31) * 256 + (lane >> 4), col = ((blk >> 5) & 3) * 128 + 8 * (lane & 15);
    for (int trip = wv; trip < 16; trip += NWAVES) {
        v4u a[4], b[4], gq[4];
#pragma unroll
        for (int r = 0; r < 4; ++r) { const size_t ro = (size_t)(row0 + 16 * trip + 4 * r) * 512 + col; a[r] = *(const v4u*)(O1b + ro); b[r] = *(const v4u*)(O2b + ro); gq[r] = *(const v4u*)(GAb + ro); }
#pragma unroll
        for (int r = 0; r < 4; ++r) {
            float o[8], gg[8]; float ss = 0.f;
#pragma unroll
            for (int i = 0; i < 4; ++i) { const unsigned aw = a[r][i], bw = b[r][i], gw_ = gq[r][i];
                o[2 * i] = __uint_as_float(aw << 16) - lam * __uint_as_float(bw << 16); o[2 * i + 1] = __uint_as_float(aw & 0xffff0000u) - lam * __uint_as_float(bw & 0xffff0000u);
                gg[2 * i] = __uint_as_float(gw_ << 16); gg[2 * i + 1] = __uint_as_float(gw_ & 0xffff0000u);
                ss += o[2 * i] * o[2 * i] + o[2 * i + 1] * o[2 * i + 1]; }
            ss = row16_sum(ss);
            const float rs = 1.0f / sqrtf(ss * (1.f / 128.f) + EPS);
            v4u w; w.x = pk2(o[0] * rs * sg0[0] * gg[0], o[1] * rs * sg0[1] * gg[1]); w.y = pk2(o[2] * rs * sg0[2] * gg[2], o[3] * rs * sg0[3] * gg[3]);
            w.z = pk2(o[4] * rs * sg1[0] * gg[4], o[5] * rs * sg1[1] * gg[5]); w.w = pk2(o[6] * rs * sg1[2] * gg[6], o[7] * rs * sg1[3] * gg[7]);
            { bf16* mp_ = Mb + (size_t)(row0 + 16 * trip + 4 * r) * 1024 + col; asm volatile("global_store_dwordx4 %0, %1, off sc1\n\ts_nop 1" :: "v"(mp_), "v"(w) : "memory"); } }
    }
}
template <bool PROMPT> __device__ __forceinline__ void final_norm(Frame& F, const Args& A, const int first_cu) {
    if (PROMPT && (int)blockIdx.x < first_cu) return;
    const float* part = WSP(float, WS_PART); const float* xs = A.in[1]; float* out = A.out;
    int tid_ = F.wave * 64 + lane_id(); asm volatile("" : "+v"(tid_)); const int lane = tid_ & 63, gw = ((int)blockIdx.x - first_cu) * NWAVES + __builtin_amdgcn_readfirstlane(tid_ >> 6), NGW = ((int)F.G - first_cu) * NWAVES;
    f32x4 gv[4];
#pragma unroll
    for (int j = 0; j < 4; ++j) gv[j] = *((const f32x4*)A.in[20] + lane + 64 * j);
    if constexpr (PROMPT) { const float* xp = A.in[0]; const bf16* mix = WSP(bf16, WS_MIX); typedef unsigned u32x2 __attribute__((ext_vector_type(2)));
      for (int grp = gw; grp < MP / 4; grp += NGW) {
        f32x4 y[4][4]; u32x2 mw[4][4];
#pragma unroll
        for (int r = 0; r < 4; ++r)
#pragma unroll
            for (int j = 0; j < 4; ++j) { y[r][j] = *((const f32x4*)(xp + (size_t)(4 * grp + r) * D_MODEL) + lane + 64 * j); mw[r][j] = *((const u32x2*)(mix + (size_t)(4 * grp + r) * D_MODEL) + lane + 64 * j); }
#pragma unroll
        for (int r = 0; r < 4; ++r) { float ss = 0.f;
#pragma unroll
            for (int j = 0; j < 4; ++j) { y[r][j][0] += __uint_as_float(mw[r][j].x << 16); y[r][j][1] += __uint_as_float(mw[r][j].x & 0xffff0000u); y[r][j][2] += __uint_as_float(mw[r][j].y << 16); y[r][j][3] += __uint_as_float(mw[r][j].y & 0xffff0000u);
                ss += (y[r][j][0] * y[r][j][0] + y[r][j][1] * y[r][j][1]) + (y[r][j][2] * y[r][j][2] + y[r][j][3] * y[r][j][3]); }
            const float rs = 1.0f / sqrtf(wave_sum(ss) * (1.f / D_MODEL) + EPS);
#pragma unroll
            for (int j = 0; j < 4; ++j) { const f32x4 yo_ = y[r][j] * rs * gv[j]; float* yp_ = out + (size_t)(4 * grp + r) * D_MODEL + 4 * (lane + 64 * j); asm volatile("global_store_dwordx4 %0, %1, off sc1\n\ts_nop 1" :: "v"(yp_), "v"(yo_) : "memory"); } }
      } }
    else for (int row = first_cu + 2 * (gw & 7), rend = row + 2; row < rend; ++row) {
        f32x4 y[4]; float ss = 0.f;
#pragma unroll
        for (int j = 0; j < 4; ++j) { const size_t o = (size_t)row * D_MODEL + 4 * lane + 256 * j;
            y[j] = *(const f32x4*)(xs + o) + ((*(const f32x4*)(part + o) + *(const f32x4*)(part + o + (size_t)MS * D_MODEL)) + (*(const f32x4*)(part + o + 2 * (size_t)MS * D_MODEL) + *(const f32x4*)(part + o + 3 * (size_t)MS * D_MODEL)));
            ss += (y[j][0] * y[j][0] + y[j][1] * y[j][1]) + (y[j][2] * y[j][2] + y[j][3] * y[j][3]); }
        const float rs = 1.0f / sqrtf(wave_sum(ss) * (1.f / D_MODEL) + EPS);
#pragma unroll
        for (int j = 0; j < 4; ++j) *((f32x4*)(out + OFF_YS + (size_t)row * D_MODEL) + lane + 64 * j) = y[j] * rs * gv[j];
    }
}

__global__ void __launch_bounds__(NWAVES * 64, 2) hymba_fwd(Args args) {
    extern __shared__ __attribute__((aligned(16))) unsigned char lds[];
    Frame F;
    F.lds = (LAS unsigned char*)lds;
    F.MISC = (volatile LAS unsigned*)(F.lds + MISC_OFF);
    F.wave = __builtin_amdgcn_readfirstlane((int)threadIdx.x >> 6);
    F.G = gridDim.x; { const int bx = blockIdx.x; F.vcu = (F.G % 8 == 0) ? (bx % 8) * (F.G / 8) + bx / 8 : bx; }
    const Args& A = args;
    F.ctl = (gu32*)(A.ws + WS_CTL);
    for (int u = F.wave * 64 + lane_id(); u < (LDS_BYTES - LDSCTL_OFF) / 4; u += NWAVES * 64) ((LAS unsigned*)(F.lds + LDSCTL_OFF))[u] = 0u;
    __syncthreads();
    XcdBarrier bar = xcd_barrier_post((unsigned*)(F.ctl + CW_BAR), F.MISC + 8, F.wave);

#ifndef SKIP_P0
    p0_prologue(F, A);
#endif
    xcd_barrier(bar);
#ifndef SKIP_G1
    { pg8::Gemm g{WSP(bf16, WS_XN), WSP(bf16, WS_WIN), MT, D_IN, D_MODEL, D_MODEL}; pg8::StaticOrder S; S.init(MT, D_IN, F.G, (int)blockIdx.x);
      pg8::EpiIn E{WSP(bf16, WS_Q), WSP(bf16, WS_K), WSP(bf16, WS_V), WSP(bf16, WS_GA), WSP(bf16, WS_GC), WSP(bf16, WS_U), A.out};
      pg8::gemm_phase<pg8::EpiIn, pg8::StaticOrder, false, PG8_SP2>(F.lds + RING_OFF, g, S, E, F.wave); }
#endif
    xcd_barrier(bar);
#ifndef SKIP_CONV
    conv_phase(F, A);
#endif
    asm volatile("s_waitcnt vmcnt(0)" ::: "memory");
    __syncthreads();
    if (F.wave == 0 && lane_id() == 0) {
        xcd_arrive((unsigned*)F.ctl, CW_XCONV, CW_CONV, bar.x, F.MISC[8]); }
    {
      const attn128::bf16 *Qp = WSP(const attn128::bf16, WS_Q), *Kp = WSP(const attn128::bf16, WS_K), *Vp = WSP(const attn128::bf16, WS_V);
      const int grp = F.vcu >> 4, s16 = F.vcu & 15, ab = grp >> 3, ah = (grp >> 1) & 3, amap = grp & 1;
      const int cmb = ((F.vcu & 31) * 3) >> 5; const bool rev = cmb != 1 || (grp & 1) != 0; const int sa = cmb, sb = cmb;
      for (int i = 0; i < 3; ++i) {
          if (i == sa) decode_items(F, A, F.vcu, DEC_B * 4);
          if (i < 2) { const int qb = ((i == 0) != rev) ? s16 : 31 - s16;
              attn128::bf16* Op = amap ? WSP(attn128::bf16, WS_O2) : WSP(attn128::bf16, WS_O1);
              if (attn128::attn_unit<8, true>(ab, ah * 128 + amap * 64, ah * 128, qb, Qp, Kp, Vp, Op, (char*)lds + RING_OFF, F.wave))
                  (void)attn128::attn_unit<8, false>(ab, ah * 128 + amap * 64, ah * 128, qb, Qp, Kp, Vp, Op, (char*)lds + RING_OFF, F.wave);
              asm volatile("s_waitcnt vmcnt(0)" ::: "memory");
              __syncthreads();
              if (F.wave == 0 && lane_id() == 0) { const int blk = (grp >> 1) * 32 + qb;
                  if (xb_add((unsigned*)(F.ctl + CW_PAIR + 16 * blk), 1u) == 1u) { const unsigned qi = xb_add((unsigned*)(F.ctl + CW_QTAIL), 1u);
                      __hip_atomic_store((unsigned*)(F.ctl + CW_QUEUE + 8 * (qi & 255u)), (unsigned)blk + 1u, RLX_AGENT); } } }

      }
    }
    asm volatile("s_waitcnt vmcnt(0)" ::: "memory");
    __syncthreads();
    if (F.wave == 0 && lane_id() == 0) {
        unsigned* tb = (unsigned*)(F.ctl + CW_BAR);
        const unsigned t = xb_add((unsigned*)(F.ctl + CW_TICKET), 1u);
        if (t < (unsigned)((MT / 256) * 2)) { XB_SPIN(xb_ld((unsigned*)(F.ctl + CW_CONV)) < (unsigned)F.G, tb); __builtin_amdgcn_fence(__ATOMIC_ACQUIRE, "agent"); asm volatile("s_waitcnt vmcnt(0)" ::: "memory"); }
        F.MISC[12] = t; }
    __syncthreads();
    { pg8::Gemm g{WSP(bf16, WS_C), WSP(bf16, WS_WPW), MT, 512, 512, 512}; pg8::TicketOrder S{__builtin_amdgcn_readfirstlane((int)F.MISC[12])};
      pg8::EpiPw2 E{A.in[18], WSP(bf16, WS_GC), WSP(bf16, WS_M)};
      pg8::gemm_phase<pg8::EpiPw2, pg8::TicketOrder, PG8_ALIGN, PG8_SP2>(F.lds + RING_OFF, g, S, E, F.wave); }
    { const int t_ = __builtin_amdgcn_readfirstlane((int)F.MISC[12]);
      if (t_ < 128) {
          asm volatile("s_waitcnt vmcnt(0)" ::: "memory");
          __syncthreads();
          if (F.wave == 0 && lane_id() == 0) panel_post((unsigned*)F.ctl, t_ >> 1); } }
    for (;;) {
        __syncthreads();
        if (F.wave == 0 && lane_id() == 0) { unsigned* tb = (unsigned*)(F.ctl + CW_BAR);
            const unsigned qi = xb_add((unsigned*)(F.ctl + CW_QHEAD), 1u); unsigned e = 0u;
            if (qi < 256u) { unsigned* qe = (unsigned*)(F.ctl + CW_QUEUE + 8 * qi); XB_SPIN((e = xb_ld(qe)) == 0u, tb);
                __builtin_amdgcn_fence(__ATOMIC_ACQUIRE, "agent"); asm volatile("s_waitcnt vmcnt(0)" ::: "memory"); }
            F.MISC[13] = e; }
        __syncthreads();
        const int e = __builtin_amdgcn_readfirstlane((int)F.MISC[13]);
        if (e == 0) break;
        attn_post(F, A, e - 1);
        asm volatile("s_waitcnt vmcnt(0)" ::: "memory");
        __syncthreads();
        if (F.wave == 0 && lane_id() == 0) panel_post((unsigned*)F.ctl, ((e - 1) >> 7) * 32 + ((e - 1) & 31));
    }
    for (;;) {
        __syncthreads();
        if (F.wave == 0 && lane_id() == 0) { unsigned* tb = (unsigned*)(F.ctl + CW_BAR);
            const unsigned qi = xb_add((unsigned*)(F.ctl + CW_PHEAD), 1u); unsigned e = 0u;
            if (qi < 256u) { unsigned* qe = (unsigned*)(F.ctl + CW_PQ + 4 * qi); XB_SPIN((e = xb_ld(qe)) == 0u, tb);
                __builtin_amdgcn_fence(__ATOMIC_ACQUIRE, "agent"); asm volatile("s_waitcnt vmcnt(0)" ::: "memory"); }
            F.MISC[13] = e; }
        __syncthreads();
        const int e = __builtin_amdgcn_readfirstlane((int)F.MISC[13]);
        if (e == 0) break;
        { pg8::Gemm g{WSP(bf16, WS_M), WSP(bf16, WS_WOUT), MP, D_MODEL, D_MODEL, D_MODEL}; pg8::OneUnit S{(e - 1) >> 2, (e - 1) & 3};
          pg8::EpiOut E{WSP(bf16, WS_MIX)};
          pg8::gemm_phase<pg8::EpiOut, pg8::OneUnit, PG8_ALIGN, PG8_SP2>(F.lds + RING_OFF, g, S, E, F.wave); }
    }
    xcd_barrier(bar);
    { const int c = (int)blockIdx.x, kc = c & 3;
      pg8::Gemm g{WSP(bf16, WS_M) + kc * 256, WSP(bf16, WS_WOUT) + kc * 256, MT, D_MODEL, 256, D_MODEL}; pg8::SampleOrder S{c};
      pg8::EpiPart E{WSP(float, WS_PART) + (size_t)kc * MS * D_MODEL};
      pg8::gemm_phase<pg8::EpiPart, pg8::SampleOrder, PG8_ALIGN, PG8_SP2>(F.lds + RING_OFF, g, S, E, F.wave); }
    if ((int)blockIdx.x < 64) {
        const int rb = (int)blockIdx.x >> 4;
        asm volatile("s_waitcnt vmcnt(0)" ::: "memory");
        __syncthreads();
        if (F.wave == 0 && lane_id() == 0) {
            unsigned* cnt = (unsigned*)(F.ctl + CW_SROW + 64 * rb); unsigned* tb = (unsigned*)(F.ctl + CW_BAR);
            __builtin_amdgcn_fence(__ATOMIC_RELEASE, "agent");
            asm volatile("s_waitcnt vmcnt(0)" ::: "memory");
            (void)xb_add(cnt, 1u);
            XB_SPIN(xb_ld(cnt) < 16u, tb);
            __builtin_amdgcn_fence(__ATOMIC_ACQUIRE, "agent");
            asm volatile("s_waitcnt vmcnt(0)" ::: "memory");
        }
        __syncthreads();
        final_norm<false>(F, A, rb * 256 + ((int)blockIdx.x & 15) * 16);
    }
#ifndef SKIP_FIN
    else final_norm<true>(F, A, 64);
#endif
}

extern "C" void kernel_launch(void* const* d_in, const int* in_sizes, int n_in, void* d_out, int out_size, void* d_ws, size_t ws_size, hipStream_t stream) {
    static int grid = 0;
    if (grid == 0) {
        if (n_in != 21 || in_sizes[0] != MP * D_MODEL || (size_t)out_size != OUT_TOTAL || ws_size < WS_END) { fprintf(stderr, "kernel_launch: unexpected problem (n_in %d, in0 %d, out %d, ws %zu); nothing launched\n", n_in, n_in > 0 ? in_sizes[0] : -1, out_size, ws_size); grid = -1; return; }
        int dev = 0, cus = 0, per_cu = 0;
        if (hipGetDevice(&dev) != hipSuccess || hipDeviceGetAttribute(&cus, hipDeviceAttributeMultiprocessorCount, dev) != hipSuccess) { fprintf(stderr, "kernel_launch: device query failed\n"); grid = -1; return; }
        if (hipFuncSetAttribute((const void*)hymba_fwd, hipFuncAttributeMaxDynamicSharedMemorySize, LDS_BYTES) != hipSuccess) { fprintf(stderr, "kernel_launch: hipFuncSetAttribute failed\n"); grid = -1; return; }
        if (hipOccupancyMaxActiveBlocksPerMultiprocessor(&per_cu, (const void*)hymba_fwd, NWAVES * 64, LDS_BYTES) != hipSuccess || per_cu < 1)
            fprintf(stderr, "kernel_launch: note: occupancy query reports %d workgroups per CU\n", per_cu);
        (void)hipGetLastError();
        grid = cus;
        if (grid != 256) fprintf(stderr, "kernel_launch: %d CUs; the attention unit deal is written for 256\n", grid);
    }
    if (grid < 0) return;
    if (hipMemsetAsync((char*)d_ws + WS_CTL, 0, CTL_ZERO_BYTES, stream) != hipSuccess) { fprintf(stderr, "kernel_launch: memset failed\n"); return; }
    Args a{};
    for (int i = 0; i < 21; ++i) a.in[i] = (const float*)d_in[i];
    a.out = (float*)d_out; a.ws = (unsigned char*)d_ws;
    hipLaunchKernelGGL(hymba_fwd, dim3(grid), dim3(NWAVES * 64), LDS_BYTES, stream, a);
    const hipError_t le = hipPeekAtLastError();
    if (le != hipSuccess) fprintf(stderr, "kernel_launch: launch failed: %s\n", hipGetErrorName(le));
}
```

```cpp
#include <hip/hip_runtime.h>
#include <cstdio>
#include <cstdint>
constexpr int D_MODEL = 1024, SEQ = 8192, NBATCH = 2, MP = NBATCH * SEQ;
constexpr int DEC_B = 128, DEC_S = 8, MS = DEC_B * DEC_S;
constexpr int MT = MP + MS;
constexpr int D_IN = 3584, CONV_W = 31, HIST = 30, NPAGES = 16;
constexpr float EPS = 1e-5f, LOG2E = 1.4426950408889634f;
constexpr float QSCALE = 0.125f * LOG2E;
constexpr size_t OFF_YP = 0, OFF_YS = OFF_YP + (size_t)MP * D_MODEL, OFF_KP = OFF_YS + (size_t)MS * D_MODEL, OFF_VP = OFF_KP + (size_t)MP * 512, OFF_CP = OFF_VP + (size_t)MP * 512,
    OFF_KS = OFF_CP + (size_t)NBATCH * HIST * 512, OFF_VS = OFF_KS + (size_t)MS * 512, OFF_CS = OFF_VS + (size_t)MS * 512, OUT_TOTAL = OFF_CS + (size_t)DEC_B * HIST * 512;
static_assert(OUT_TOTAL == 37648384, "output size");
constexpr int UP_SEQ = SEQ + HIST, USMP0 = NBATCH * UP_SEQ, US_SEQ = HIST + DEC_S, U_ROWS = USMP0 + DEC_B * US_SEQ;
__host__ __device__ __forceinline__ int u_row(int row) { return row < MP ? row + HIST * ((row >> 13) + 1) : USMP0 + ((row - MP) >> 3) * US_SEQ + HIST + ((row - MP) & 7); }
__device__ __forceinline__ int lane_id() { int l; asm volatile("v_mbcnt_lo_u32_b32 %0, -1, 0\n\tv_mbcnt_hi_u32_b32 %0, -1, %0" : "=v"(l)); return l; }
namespace pg8 {
#define PG8_LAS __attribute__((address_space(3)))
typedef unsigned short bf16_t;
typedef short bf16x8 __attribute__((ext_vector_type(8)));
typedef float f32x4 __attribute__((ext_vector_type(4)));
typedef unsigned u32x4 __attribute__((ext_vector_type(4)));
constexpr int BM = 256, BK = 64, HALF = 128, HTB = HALF * BK * 2  , STAGE_BYTES = 8 * HTB, NXCD = 8, WGM = 8;

__host__ __device__ __forceinline__ int lds_byte(int r, int c) { const int st = (r >> 4) * 2 + (c >> 5), rr = r & 15, cc = c & 31, ob = rr * 64 + cc * 2; return st * 1024 + (ob ^ (((ob >> 9) & 1) << 5)); }
__host__ __device__ __forceinline__ void stage_rc(int b, int& R, int& C) { const int st = b / 1024, sb = b % 1024, swz = sb ^ (((sb >> 9) & 1) << 5); R = (st >> 1) * 16 + swz / 64; C = (st & 1) * 32 + (swz % 64) / 2; }
__host__ __device__ __forceinline__ int perm32(int rho) { const int n = rho >> 4, i = rho & 15; return 8 * (i >> 2) + 4 * n + (i & 3); }

struct Unit { int pm, pn; };
struct Gemm { const bf16_t* A; const bf16_t* Bt; int M, N, K, ld; };

struct StaticOrder {
    int nM, nN, nwg, G, c;
    __host__ __device__ void init(int M, int N, int G_, int c_) { nM = M / BM; nN = N / BM; nwg = nM * nN; G = G_; c = c_; }
    __host__ __device__ bool next(int i, Unit& u) const {
        const long L = (long)i * G + c; if (L >= nwg) return false;
        int wgid = (int)L; { const int q = nwg / NXCD, r = nwg % NXCD, xcd = wgid % NXCD, off = wgid / NXCD; wgid = (xcd < r ? xcd * (q + 1) : r * (q + 1) + (xcd - r) * q) + off; }
        const int nig = WGM * nN, gid = wgid / nig, fm = gid * WGM, gsz = (nM - fm) < WGM ? (nM - fm) : WGM;
        u.pm = fm + ((wgid % nig) % gsz); u.pn = (wgid % nig) / gsz; return true;
    }
    __device__ __forceinline__ void a_ready(const Unit&) const {}
    __device__ __forceinline__ void done(const Unit&) const {}
};
__device__ __forceinline__ unsigned cvt_pk_bf16(float lo, float hi) { unsigned r; asm volatile("v_cvt_pk_bf16_f32 %0, %1, %2" : "=v"(r) : "v"(lo), "v"(hi)); return r; }
typedef float f32x2 __attribute__((ext_vector_type(2)));
__device__ __forceinline__ float sigm_f(float x) { return __builtin_amdgcn_rcpf(1.0f + __builtin_amdgcn_exp2f(-LOG2E * x)); }
__device__ __forceinline__ float silu_f(float x) { return x * sigm_f(x); }
__device__ __forceinline__ u32x4 pack8(const f32x4 v0, const f32x4 v1) { u32x4 w; w.x = cvt_pk_bf16(v0[0], v0[1]); w.y = cvt_pk_bf16(v0[2], v0[3]); w.z = cvt_pk_bf16(v1[0], v1[1]); w.w = cvt_pk_bf16(v1[2], v1[3]); return w; }
#define ST16_WT(p, v) asm volatile("global_store_dwordx4 %0, %1, off sc1\n\ts_nop 1" :: "v"(p), "v"(v) : "memory")
struct EpiIn {
    static constexpr bool PERM = true, AFTER_DRAIN = false;
    bf16_t *Qb, *Kb, *Vb, *GAb, *GCb; bf16_t* U; float* out;
    __device__ __forceinline__ void operator()(const f32x4 (&acc)[2][2][4][2], const Unit& u, int wr, int wc, int fr, int fq) const {
        const int row0 = u.pm * BM + wr * 64 + fr, pn = u.pn, cw = wc * 32 + 8 * fq;
        if (pn < 2 || pn == 6 || pn == 7 || pn >= 12) {
            bf16_t* base; int mode;
            if (pn < 2) { base = Qb + pn * 256; mode = 0; } else if (pn < 8) { base = GAb + (pn - 6) * 256; mode = 1; } else { base = GCb + (pn - 12) * 256; mode = 2; }
#pragma unroll
            for (int ai = 0; ai < 2; ++ai)
#pragma unroll
                for (int m = 0; m < 4; ++m) { bf16_t* rowp = base + (size_t)(row0 + ai * HALF + m * 16) * 512 + cw;
#pragma unroll
                    for (int bj = 0; bj < 2; ++bj) { f32x4 v0 = acc[ai][bj][m][0], v1 = acc[ai][bj][m][1];
                        if (mode == 0) { v0 = v0 * QSCALE; v1 = v1 * QSCALE; }
                        else { const float sc = mode == 1 ? 0.8f : 1.0f;
#pragma unroll
                            for (int i = 0; i < 4; ++i) { v0[i] = silu_f(v0[i]) * sc; v1[i] = silu_f(v1[i]) * sc; } }
                        *(u32x4*)(rowp + bj * HALF) = pack8(v0, v1); } }
        } else if (pn < 6) {
            const int t = (pn - 2) >> 1, cb = ((pn - 2) & 1) * 256 + cw; const bool smp = u.pm >= MP / BM;
            bf16_t* bb = (t ? Vb : Kb) + cb;
            float* fb = out + (smp ? (t ? OFF_VS : OFF_KS) - (size_t)MP * 512 : (t ? OFF_VP : OFF_KP)) + cb;
#pragma unroll
            for (int ai = 0; ai < 2; ++ai)
#pragma unroll
                for (int m = 0; m < 4; ++m) { const size_t ro = (size_t)(row0 + ai * HALF + m * 16) * 512;
#pragma unroll
                    for (int bj = 0; bj < 2; ++bj) { const f32x4 v0 = acc[ai][bj][m][0], v1 = acc[ai][bj][m][1];
                        *(f32x4*)(fb + ro + bj * HALF) = v0; *(f32x4*)(fb + ro + bj * HALF + 4) = v1; *(u32x4*)(bb + ro + bj * HALF) = pack8(v0, v1); } }
        } else {
            bf16_t* ub = U + 128 * (pn - 8) + cw; const int ccol = 128 * (pn - 8) + cw;
            const bool outs = (u.pm & 31) == 31 || u.pm >= MP / BM;
#pragma unroll
            for (int ai = 0; ai < 2; ++ai)
#pragma unroll
                for (int m = 0; m < 4; ++m) { const int row = row0 + ai * HALF + m * 16; const size_t ro = (size_t)u_row(row) * 512; f32x4 o[2];
#pragma unroll
                    for (int n = 0; n < 2; ++n) { const f32x4 a = acc[ai][0][m][n], b = acc[ai][1][m][n];
#pragma unroll
                        for (int i = 0; i < 4; ++i) o[n][i] = a[i] * sigm_f(b[i]); }
                    *(u32x4*)(ub + ro) = pack8(o[0], o[1]);
                    if (outs) { long od = -1;
                        if (row < MP) { const int t = row & (SEQ - 1); if (t >= SEQ - HIST) od = (long)OFF_CP + ((long)(row >> 13) * HIST + (t - (SEQ - HIST))) * 512; }
                        else { const int rs = row - MP; od = (long)OFF_CS + ((long)(rs >> 3) * HIST + (HIST - DEC_S) + (rs & 7)) * 512; }
                        if (od >= 0) { *(f32x4*)(out + od + ccol) = o[0]; *(f32x4*)(out + od + ccol + 4) = o[1]; } } }
        }
    }
};
struct EpiPw2 {
    static constexpr bool PERM = true, AFTER_DRAIN = false;
    const float* bias; const bf16_t* GCb; bf16_t* Mb;
    __device__ __forceinline__ void operator()(const f32x4 (&acc)[2][2][4][2], const Unit& u, int wr, int wc, int fr, int fq) const {
        const int row0 = u.pm * BM + wr * 64 + fr, c0 = u.pn * BM + wc * 32 + 8 * fq;
        f32x4 bv[2][2];
#pragma unroll
        for (int bj = 0; bj < 2; ++bj)
#pragma unroll
            for (int n = 0; n < 2; ++n) bv[bj][n] = *(const f32x4*)(bias + c0 + bj * HALF + 4 * n);
#pragma unroll
        for (int ai = 0; ai < 2; ++ai)
#pragma unroll
            for (int m = 0; m < 4; ++m) { const size_t r = (size_t)(row0 + ai * HALF + m * 16);
#pragma unroll
                for (int bj = 0; bj < 2; ++bj) { const u32x4 gw = *(const u32x4*)(GCb + r * 512 + c0 + bj * HALF);
                    f32x4 g0, g1; g0[0] = __uint_as_float(gw.x << 16); g0[1] = __uint_as_float(gw.x & 0xffff0000u); g0[2] = __uint_as_float(gw.y << 16); g0[3] = __uint_as_float(gw.y & 0xffff0000u);
                    g1[0] = __uint_as_float(gw.z << 16); g1[1] = __uint_as_float(gw.z & 0xffff0000u); g1[2] = __uint_as_float(gw.w << 16); g1[3] = __uint_as_float(gw.w & 0xffff0000u);
                    const f32x4 v0 = (acc[ai][bj][m][0] + bv[bj][0]) * g0, v1 = (acc[ai][bj][m][1] + bv[bj][1]) * g1;
                    { const u32x4 pw_ = pack8(v0, v1); ST16_WT(Mb + r * 1024 + 512 + c0 + bj * HALF, pw_); } } }
    }
};
struct EpiOut {
    static constexpr bool PERM = true, AFTER_DRAIN = false;
    bf16_t* mix;
    __device__ __forceinline__ void operator()(const f32x4 (&acc)[2][2][4][2], const Unit& u, int wr, int wc, int fr, int fq) const {
        const int row0 = u.pm * BM + wr * 64 + fr, c0 = u.pn * BM + wc * 32 + 8 * fq;
#pragma unroll
        for (int ai = 0; ai < 2; ++ai)
#pragma unroll
            for (int m = 0; m < 4; ++m) { bf16_t* rowp = mix + (size_t)(row0 + ai * HALF + m * 16) * D_MODEL + c0;
#pragma unroll
                for (int bj = 0; bj < 2; ++bj) *(u32x4*)(rowp + bj * HALF) = pack8(acc[ai][bj][m][0], acc[ai][bj][m][1]); }
    }
};
struct EpiPart {
    static constexpr bool PERM = true, AFTER_DRAIN = false;
    float* part;
    __device__ __forceinline__ void operator()(const f32x4 (&acc)[2][2][4][2], const Unit& u, int wr, int wc, int fr, int fq) const {
        const int row0 = (u.pm - MP / BM) * BM + wr * 64 + fr, c0 = u.pn * BM + wc * 32 + 8 * fq;
#pragma unroll
        for (int ai = 0; ai < 2; ++ai)
#pragma unroll
            for (int m = 0; m < 4; ++m) { const size_t r = (size_t)(row0 + ai * HALF + m * 16);
#pragma unroll
                for (int bj = 0; bj < 2; ++bj)
#pragma unroll
                    for (int n = 0; n < 2; ++n) *(f32x4*)(part + r * D_MODEL + c0 + bj * HALF + 4 * n) = acc[ai][bj][m][n]; }
    }
};
struct SampleOrder {
    int c;
    __device__ __forceinline__ bool next(int i, Unit& u) const { if (i > 0 || c >= 64) return false; u.pm = MP / BM + (c >> 4); u.pn = (c >> 2) & 3; return true; }
    __device__ __forceinline__ void a_ready(const Unit&) const {}
    __device__ __forceinline__ void done(const Unit&) const {}
};
struct TicketOrder {
    int t;
    __device__ __forceinline__ bool next(int i, Unit& u) const { if (i > 0 || t >= (MT / BM) * 2) return false; u.pm = t >> 1; u.pn = t & 1; return true; }
    __device__ __forceinline__ void a_ready(const Unit&) const {}
    __device__ __forceinline__ void done(const Unit&) const {}
};
struct OneUnit {
    int pm, pn;
    __device__ __forceinline__ bool next(int i, Unit& u) const { if (i > 0) return false; u.pm = pm; u.pn = pn; return true; }
    __device__ __forceinline__ void a_ready(const Unit&) const {}
    __device__ __forceinline__ void done(const Unit&) const {}
};
template <class Epi, class Sched, bool ALIGN_EPI = false, bool SP2 = false>
__device__ __forceinline__ void gemm_phase(PG8_LAS unsigned char* lds, const Gemm g, const Sched& S, const Epi& E, const int g_wave) {
    int tid = g_wave * 64 + lane_id(); asm volatile("" : "+v"(tid));
    const int wid = __builtin_amdgcn_readfirstlane(tid >> 6), lane = tid & 63, wr = wid >> 2, wc = wid & 3, fr = lane & 15, fq = lane >> 4;
    const int K = g.K, LD = g.ld, nt = K / BK;
    unsigned voffA[2], voffB[2];
#pragma unroll
    for (int i = 0; i < 2; ++i) { int R, C; stage_rc(tid * 16 + i * 8192, R, C); const int Rb = Epi::PERM ? ((R & ~31) + perm32(R & 31)) : R;
        voffA[i] = (unsigned)(R * LD + C) * 2u; voffB[i] = (unsigned)(Rb * LD + C) * 2u; }
    const size_t kstep = (size_t)(BK * 2);
    const size_t hstep = (size_t)HALF * LD * 2;
    const size_t tstep = 2 * hstep;
    const unsigned ldsw = (unsigned)wid * 1024u;
    const int aoff = lds_byte(wr * 64 + fr, fq * 8), boff = lds_byte(wc * 32 + fr, fq * 8);
#define PG8_SA(b, h) (((b) * 2 + (h)) * HTB)
#define PG8_SB(b, h) ((4 + (b) * 2 + (h)) * HTB)
#define PG8_STAGE(bufoff, gbase, voff) do { _Pragma("unroll") for (int _i = 0; _i < 2; ++_i) \
        __builtin_amdgcn_global_load_lds((const unsigned*)((const char*)(gbase) + (voff)[_i]), (PG8_LAS unsigned*)(lds + (bufoff) + ldsw + _i * 8192), 16, 0, 0); } while (0)
#define PG8_LDA(dst, b, h) do { _Pragma("unroll") for (int m = 0; m < 4; ++m) _Pragma("unroll") for (int k = 0; k < 2; ++k) dst[m][k] = *(const PG8_LAS bf16x8*)(lds + PG8_SA(b, h) + aoff + m * 2048 + k * 1024); } while (0)
#define PG8_LDB(dst, b, h) do { _Pragma("unroll") for (int n = 0; n < 2; ++n) _Pragma("unroll") for (int k = 0; k < 2; ++k) dst[n][k] = *(const PG8_LAS bf16x8*)(lds + PG8_SB(b, h) + boff + n * 2048 + k * 1024); } while (0)
#define PG8_MMA(ai, bj, At, Bt) do { __builtin_amdgcn_s_setprio(1); _Pragma("unroll") for (int m = 0; m < 4; ++m) _Pragma("unroll") for (int n = 0; n < 2; ++n) _Pragma("unroll") for (int k = 0; k < 2; ++k) \
        acc[ai][bj][m][n] = __builtin_amdgcn_mfma_f32_16x16x32_bf16(Bt[n][k], At[m][k], acc[ai][bj][m][n], 0, 0, 0); __builtin_amdgcn_s_setprio(0); } while (0)
#define PG8_WAIT_V(n) asm volatile("s_waitcnt vmcnt(" #n ")" ::: "memory")
#define PG8_WAIT_L(n) asm volatile("s_waitcnt lgkmcnt(" #n ")" ::: "memory")
#define PG8_BAR __builtin_amdgcn_s_barrier()
#define PG8_SCHED __builtin_amdgcn_sched_barrier(0)
    Unit cur, nxt; int ui = 0;
    if (!S.next(0, cur)) return;
    f32x4 acc[2][2][4][2];
#pragma unroll
    for (int a = 0; a < 2; ++a)
#pragma unroll
        for (int b = 0; b < 2; ++b)
#pragma unroll
            for (int m = 0; m < 4; ++m)
#pragma unroll
                for (int n = 0; n < 2; ++n) acc[a][b][m][n] = (f32x4){0.f, 0.f, 0.f, 0.f};
    bf16x8 At[4][2], B0[2][2], B1[2][2];
    const char* cA = (const char*)g.A + (size_t)cur.pm * tstep; const char* cB = (const char*)g.Bt + (size_t)cur.pn * tstep;
    S.a_ready(cur);
    if constexpr (SP2) {
        PG8_STAGE(PG8_SB(0, 0), cB, voffB); PG8_STAGE(PG8_SB(0, 1), cB + hstep, voffB); PG8_STAGE(PG8_SA(0, 0), cA, voffA); PG8_STAGE(PG8_SA(0, 1), cA + hstep, voffA);
        if (wr == 1) PG8_BAR;
        PG8_WAIT_V(2); PG8_BAR;
        PG8_STAGE(PG8_SB(1, 0), cB + kstep, voffB); PG8_STAGE(PG8_SA(1, 0), cA + kstep, voffA); PG8_STAGE(PG8_SB(1, 1), cB + hstep + kstep, voffB);
        PG8_WAIT_V(6); PG8_BAR;
    } else {
        PG8_STAGE(PG8_SB(0, 0), cB, voffB); PG8_STAGE(PG8_SA(0, 0), cA, voffA); PG8_STAGE(PG8_SB(0, 1), cB + hstep, voffB); PG8_STAGE(PG8_SA(0, 1), cA + hstep, voffA);
        if (wr == 1) PG8_BAR;
        PG8_WAIT_V(4); PG8_BAR;
        PG8_STAGE(PG8_SB(1, 0), cB + kstep, voffB); PG8_STAGE(PG8_SA(1, 0), cA + kstep, voffA); PG8_STAGE(PG8_SB(1, 1), cB + hstep + kstep, voffB);
        PG8_WAIT_V(6); PG8_BAR;
    }
    for (;;) {
        const bool has_next = S.next(ui + 1, nxt);
        const char* nA = has_next ? (const char*)g.A + (size_t)nxt.pm * tstep : cA; const char* nB = has_next ? (const char*)g.Bt + (size_t)nxt.pn * tstep : cB;
        for (int t = 0; t < nt; t += 2) {
            const bool last = (t == nt - 2);
            const char* a1 = cA + (size_t)(t + 1) * kstep;
            const char* a2 = last ? nA : cA + (size_t)(t + 2) * kstep; const char* b2 = last ? nB : cB + (size_t)(t + 2) * kstep;
            const char* a3 = a2 + kstep; const char* b3 = b2 + kstep;
            if (last && has_next) S.a_ready(nxt);
            if constexpr (SP2) {
            PG8_LDB(B0, 0, 0); PG8_LDB(B1, 0, 1); PG8_SCHED; PG8_LDA(At, 0, 0); PG8_STAGE(PG8_SA(1, 1), a1 + hstep, voffA);
            PG8_WAIT_V(8); PG8_WAIT_L(0); PG8_BAR; PG8_MMA(0, 0, At, B0); PG8_MMA(0, 1, At, B1); PG8_BAR; PG8_SCHED;
            PG8_LDA(At, 0, 1); PG8_STAGE(PG8_SB(0, 0), b2, voffB); PG8_STAGE(PG8_SB(0, 1), b2 + hstep, voffB); PG8_STAGE(PG8_SA(0, 0), a2, voffA);
            PG8_WAIT_V(8); PG8_WAIT_L(0); PG8_BAR; PG8_MMA(1, 0, At, B0); PG8_MMA(1, 1, At, B1); PG8_BAR; PG8_SCHED;
            PG8_LDB(B0, 1, 0); PG8_LDB(B1, 1, 1); PG8_SCHED; PG8_LDA(At, 1, 0); PG8_STAGE(PG8_SA(0, 1), a2 + hstep, voffA);
            PG8_WAIT_V(8); PG8_WAIT_L(0); PG8_BAR; PG8_MMA(0, 0, At, B0); PG8_MMA(0, 1, At, B1); PG8_BAR; PG8_SCHED;
            PG8_LDA(At, 1, 1); PG8_STAGE(PG8_SB(1, 0), b3, voffB); PG8_STAGE(PG8_SB(1, 1), b3 + hstep, voffB); PG8_STAGE(PG8_SA(1, 0), a3, voffA);
            PG8_WAIT_V(8); PG8_WAIT_L(0); PG8_BAR; PG8_MMA(1, 0, At, B0); PG8_MMA(1, 1, At, B1); PG8_BAR; PG8_SCHED;
            } else {
            PG8_LDB(B0, 0, 0); PG8_SCHED; PG8_LDA(At, 0, 0); PG8_STAGE(PG8_SA(1, 1), a1 + hstep, voffA);
            PG8_WAIT_L(8); PG8_BAR; PG8_WAIT_L(0); PG8_MMA(0, 0, At, B0); PG8_BAR; PG8_SCHED;
            PG8_LDB(B1, 0, 1); PG8_STAGE(PG8_SB(0, 0), b2, voffB);
            PG8_BAR; PG8_WAIT_L(0); PG8_MMA(0, 1, At, B1); PG8_BAR;
            PG8_LDA(At, 0, 1); PG8_STAGE(PG8_SA(0, 0), a2, voffA);
            PG8_BAR; PG8_WAIT_L(0); PG8_MMA(1, 0, At, B0); PG8_BAR; PG8_SCHED;
            PG8_STAGE(PG8_SB(0, 1), b2 + hstep, voffB);
            PG8_WAIT_V(6); PG8_BAR; PG8_MMA(1, 1, At, B1); PG8_BAR;
            PG8_LDB(B0, 1, 0); PG8_SCHED; PG8_LDA(At, 1, 0); PG8_STAGE(PG8_SA(0, 1), a2 + hstep, voffA);
            PG8_WAIT_L(8); PG8_BAR; PG8_WAIT_L(0); PG8_MMA(0, 0, At, B0); PG8_BAR; PG8_SCHED;
            PG8_LDB(B1, 1, 1); PG8_STAGE(PG8_SB(1, 0), b3, voffB);
            PG8_BAR; PG8_WAIT_L(0); PG8_MMA(0, 1, At, B1); PG8_BAR;
            PG8_LDA(At, 1, 1); PG8_STAGE(PG8_SA(1, 0), a3, voffA);
            PG8_BAR; PG8_WAIT_L(0); PG8_MMA(1, 0, At, B0); PG8_BAR; PG8_SCHED;
            PG8_STAGE(PG8_SB(1, 1), b3 + hstep, voffB);
            PG8_WAIT_V(6); PG8_BAR; PG8_MMA(1, 1, At, B1); PG8_BAR;
            }
        }
        if constexpr (ALIGN_EPI) { if (wr == 0) PG8_BAR; }
        if constexpr (!Epi::AFTER_DRAIN) { E(acc, cur, wr, wc, fr, fq); S.done(cur); }
        if (!has_next) break;
#pragma unroll
        for (int a = 0; a < 2; ++a)
#pragma unroll
            for (int b = 0; b < 2; ++b)
#pragma unroll
                for (int m = 0; m < 4; ++m)
#pragma unroll
                    for (int n = 0; n < 2; ++n) acc[a][b][m][n] = (f32x4){0.f, 0.f, 0.f, 0.f};
        cur = nxt; cA = nA; cB = nB; ++ui;
        if constexpr (ALIGN_EPI) { if (wr == 1) PG8_BAR; }
    }
    PG8_WAIT_V(0);
    if constexpr (!ALIGN_EPI) { if (wr == 0) PG8_BAR; }
    PG8_BAR;
    if constexpr (Epi::AFTER_DRAIN) { E.fused(acc, cur, wr, wc, fr, fq, lds, wid, lane); S.done(cur); }
#undef PG8_SA
#undef PG8_SB
#undef PG8_STAGE
#undef PG8_LDA
#undef PG8_LDB
#undef PG8_MMA
#undef PG8_WAIT_V
#undef PG8_WAIT_L
#undef PG8_BAR
#undef PG8_SCHED
}
}
#ifndef PG8_SP2
#define PG8_SP2 true
#endif
#ifndef PG8_ALIGN
#define PG8_ALIGN true
#endif
#include <hip/hip_bf16.h>
#include <cmath>
namespace attn128 {
using bf16=__hip_bfloat16;
using bf16x8=__attribute__((ext_vector_type(8)))short;
using s16x4=__attribute__((ext_vector_type(4)))short;
using f32x16=__attribute__((ext_vector_type(16)))float;
using u32x4=__attribute__((ext_vector_type(4)))unsigned;
constexpr int BATCH=2,NHEAD=8,SEQ=8192,D=64,DV=128,DM=512;
constexpr int NW=8,QBLK=32,QB=QBLK*NW,KVBLK=64,NQB=SEQ/QB;
constexpr int ATTN_PITCH=DM, ATTN_UNIT_ROWS=QB;
__device__ __forceinline__ int crow(int r,int hi){return (r&3)+8*(r>>2)+4*hi;}
#define SBAR() __builtin_amdgcn_sched_barrier(0)
__device__ __forceinline__ void cmask(f32x16&p0,f32x16&p1,int jb,int qrel,int hi){
  const float NEG=-INFINITY; int kb=64*jb+4*hi;
  #pragma unroll
  for(int r=0;r<16;++r){int kv=kb+(r&3)+8*(r>>2); if(kv>qrel)p0[r]=NEG; if(kv+32>qrel)p1[r]=NEG;}
}

constexpr int NSLOT=3, SLOTB=8192;
constexpr int LDS_K=0, LDS_V=NSLOT*SLOTB, LDS_WS=3*NSLOT*SLOTB, LDS_OST=LDS_WS+NW*64*4, LDS_BYTES=LDS_OST+NW*4096;
constexpr float C2=0.125f*1.4426950408889634f;
__device__ __forceinline__ void glds16(const void*gsrc,unsigned lds_dst){unsigned keep;
  asm volatile("s_mov_b32 %0, m0\n\ts_mov_b32 m0, %2\n\ts_nop 0\n\tglobal_load_lds_dwordx4 %1, off\n\ts_mov_b32 m0, %0":"=&s"(keep):"v"(gsrc),"s"(lds_dst):"memory");}
__device__ __forceinline__ float max3f(float a,float b,float c){float r;asm("v_max3_f32 %0, %1, %2, %3":"=v"(r):"v"(a),"v"(b),"v"(c));return r;}
__device__ __forceinline__ float max2f(float a,float b){float r;asm("v_max_f32_e32 %0, %1, %2":"=v"(r):"v"(a),"v"(b));return r;}
__device__ __forceinline__ float fadd_s(float a,float b){float r;asm("v_add_f32_e32 %0, %1, %2":"=v"(r):"v"(a),"v"(b));return r;}
__device__ __forceinline__ float fsub_s(float a,float b){float r;asm("v_sub_f32_e32 %0, %1, %2":"=v"(r):"v"(a),"v"(b));return r;}
typedef float f32x2_t __attribute__((ext_vector_type(2))); typedef __bf16 bf16x2_t __attribute__((ext_vector_type(2)));
__device__ __forceinline__ unsigned cvtpk_s(float lo,float hi){f32x2_t v={lo,hi};bf16x2_t b=__builtin_convertvector(v,bf16x2_t);return __builtin_bit_cast(unsigned,b);}
#define WAIT_BAR(N) asm volatile("s_waitcnt vmcnt(" #N ") lgkmcnt(0)\n\ts_barrier":::"memory")

__device__ __forceinline__ void qkt(f32x16&p0,f32x16&p1,const char*Kslot,const bf16x8*qr,int r32,int hi){
  const char*kb=Kslot+hi*1024+r32*16;
  #pragma unroll
  for(int d0=0;d0<4;++d0){
    const bf16x8 b0=*reinterpret_cast<const bf16x8*>(kb+d0*2048);
    const bf16x8 b1=*reinterpret_cast<const bf16x8*>(kb+d0*2048+512);
    if(d0==0){p0=__builtin_amdgcn_mfma_f32_32x32x16_bf16(b0,qr[0],f32x16{},0,0,0);p1=__builtin_amdgcn_mfma_f32_32x32x16_bf16(b1,qr[0],f32x16{},0,0,0);}
    else{p0=__builtin_amdgcn_mfma_f32_32x32x16_bf16(b0,qr[d0],p0,0,0,0);p1=__builtin_amdgcn_mfma_f32_32x32x16_bf16(b1,qr[d0],p1,0,0,0);}}
}
typedef __attribute__((address_space(3))) const char* lds_cptr;
typedef short v4i16_t __attribute__((ext_vector_type(4)));
__device__ __forceinline__ void kload8(bf16x8*kf,lds_cptr kp){
  kf[0]=*(const __attribute__((address_space(3))) bf16x8*)(kp);      kf[1]=*(const __attribute__((address_space(3))) bf16x8*)(kp+512);
  kf[2]=*(const __attribute__((address_space(3))) bf16x8*)(kp+2048); kf[3]=*(const __attribute__((address_space(3))) bf16x8*)(kp+2560);
  kf[4]=*(const __attribute__((address_space(3))) bf16x8*)(kp+4096); kf[5]=*(const __attribute__((address_space(3))) bf16x8*)(kp+4608);
  kf[6]=*(const __attribute__((address_space(3))) bf16x8*)(kp+6144); kf[7]=*(const __attribute__((address_space(3))) bf16x8*)(kp+6656);
}
__device__ __forceinline__ void kload2(bf16x8*kf,lds_cptr kp,int j){ kf[2*j]=*(const __attribute__((address_space(3))) bf16x8*)(kp+j*2048); kf[2*j+1]=*(const __attribute__((address_space(3))) bf16x8*)(kp+j*2048+512); }
__device__ __forceinline__ s16x4 vtr(lds_cptr p){ return __builtin_bit_cast(s16x4,__builtin_amdgcn_ds_read_tr16_b64_v4i16((__attribute__((address_space(3))) v4i16_t*)p)); }
__device__ __forceinline__ float rowmax(const f32x16&p0,const f32x16&p1){
  float a=max3f(p0[0],p0[1],p1[0]),b=max3f(p0[2],p0[3],p1[1]);a=max3f(a,p1[2],p1[3]);
  #pragma unroll
  for(int r=4;r<16;r+=4){a=max3f(a,p0[r],p0[r+1]);b=max3f(b,p0[r+2],p0[r+3]);a=max3f(a,p1[r],p1[r+1]);b=max3f(b,p1[r+2],p1[r+3]);}
  const float m=max2f(a,b);
  auto rr=__builtin_amdgcn_permlane32_swap(__float_as_uint(m),__float_as_uint(m),false,false);
  return max2f(__uint_as_float(rr[0]),__uint_as_float(rr[1]));
}
__device__ __forceinline__ void pv(f32x16*o,int vb,bf16x8 pa0,bf16x8 pa1,bf16x8 pa2,bf16x8 pa3){
  #pragma unroll
  for(int d0=0;d0<4;++d0){s16x4 lo[4],hi[4];
    #pragma unroll
    for(int ks=0;ks<4;++ks){
      asm volatile("ds_read_b64_tr_b16 %0,%1 offset:%c2":"=&v"(lo[ks]):"v"(vb),"i"(d0*4096+ks*1024):"memory");
      asm volatile("ds_read_b64_tr_b16 %0,%1 offset:%c2":"=&v"(hi[ks]):"v"(vb),"i"(d0*4096+ks*1024+512):"memory");}
    asm volatile("s_waitcnt lgkmcnt(0)":::"memory");SBAR();
    #define PK(k) (bf16x8){lo[k][0],lo[k][1],lo[k][2],lo[k][3],hi[k][0],hi[k][1],hi[k][2],hi[k][3]}
    o[d0]=__builtin_amdgcn_mfma_f32_32x32x16_bf16(pa0,PK(0),o[d0],0,0,0);
    o[d0]=__builtin_amdgcn_mfma_f32_32x32x16_bf16(pa1,PK(1),o[d0],0,0,0);
    o[d0]=__builtin_amdgcn_mfma_f32_32x32x16_bf16(pa2,PK(2),o[d0],0,0,0);
    o[d0]=__builtin_amdgcn_mfma_f32_32x32x16_bf16(pa3,PK(3),o[d0],0,0,0);
    #undef PK
  }
}

#ifndef ATTN_STORE16
#define ATTN_STORE16(p,v) asm volatile("global_store_dwordx4 %0, %1, off sc1\n\ts_nop 1" :: "v"(p), "v"(v) : "memory")
#endif
template<int THRL,bool FAST> __device__ __forceinline__ bool attn_unit(int b,int qcol,int vcol,int qb,const bf16*Q,const bf16*__restrict__ K,const bf16*__restrict__ V,bf16*O,char*shm,const int g_wave){
  const int tid=g_wave*64+lane_id(),lane=tid&63,r32=lane&31,hi=lane>>5; const int wid=__builtin_amdgcn_readfirstlane(tid>>6);
  const long rowbase=(long)b*SEQ; const int q0=qb*QB;
  const bf16*Qw=Q+(rowbase+q0+wid*QBLK)*DM+qcol;
  const bf16*Kh=K+rowbase*DM+qcol,*Vh=V+rowbase*DM+vcol;
  const unsigned lds0=(unsigned)(uintptr_t)shm;
  float*wsf=(float*)(shm+LDS_WS)+wid*64;
  const bf16*ksrc=Kh+(long)lane*DM+wid*8;
  const bf16*vsrc=Vh+(long)(16*(wid&3)+(lane>>2))*DM+(wid>>2)*32+(lane&3)*8;
  const unsigned kdst=lds0+LDS_K+wid*1024, vdst=lds0+LDS_V+wid*1024;
  #define DMA_K(t,slot) glds16(ksrc+(long)(t)*KVBLK*DM,(unsigned)__builtin_amdgcn_readfirstlane(kdst+(slot)))
  #define DMA_V(t,slot) do{ glds16(vsrc+(long)(t)*KVBLK*DM,(unsigned)__builtin_amdgcn_readfirstlane(vdst+2*(slot))); glds16(vsrc+(long)(t)*KVBLK*DM+64,(unsigned)__builtin_amdgcn_readfirstlane(vdst+2*(slot)+8192)); }while(0)
  const int vb0=(int)(lds0+LDS_V)+((lane>>4)&1)*32+(lane&3)*8+(4*hi+((lane&15)>>2))*64;
  const char*Kbase=shm+LDS_K; bf16x8 kf[8];
  const lds_cptr shm3=(lds_cptr)shm; const lds_cptr kp0=shm3+LDS_K+hi*1024+r32*16; const lds_cptr vp0=shm3+LDS_V+((lane>>4)&1)*32+(lane&3)*8+(4*hi+((lane&15)>>2))*64;
  const int NT=(q0+QB)/KVBLK;
  volatile __attribute__((address_space(3))) unsigned*redo=(volatile __attribute__((address_space(3))) unsigned*)((__attribute__((address_space(3))) char*)shm+LDS_BYTES);
  if(FAST&&wid==0&&lane==0)*redo=0u;
  DMA_K(0,0);DMA_V(0,0);DMA_K(1,SLOTB);
  bf16x8 qr[4];
  #pragma unroll
  for(int d0=0;d0<4;++d0)qr[d0]=*reinterpret_cast<const bf16x8*>(&Qw[(long)r32*DM+d0*16+hi*8]);
  float mhat=0.f,l_reg=0.f;f32x16 o[4];o[0]=f32x16{};o[1]=f32x16{};o[2]=f32x16{};o[3]=f32x16{};
  const int qrel=wid*QBLK+r32;
  #define CMASK(P0,P1,t) do{int jb_=(t)-(NT-4); if(jb_>=0)cmask(P0,P1,jb_,qrel,hi);}while(0)
  bool resc=false;
  #define START(P0,P1) do{ resc=false; \
    if constexpr(!FAST){ const float rm=rowmax(P0,P1); const float dl=rm; mhat=fadd_s(mhat,dl); \
      _Pragma("unroll") for(int r=0;r<16;++r){P0[r]=fsub_s(P0[r],dl);P1[r]=fsub_s(P1[r],dl);} \
      } \
    _Pragma("unroll") for(int r=0;r<16;++r)P0[r]=__builtin_amdgcn_exp2f(P0[r]); }while(0)
  #define RESC() do{ if constexpr(!FAST) if(resc){ asm volatile("s_waitcnt lgkmcnt(0)":::"memory"); \
      _Pragma("unroll") for(int d_=0;d_<4;++d_) _Pragma("unroll") for(int r=0;r<16;++r)o[d_][r]*=wsf[crow(r,hi)]; } }while(0)
  f32x16 pA0,pA1,pB0,pB1;
  int sl_prev=0,sl_cur=0,sl_next=SLOTB;
  #define ROT() do{sl_prev=sl_cur;sl_cur=sl_next;sl_next=(sl_next==(NSLOT-1)*SLOTB)?0:sl_next+SLOTB;}while(0)
  DMA_K(2,2*SLOTB);
  WAIT_BAR(4);
  qkt(pA0,pA1,Kbase,qr,r32,hi);asm volatile("s_nop 15\n\ts_nop 7":"+v"(pA0),"+v"(pA1));CMASK(pA0,pA1,0);
  START(pA0,pA1);
  _Pragma("unroll") for(int r=0;r<16;++r)pA1[r]=__builtin_amdgcn_exp2f(pA1[r]);
  WAIT_BAR(0);
  DMA_K(3,0);DMA_V(1,SLOTB);
  ROT();
  kload8(kf,kp0+sl_cur);
  WAIT_BAR(3);
  s16x4 vlo[8],vhi[8]; u32x4 pw0,pw1,pw2,pw3;
  #define PKW(P,B) cvtpk_s(P[B],P[B+1])
  #define PAF(k) __builtin_bit_cast(bf16x8,pw##k)
  #define VFR(i) (bf16x8){vlo[(i)&7][0],vlo[(i)&7][1],vlo[(i)&7][2],vlo[(i)&7][3],vhi[(i)&7][0],vhi[(i)&7][1],vhi[(i)&7][2],vhi[(i)&7][3]}
  #define PIN(x) asm volatile("":"+v"(x))
  #define MX3(a,b,c) __builtin_fmaxf(__builtin_fmaxf((a),(b)),(c))
  #define GAPA(MF,A0,A1,A2,A3,W0,W1,PW) do{ MF; sacc+=A0; sacc+=A1; sacc+=A2; sacc+=A3; PIN(sacc); W0; W1; PIN(PW); SBAR(); }while(0)
  #define EX(v) __builtin_amdgcn_exp2f(v)
  #define GAPB(MF,X,B) do{ MF; if constexpr(FAST){ X[B]=EX(X[B]); X[B+1]=EX(X[B+1]); } else { X[B]=EX(X[B]-mhat); X[B+1]=EX(X[B+1]-mhat); } PIN(X); SBAR(); }while(0)
  #define VRD(i) do{ vlo[(i)&7]=vtr(vp_+(((i)>>2)*4096+((i)&3)*1024)); vhi[(i)&7]=vtr(vp_+(((i)>>2)*4096+((i)&3)*1024+512)); }while(0)
  #define VRDB(i) do{ VRD(i); SBAR(); }while(0)
  #define KRD(G,j) do{ if(G){ kload2(kf,kp0+sl_next,j); SBAR(); } }while(0)
  #define STEP(C0,C1,P0,P1,t,GK,GV,GL) do{ SBAR(); \
    const lds_cptr vp_=vp0+2*sl_prev; \
    VRD(0); SBAR(); float sacc=(P0[0]+P0[1]); \
    GAPA(C0=__builtin_amdgcn_mfma_f32_32x32x16_bf16(kf[0],qr[0],f32x16{},0,0,0), P0[2],P0[3],P0[4],P0[5],     pw0[0]=PKW(P0,0), pw0[1]=PKW(P0,2), pw0); \
    GAPA(C1=__builtin_amdgcn_mfma_f32_32x32x16_bf16(kf[1],qr[0],f32x16{},0,0,0), P0[6],P0[7],P0[8],P0[9],     pw0[2]=PKW(P0,4), pw0[3]=PKW(P0,6), pw0); \
    VRD(1); SBAR(); GAPA(C0=__builtin_amdgcn_mfma_f32_32x32x16_bf16(kf[2],qr[1],C0,0,0,0),   P0[10],P0[11],P0[12],P0[13], pw1[0]=PKW(P0,8), pw1[1]=PKW(P0,10), pw1); \
    GAPA(C1=__builtin_amdgcn_mfma_f32_32x32x16_bf16(kf[3],qr[1],C1,0,0,0),   P0[14],P0[15],P1[0],P1[1],   pw1[2]=PKW(P0,12),pw1[3]=PKW(P0,14), pw1); \
    VRD(2); SBAR(); GAPA(C0=__builtin_amdgcn_mfma_f32_32x32x16_bf16(kf[4],qr[2],C0,0,0,0),   P1[2],P1[3],P1[4],P1[5],     pw2[0]=PKW(P1,0), pw2[1]=PKW(P1,2), pw2); \
    GAPA(C1=__builtin_amdgcn_mfma_f32_32x32x16_bf16(kf[5],qr[2],C1,0,0,0),   P1[6],P1[7],P1[8],P1[9],     pw2[2]=PKW(P1,4), pw2[3]=PKW(P1,6), pw2); \
    VRD(3); SBAR(); GAPA(C0=__builtin_amdgcn_mfma_f32_32x32x16_bf16(kf[6],qr[3],C0,0,0,0),   P1[10],P1[11],P1[12],P1[13], pw3[0]=PKW(P1,8), pw3[1]=PKW(P1,10), pw3); \
    GAPA(C1=__builtin_amdgcn_mfma_f32_32x32x16_bf16(kf[7],qr[3],C1,0,0,0),   P1[14],P1[15],0.f,0.f,       pw3[2]=PKW(P1,12),pw3[3]=PKW(P1,14), pw3); \
    l_reg+=sacc; \
    if(GK){DMA_K((t)+3,sl_cur);} if(GV){DMA_V((t)+1,sl_next);} \
    CMASK(C0,C1,t); \
    if constexpr(!FAST){ float a=MX3(C0[0],C0[1],C1[0]),b=MX3(C0[2],C0[3],C1[1]); a=MX3(a,C1[2],C1[3]); \
      _Pragma("unroll") for(int r=4;r<16;r+=4){a=MX3(a,C0[r],C0[r+1]);b=MX3(b,C0[r+2],C0[r+3]);a=MX3(a,C1[r],C1[r+1]);b=MX3(b,C1[r+2],C1[r+3]);} \
      float rm=__builtin_fmaxf(a,b); { auto rr=__builtin_amdgcn_permlane32_swap(__float_as_uint(rm),__float_as_uint(rm),false,false); rm=__builtin_fmaxf(__uint_as_float(rr[0]),__uint_as_float(rr[1])); } \
      resc=false; const float rel_=rm-mhat;     \
      if(__builtin_expect(__any(rel_>(float)THRL),0)){ const float dl=__builtin_fmaxf(rel_,0.f); mhat+=dl; \
        const float f=__builtin_amdgcn_exp2f(-dl); l_reg*=f; if(hi==0)wsf[r32]=f; resc=true; } } \
    SBAR(); \
      \
    GAPB(o[0]=__builtin_amdgcn_mfma_f32_32x32x16_bf16(PAF(0),VFR(0),o[0],0,0,0), C0,0);   VRDB(4); \
    GAPB(o[0]=__builtin_amdgcn_mfma_f32_32x32x16_bf16(PAF(1),VFR(1),o[0],0,0,0), C0,2);   VRDB(5); \
    GAPB(o[0]=__builtin_amdgcn_mfma_f32_32x32x16_bf16(PAF(2),VFR(2),o[0],0,0,0), C0,4);   VRDB(6); \
    GAPB(o[0]=__builtin_amdgcn_mfma_f32_32x32x16_bf16(PAF(3),VFR(3),o[0],0,0,0), C0,6);   VRDB(7); \
    GAPB(o[1]=__builtin_amdgcn_mfma_f32_32x32x16_bf16(PAF(0),VFR(4),o[1],0,0,0), C0,8);   VRDB(8); \
    GAPB(o[1]=__builtin_amdgcn_mfma_f32_32x32x16_bf16(PAF(1),VFR(5),o[1],0,0,0), C0,10);  VRDB(9); \
    GAPB(o[1]=__builtin_amdgcn_mfma_f32_32x32x16_bf16(PAF(2),VFR(6),o[1],0,0,0), C0,12);  VRDB(10); \
    GAPB(o[1]=__builtin_amdgcn_mfma_f32_32x32x16_bf16(PAF(3),VFR(7),o[1],0,0,0), C0,14);  VRDB(11); \
    GAPB(o[2]=__builtin_amdgcn_mfma_f32_32x32x16_bf16(PAF(0),VFR(8),o[2],0,0,0), C1,0);   VRDB(12); \
    GAPB(o[2]=__builtin_amdgcn_mfma_f32_32x32x16_bf16(PAF(1),VFR(9),o[2],0,0,0), C1,2);   VRDB(13); \
    GAPB(o[2]=__builtin_amdgcn_mfma_f32_32x32x16_bf16(PAF(2),VFR(10),o[2],0,0,0), C1,4);  VRDB(14); \
    GAPB(o[2]=__builtin_amdgcn_mfma_f32_32x32x16_bf16(PAF(3),VFR(11),o[2],0,0,0), C1,6);  VRDB(15); \
    KRD(GL,0); GAPB(o[3]=__builtin_amdgcn_mfma_f32_32x32x16_bf16(PAF(0),VFR(12),o[3],0,0,0), C1,8); \
    KRD(GL,1); GAPB(o[3]=__builtin_amdgcn_mfma_f32_32x32x16_bf16(PAF(1),VFR(13),o[3],0,0,0), C1,10); \
    KRD(GL,2); GAPB(o[3]=__builtin_amdgcn_mfma_f32_32x32x16_bf16(PAF(2),VFR(14),o[3],0,0,0), C1,12); \
    KRD(GL,3); GAPB(o[3]=__builtin_amdgcn_mfma_f32_32x32x16_bf16(PAF(3),VFR(15),o[3],0,0,0), C1,14); \
    }while(0)
  int t=1;
  #undef CMASK
  #define CMASK(P0,P1,t) do{}while(0)
  for(;t+5<NT;t+=2){
    STEP(pB0,pB1,pA0,pA1,t,true,true,true);     WAIT_BAR(3); RESC(); ROT();
    STEP(pA0,pA1,pB0,pB1,t+1,true,true,true);   WAIT_BAR(3); RESC(); ROT();
  }
  #undef CMASK
  #define CMASK(P0,P1,t) do{int jb_=(t)-(NT-4); if(jb_>=0)cmask(P0,P1,jb_,qrel,hi);}while(0)
  #define ENDW(tt) do{ if((tt)+3<NT){WAIT_BAR(3);} else if((tt)+2<NT){WAIT_BAR(2);} else {WAIT_BAR(0);} }while(0)
  for(;t+1<NT;t+=2){
    STEP(pB0,pB1,pA0,pA1,t,(t+3<NT),(t+1<NT),(t+1<NT));       ENDW(t);   RESC(); ROT();
    STEP(pA0,pA1,pB0,pB1,t+1,(t+4<NT),(t+2<NT),(t+2<NT));     ENDW(t+1); RESC(); ROT();
  }
  STEP(pB0,pB1,pA0,pA1,NT-1,false,false,false); RESC();
  { float sacc=pB0[0]+pB0[1]; _Pragma("unroll") for(int r=2;r<16;++r)sacc+=pB0[r]; _Pragma("unroll") for(int r=0;r<16;++r)sacc+=pB1[r]; l_reg+=sacc;
    pw0=(u32x4){PKW(pB0,0),PKW(pB0,2),PKW(pB0,4),PKW(pB0,6)};pw1=(u32x4){PKW(pB0,8),PKW(pB0,10),PKW(pB0,12),PKW(pB0,14)};pw2=(u32x4){PKW(pB1,0),PKW(pB1,2),PKW(pB1,4),PKW(pB1,6)};pw3=(u32x4){PKW(pB1,8),PKW(pB1,10),PKW(pB1,12),PKW(pB1,14)};
    SBAR(); pv(o,vb0+2*sl_cur,PAF(0),PAF(1),PAF(2),PAF(3)); }
  #undef PKW
  #undef PAF
  #undef VFR
  #undef PIN
  #undef MX3
  #undef GAPA
  #undef GAPB
  #undef EX
  #undef VRD
  #undef VRDB
  #undef KRD
  #undef STEP
  #undef ENDW
  {auto rr=__builtin_amdgcn_permlane32_swap(__float_as_uint(l_reg),__float_as_uint(l_reg),false,false);l_reg=__uint_as_float(rr[0])+__uint_as_float(rr[1]);}
  if(FAST){ if(__any(!(l_reg>1e-30f&&l_reg<1e30f))&&lane==0)*redo=1u; }
  if(hi==0)wsf[32+r32]=l_reg;asm volatile("s_waitcnt lgkmcnt(0)":::"memory");
  float rli[16];
  #pragma unroll
  for(int r=0;r<16;++r)rli[r]=__builtin_amdgcn_rcpf(wsf[32+crow(r,hi)]);
  bf16*Ow=O+(rowbase+q0+wid*QBLK)*DM+vcol;
  { bf16*stg=(bf16*)(shm+LDS_OST)+wid*2048;
    #pragma unroll
    for(int ps=0;ps<2;++ps){
      #pragma unroll
      for(int r=0;r<16;++r){const int orow=crow(r,hi);
        #pragma unroll
        for(int d0=0;d0<2;++d0)stg[orow*64+d0*32+r32]=__float2bfloat16(o[2*ps+d0][r]*rli[r]);}
      asm volatile("s_waitcnt lgkmcnt(0)":::"memory");
      #pragma unroll
      for(int i=0;i<4;++i){const int row=i*8+(lane>>3),ch=lane&7; const u32x4 v=*(const u32x4*)(stg+row*64+ch*8); ATTN_STORE16(Ow+(long)row*DM+ps*64+ch*8,v);}
      asm volatile("s_waitcnt lgkmcnt(0)":::"memory"); } }
  asm volatile("s_waitcnt lgkmcnt(0)\n\ts_barrier":::"memory");
  bool again=false;
  if(FAST){ again=(*redo!=0u); asm volatile("s_waitcnt lgkmcnt(0)\n\ts_barrier":::"memory"); }
  #undef DMA_K
  #undef DMA_V
  #undef CMASK
  #undef START
  #undef RESC
  #undef ROT
  return again;
}
constexpr int ATTN_LDS_BYTES=LDS_BYTES;
struct AttnTensors { const bf16* Q; const bf16* K; const bf16* V; bf16* O1; bf16* O2; };
#undef SBAR
#undef WAIT_BAR
}
#define GAS __attribute__((address_space(1)))
#define LAS __attribute__((address_space(3)))
typedef unsigned short bf16;
typedef unsigned v4u __attribute__((ext_vector_type(4)));
typedef float f32x4 __attribute__((ext_vector_type(4)));
typedef short bf16x8 __attribute__((ext_vector_type(8)));
typedef GAS unsigned gu32;
typedef GAS unsigned long long gu64;
#define RLX_AGENT __ATOMIC_RELAXED, __HIP_MEMORY_SCOPE_AGENT
#define LDS_WAIT() asm volatile("s_waitcnt lgkmcnt(0)" ::: "memory")
#define VM_WAIT() asm volatile("s_waitcnt vmcnt(0)" ::: "memory")
__device__ __forceinline__ unsigned long long rt() { return __builtin_amdgcn_s_memrealtime(); }
__device__ __forceinline__ unsigned f2bf(float f) { unsigned u = __builtin_bit_cast(unsigned, f); return (u + 0x7fffu + ((u >> 16) & 1u)) >> 16; }
__device__ __forceinline__ unsigned pk2(float lo, float hi) { return f2bf(lo) | (f2bf(hi) << 16); }
#define XB_TMO      128
#define XB_XCNT(j)  (256  + 64 * (j))
#define XB_XSUB(j)  (1280 + 64 * (j))
#define XB_XGEN(j)  (2304 + 64 * (j))
#define XB_TOP      3328
#define XB_TOPGEN   3392
#define XCD_BAR_WORDS 3456
#define XB_SPIN_CAP (1u << 18)

__device__ __forceinline__ unsigned xb_ld(unsigned* p)              { return __hip_atomic_load(p, __ATOMIC_RELAXED, __HIP_MEMORY_SCOPE_AGENT); }
__device__ __forceinline__ unsigned xb_add(unsigned* p, unsigned v) { return __hip_atomic_fetch_add(p, v, __ATOMIC_RELAXED, __HIP_MEMORY_SCOPE_AGENT); }
__device__ __forceinline__ unsigned xb_xcc_id() { return (unsigned)__builtin_amdgcn_s_getreg((3 << 11) | 20) & 0xFu; }
#define XB_SPIN(cond, bar) do { unsigned _sp = 0; while (cond) { __builtin_amdgcn_s_sleep(1); \
    if ((++_sp & 255u) == 0u) { if (xb_ld(&(bar)[XB_TMO])) break; if (_sp > XB_SPIN_CAP) { atomicAdd(&(bar)[XB_TMO], 1u); break; } } } } while (0)

struct XcdBarrier {
    unsigned* bar; unsigned x; int wave;
    volatile LAS unsigned* st;
};

__device__ __forceinline__ XcdBarrier xcd_barrier_post(unsigned* bar, volatile LAS unsigned* st, const int g_wave) {
    XcdBarrier b; b.bar = bar; b.x = xb_xcc_id(); b.st = st; b.wave = g_wave;
    if (g_wave == 0 && lane_id() == 0) (void)xb_add(&bar[XB_XCNT(b.x)], 1u);
    return b;
}
__device__ __forceinline__ void xcd_barrier_complete(unsigned* bar, unsigned x, unsigned& nloc, unsigned& nx) {
    const unsigned G = gridDim.x * gridDim.y * gridDim.z;
    unsigned sum, cnt, mine, sp = 0u;
    for (;;) {
        sum = 0u; cnt = 0u; mine = 0u;
#pragma unroll
        for (unsigned j = 0; j < 16; ++j) { const unsigned c = xb_ld(&bar[XB_XCNT(j)]); sum += c; cnt += (c > 0u) ? 1u : 0u; mine = (j == x) ? c : mine; }
        if (sum == G) break;
        __builtin_amdgcn_s_sleep(1);
        if ((++sp & 255u) == 0u) { if (xb_ld(&bar[XB_TMO])) break; if (sp > XB_SPIN_CAP) { atomicAdd(&bar[XB_TMO], 1u); break; } }
    }
    nloc = mine > 0u ? mine : 1u; nx = cnt > 0u ? cnt : 1u;
}

__device__ __forceinline__ void xcd_barrier(const XcdBarrier& b) {
    asm volatile("s_waitcnt vmcnt(0)" ::: "memory");
    __syncthreads();
    if (b.wave == 0 && lane_id() == 0) {
        unsigned* bar = b.bar;
        __builtin_amdgcn_s_waitcnt(0);
        unsigned nloc = b.st[0], nx = b.st[1];
        if (nloc == 0u) { xcd_barrier_complete(bar, b.x, nloc, nx); b.st[0] = nloc; b.st[1] = nx; }
        const unsigned old = xb_add(&bar[XB_XSUB(b.x)], 1u);
        const unsigned gen = old / nloc;
        if (old + 1u == (gen + 1u) * nloc) {
            __builtin_amdgcn_fence(__ATOMIC_RELEASE, "agent");
            asm volatile("s_waitcnt vmcnt(0)" ::: "memory");
            const unsigned og = xb_add(&bar[XB_TOP], 1u);
            const unsigned tg = og / nx;
            if (og + 1u == (tg + 1u) * nx) xb_add(&bar[XB_TOPGEN], 1u);
            else XB_SPIN(xb_ld(&bar[XB_TOPGEN]) == tg, bar);
            __builtin_amdgcn_fence(__ATOMIC_ACQUIRE, "agent");
            xb_add(&bar[XB_XGEN(b.x)], 1u);
            asm volatile("s_waitcnt vmcnt(0)" ::: "memory");
        } else {
            XB_SPIN(xb_ld(&bar[XB_XGEN(b.x)]) == gen, bar);
            __builtin_amdgcn_fence(__ATOMIC_ACQUIRE, "agent");
            asm volatile("s_waitcnt vmcnt(0)" ::: "memory");
        }
    }
    __syncthreads();
}
__device__ __forceinline__ void xcd_arrive(unsigned* ctl, const int wstage, const int wtotal, const unsigned x, const unsigned nloc) {
    const unsigned old = xb_add(ctl + wstage + 64 * x, 1u);
    if (old + 1u == nloc) { __builtin_amdgcn_fence(__ATOMIC_RELEASE, "agent"); asm volatile("s_waitcnt vmcnt(0)" ::: "memory"); (void)xb_add(ctl + wtotal, nloc); }
}
constexpr size_t MiB = 1u << 20;
constexpr size_t WS_CTL = 0, CTL_ZERO_BYTES = 64 * 1024;
constexpr size_t WS_WIN = 2 * MiB;
constexpr size_t WS_WPW = 10 * MiB;
constexpr size_t WS_WOUT = 11 * MiB;
constexpr size_t WS_XN = 16 * MiB;
constexpr size_t WS_Q = 52 * MiB, WS_K = 70 * MiB, WS_V = 88 * MiB, WS_GA = 106 * MiB, WS_GC = 124 * MiB;
constexpr size_t WS_U = 142 * MiB;
constexpr size_t WS_C = 186 * MiB;
constexpr size_t WS_O1 = 204 * MiB, WS_O2 = 220 * MiB;
constexpr size_t WS_M = 236 * MiB;
constexpr size_t WS_PART = 272 * MiB;
constexpr size_t WS_MIX = 288 * MiB;
constexpr size_t WS_END = 320 * MiB;
static_assert(WS_XN + (size_t)MT * 1024 * 2 <= WS_Q && WS_Q + (size_t)MT * 512 * 2 <= WS_K && WS_U + (size_t)U_ROWS * 512 * 4 <= WS_C && WS_C + (size_t)MT * 512 * 2 <= WS_O1 && WS_M + (size_t)MT * 1024 * 2 <= WS_END, "d_ws map");
constexpr int CW_XCONV = 8192 + 64 * 8, CW_XATTN = 8192 + 64 * 24;
constexpr int CW_CONV = 8192 + 64 * 4, CW_ATTN = 8192 + 64 * 5, CW_TICKET = 8192 + 64 * 6;
constexpr int CW_PCNT = 6656, CW_PQ = 0, CW_PTAIL = 8192 + 64 * 62, CW_PHEAD = 8192 + 64 * 63;
constexpr int CW_PAIR = 12288;
constexpr int CW_QUEUE = 4608, CW_QTAIL = 8192 + 64 * 60, CW_QHEAD = 8192 + 64 * 61;
constexpr int CW_SROW = 8192;
constexpr int CW_BAR = 1024;
__device__ __forceinline__ void panel_post(unsigned* ctl, const int pm) {
    if (xb_add(ctl + CW_PCNT + 16 * pm, 1u) == 5u) { const unsigned j = xb_add(ctl + CW_PTAIL, 4u);
#pragma unroll
        for (unsigned pn = 0; pn < 4; ++pn) __hip_atomic_store(ctl + CW_PQ + 4 * ((j + pn) & 255u), (unsigned)pm * 4u + pn + 1u, RLX_AGENT); }
}
constexpr int NWAVES = 8;
constexpr int RING_OFF = 0, RING_BYTES = 131072;
constexpr int LDSCTL_OFF = RING_BYTES, MISC_OFF = LDSCTL_OFF + 320;
constexpr int LDS_BYTES = 147456;

struct Frame {
    LAS unsigned char* lds;
    volatile LAS unsigned* MISC;
    gu32* ctl;
    int wave;
    int vcu, G;
};
struct Args { const float* in[21]; float* out; unsigned char* ws; };
#define WSP(T, off) ((T*)(A.ws + (off)))
template <int CTRL> __device__ __forceinline__ float dppf(float x) { return __builtin_bit_cast(float, __builtin_amdgcn_mov_dpp(__builtin_bit_cast(int, x), CTRL, 0xf, 0xf, true)); }
__device__ __forceinline__ float xrow_sum(float x) {
    auto a = __builtin_amdgcn_permlane16_swap(__float_as_uint(x), __float_as_uint(x), false, false); x = __uint_as_float(a[0]) + __uint_as_float(a[1]);
    auto b = __builtin_amdgcn_permlane32_swap(__float_as_uint(x), __float_as_uint(x), false, false); return __uint_as_float(b[0]) + __uint_as_float(b[1]); }
__device__ __forceinline__ float xrow_max(float x) {
    auto a = __builtin_amdgcn_permlane16_swap(__float_as_uint(x), __float_as_uint(x), false, false); x = fmaxf(__uint_as_float(a[0]), __uint_as_float(a[1]));
    auto b = __builtin_amdgcn_permlane32_swap(__float_as_uint(x), __float_as_uint(x), false, false); return fmaxf(__uint_as_float(b[0]), __uint_as_float(b[1])); }
__device__ __forceinline__ float row16_sum(float v) {
    v += dppf<0xB1>(v); v += dppf<0x4E>(v); v += dppf<0x141>(v); v += dppf<0x140>(v); return v; }
__device__ __forceinline__ float wave_sum(float v) { return xrow_sum(row16_sum(v)); }
__device__ __forceinline__ void p0_transpose_item(const float* W, int K, int N, bf16* WT, int k0, int n0, int dst0, LAS float* scr, int lane) {
#pragma unroll 8
    for (int i = 0; i < 32; ++i) { const int kk = 2 * i + (lane >> 5); scr[kk * 33 + (lane & 31)] = W[(size_t)(k0 + kk) * N + n0 + (lane & 31)]; }
    LDS_WAIT(); asm volatile("" ::: "memory");
    const int c = lane & 7;
#pragma unroll
    for (int j = 0; j < 4; ++j) { const int n = (lane >> 3) + 8 * j; const LAS float* s = scr + (8 * c) * 33 + n;
        v4u o; o.x = pk2(s[0 * 33], s[1 * 33]); o.y = pk2(s[2 * 33], s[3 * 33]); o.z = pk2(s[4 * 33], s[5 * 33]); o.w = pk2(s[6 * 33], s[7 * 33]);
        *(GAS v4u*)(WT + (size_t)(dst0 + n) * K + k0 + 8 * c) = o; }
    LDS_WAIT(); asm volatile("" ::: "memory");
}
__device__ __forceinline__ int win_dst_row(int n0) {
    if (n0 < 2048 || n0 >= 3072) return n0;
    int j = n0 - 2048; const int isb = j >= 512; if (isb) j -= 512;
    return 2048 + 256 * (j >> 7) + 128 * isb + (j & 127);
}
__device__ __forceinline__ void rms_row_to_bf16(const float* xrow, const f32x4 (&gv)[4], bf16* orow, int lane) {
    const GAS f32x4* xr = (const GAS f32x4*)xrow + lane;
    f32x4 v[4]; float s = 0.f;
#pragma unroll
    for (int j = 0; j < 4; ++j) { v[j] = xr[64 * j]; s += (v[j].x * v[j].x + v[j].y * v[j].y) + (v[j].z * v[j].z + v[j].w * v[j].w); }
    const float rs = 1.0f / sqrtf(wave_sum(s) * (1.f / D_MODEL) + EPS);
    GAS unsigned long long* o8 = (GAS unsigned long long*)orow + lane;
#pragma unroll
    for (int j = 0; j < 4; ++j) o8[64 * j] = (unsigned long long)pk2(v[j].x * rs * gv[j].x, v[j].y * rs * gv[j].y) | ((unsigned long long)pk2(v[j].z * rs * gv[j].z, v[j].w * rs * gv[j].w) << 32);
}
__device__ __forceinline__ void p0_prologue(Frame& F, const Args& A) {
    const float *w_in = A.in[7], *w_pw2 = A.in[17], *w_out = A.in[19], *xp = A.in[0], *xs = A.in[1]; bf16 *Win_t = WSP(bf16, WS_WIN), *Wpw_t = WSP(bf16, WS_WPW), *Wout_t = WSP(bf16, WS_WOUT), *XN = WSP(bf16, WS_XN);
    LAS float* scr = (LAS float*)(F.lds + RING_OFF + F.wave * 16384);
    const int gw = F.vcu * NWAVES + F.wave, NGW = F.G * NWAVES;
    constexpr int I_IN = (1024 / 64) * (D_IN / 32), I_PW = (512 / 64) * (512 / 32), I_OUT = (1024 / 64) * (1024 / 32);
    f32x4 gv[4];
#pragma unroll
    for (int j = 0; j < 4; ++j) gv[j] = *((const f32x4*)A.in[6] + lane_id() + 64 * j);
#pragma nounroll
    for (int ph = 0; ph < 2; ++ph) {
    if (((F.wave & 1) != 0) == (ph != 0)) {
    for (int it = gw; it < I_IN; it += NGW) {
        int r = it;
        if (r < I_IN) { const int nblk = D_IN / 32, kb = r / nblk, nb = r % nblk; p0_transpose_item(w_in, 1024, D_IN, Win_t, 64 * kb, 32 * nb, win_dst_row(32 * nb), scr, lane_id()); continue; } r -= I_IN;
        if (r < I_PW) { const int kb = r / 16, nb = r % 16; p0_transpose_item(w_pw2, 512, 512, Wpw_t, 64 * kb, 32 * nb, 32 * nb, scr, lane_id()); continue; } r -= I_PW;
        { const int kb = r / 32, nb = r % 32; p0_transpose_item(w_out, 1024, 1024, Wout_t, 64 * kb, 32 * nb, 32 * nb, scr, lane_id()); }
    }
    { bf16* U = WSP(bf16, WS_U); const float* state = A.in[4];
      for (int r = gw; r < NBATCH * HIST + DEC_B * HIST; r += NGW) { f32x4 v0 = {0.f, 0.f, 0.f, 0.f}, v1 = v0; size_t dst;
          if (r < NBATCH * HIST) dst = (size_t)((r / HIST) * UP_SEQ + r % HIST) * 512;
          else { const int q = r - NBATCH * HIST, b = q / HIST, i = q % HIST; dst = (size_t)(USMP0 + b * US_SEQ + i) * 512; v0 = *(const f32x4*)(state + (size_t)q * 512 + 8 * lane_id()); v1 = *(const f32x4*)(state + (size_t)q * 512 + 8 * lane_id() + 4); }
          v4u w; w.x = pk2(v0[0], v0[1]); w.y = pk2(v0[2], v0[3]); w.z = pk2(v1[0], v1[1]); w.w = pk2(v1[2], v1[3]);
          *(v4u*)(U + dst + 8 * lane_id()) = w; } }
    } else
    { const int lane = lane_id();
      for (int grp = NGW - 1 - gw; grp < MT / 4; grp += NGW) {
          const int m0 = 4 * grp; const float* xb = m0 < MP ? xp + (size_t)m0 * D_MODEL : xs + (size_t)(m0 - MP) * D_MODEL;
          f32x4 v[4][4];
#pragma unroll
          for (int r = 0; r < 4; ++r)
#pragma unroll
              for (int j = 0; j < 4; ++j) v[r][j] = *((const GAS f32x4*)(xb + (size_t)r * D_MODEL) + lane + 64 * j);
#pragma unroll
          for (int r = 0; r < 4; ++r) { float ss = 0.f;
#pragma unroll
              for (int j = 0; j < 4; ++j) ss += (v[r][j].x * v[r][j].x + v[r][j].y * v[r][j].y) + (v[r][j].z * v[r][j].z + v[r][j].w * v[r][j].w);
              const float rs = 1.0f / sqrtf(wave_sum(ss) * (1.f / D_MODEL) + EPS);
              GAS unsigned long long* o8 = (GAS unsigned long long*)(XN + (size_t)(m0 + r) * D_MODEL) + lane;
#pragma unroll
              for (int j = 0; j < 4; ++j) o8[64 * j] = (unsigned long long)pk2(v[r][j].x * rs * gv[j].x, v[r][j].y * rs * gv[j].y) | ((unsigned long long)pk2(v[r][j].z * rs * gv[j].z, v[r][j].w * rs * gv[j].w) << 32); } } }
    }
}
__device__ __forceinline__ void p1_idle_transposes(Frame& F, const Args& A) {
    const int nwg = (MT / 256) * (D_IN / 256), G = (int)F.G, nidle = (4 * G > nwg && 3 * G < nwg) ? 4 * G - nwg : 0, first = nidle ? G - nidle : 0;
    if ((int)blockIdx.x < first) return;
    const float *w_pw2 = A.in[17], *w_out = A.in[19]; bf16 *Wpw_t = WSP(bf16, WS_WPW), *Wout_t = WSP(bf16, WS_WOUT);
    LAS float* scr = (LAS float*)(F.lds + RING_OFF + F.wave * 16384);
    constexpr int I_PW = (512 / 64) * (512 / 32), I_OUT = (1024 / 64) * (1024 / 32);
    for (int r = ((int)blockIdx.x - first) * NWAVES + F.wave; r < I_PW + I_OUT; r += (G - first) * NWAVES) {
        if (r < I_PW) { const int kb = r / 16, nb = r % 16; p0_transpose_item(w_pw2, 512, 512, Wpw_t, 64 * kb, 32 * nb, 32 * nb, scr, lane_id()); }
        else { const int q = r - I_PW, kb = q / 32, nb = q % 32; p0_transpose_item(w_out, 1024, 1024, Wout_t, 64 * kb, 32 * nb, 32 * nb, scr, lane_id()); }
    }
}
__device__ __forceinline__ float compute_lam(Frame& F, const Args& A) {
    const float a = wave_sum(A.in[8][lane_id()] * A.in[9][lane_id()]), b = wave_sum(A.in[10][lane_id()] * A.in[11][lane_id()]);
    return __builtin_bit_cast(float, __builtin_amdgcn_readfirstlane(__builtin_bit_cast(int, expf(a) - expf(b) + 0.2f)));
}
__device__ __forceinline__ void conv_phase(Frame& F, const Args& A) {
    int tid_ = F.wave * 64 + lane_id(); asm volatile("" : "+v"(tid_)); const int lane = tid_ & 63, wave = __builtin_amdgcn_readfirstlane(tid_ >> 6);
    const bf16* U = WSP(bf16, WS_U); float* out = A.out; bf16* Cb = WSP(bf16, WS_C);
    LAS float* wl = (LAS float*)(F.lds + RING_OFF);
    for (int i = tid_; i < CONV_W * 512; i += NWAVES * 64) wl[i] = A.in[13][i];
    __syncthreads();
    const int gw = F.vcu * NWAVES + wave, NGW = F.G * NWAVES;
    for (int k = 0; k < 3; ++k) {
        const int task = k < 2 ? gw + k * NGW : (wave == 0 ? MP / 4 + F.vcu : MP / 4 + 2 * DEC_B);
        if (task >= (k < 2 ? MP / 4 : MP / 4 + 2 * DEC_B)) continue;
        int rowbase, urow0;
        if (task < MP / 4) { const int b = task >> 11, t0 = (task & 2047) * 4; rowbase = b * SEQ + t0; urow0 = b * UP_SEQ + t0; }
        else { const int q = task - MP / 4, b = q >> 1, hf = q & 1; rowbase = MP + b * 8 + 4 * hf; urow0 = USMP0 + b * US_SEQ + 4 * hf; }
        const bf16* up = U + (size_t)urow0 * 512; const int lo = 8 * lane;
        f32x4 acc[4][2];
        { const f32x4 c0 = *(const f32x4*)(A.in[14] + 8 * lane), c1 = *(const f32x4*)(A.in[14] + 8 * lane + 4);
#pragma unroll
            for (int r = 0; r < 4; ++r) { acc[r][0] = c0; acc[r][1] = c1; } }
        f32x4 W[4][2]; v4u ubuf[4][4];
#define CONV_NS 34
#define CONV_LOAD(dst, s_) do { if ((s_) < CONV_NS) { const bf16* src_ = up + (size_t)(s_) * 512;   (dst) = *(const v4u*)(src_ + lo); } } while (0)
#define CONV_FMA(s_, r_, uu) do { if ((s_) - (r_) >= 0 && (s_) - (r_) < CONV_W) { acc[r_][0] += W[((s_) - (r_)) & 3][0] * (uu)[0]; acc[r_][1] += W[((s_) - (r_)) & 3][1] * (uu)[1]; } } while (0)
#define CONV_STEP(s_, uw) do { if ((s_) < CONV_NS) { f32x4 uu[2]; uu[0][0] = __uint_as_float((uw).x << 16); uu[0][1] = __uint_as_float((uw).x & 0xffff0000u); uu[0][2] = __uint_as_float((uw).y << 16); uu[0][3] = __uint_as_float((uw).y & 0xffff0000u); \
        uu[1][0] = __uint_as_float((uw).z << 16); uu[1][1] = __uint_as_float((uw).z & 0xffff0000u); uu[1][2] = __uint_as_float((uw).w << 16); uu[1][3] = __uint_as_float((uw).w & 0xffff0000u); if ((s_) < CONV_W) { W[(s_) & 3][0] = *(const LAS f32x4*)(wl + (s_) * 512 + 8 * lane); W[(s_) & 3][1] = *(const LAS f32x4*)(wl + (s_) * 512 + 8 * lane + 4); } \
        CONV_FMA(s_, 0, uu); CONV_FMA(s_, 1, uu); CONV_FMA(s_, 2, uu); CONV_FMA(s_, 3, uu); } } while (0)
#define CONV_GROUP(gq) do { CONV_LOAD(ubuf[((gq) + 3) & 3][0], 4 * (gq) + 12); CONV_LOAD(ubuf[((gq) + 3) & 3][1], 4 * (gq) + 13); CONV_LOAD(ubuf[((gq) + 3) & 3][2], 4 * (gq) + 14); CONV_LOAD(ubuf[((gq) + 3) & 3][3], 4 * (gq) + 15); \
        CONV_STEP(4 * (gq), ubuf[(gq) & 3][0]); CONV_STEP(4 * (gq) + 1, ubuf[(gq) & 3][1]); CONV_STEP(4 * (gq) + 2, ubuf[(gq) & 3][2]); CONV_STEP(4 * (gq) + 3, ubuf[(gq) & 3][3]); asm volatile("" ::: "memory"); } while (0)
        CONV_LOAD(ubuf[0][0], 0); CONV_LOAD(ubuf[0][1], 1); CONV_LOAD(ubuf[0][2], 2); CONV_LOAD(ubuf[0][3], 3); CONV_LOAD(ubuf[1][0], 4); CONV_LOAD(ubuf[1][1], 5); CONV_LOAD(ubuf[1][2], 6); CONV_LOAD(ubuf[1][3], 7);
        CONV_LOAD(ubuf[2][0], 8); CONV_LOAD(ubuf[2][1], 9); CONV_LOAD(ubuf[2][2], 10); CONV_LOAD(ubuf[2][3], 11);
        CONV_GROUP(0); CONV_GROUP(1); CONV_GROUP(2); CONV_GROUP(3); CONV_GROUP(4); CONV_GROUP(5); CONV_GROUP(6); CONV_GROUP(7); CONV_GROUP(8);
#undef CONV_LOAD
#undef CONV_FMA
#undef CONV_STEP
#undef CONV_GROUP
        const f32x4 lg0 = *(const f32x4*)(A.in[15] + 8 * lane), lg1 = *(const f32x4*)(A.in[15] + 8 * lane + 4), lb0 = *(const f32x4*)(A.in[16] + 8 * lane), lb1 = *(const f32x4*)(A.in[16] + 8 * lane + 4);
#pragma unroll
        for (int r = 0; r < 4; ++r) {
            const f32x4 a0 = acc[r][0], a1 = acc[r][1];
            const float s1 = wave_sum(((a0[0] + a0[1]) + (a0[2] + a0[3])) + ((a1[0] + a1[1]) + (a1[2] + a1[3])));
            const float s2 = wave_sum(((a0[0] * a0[0] + a0[1] * a0[1]) + (a0[2] * a0[2] + a0[3] * a0[3])) + ((a1[0] * a1[0] + a1[1] * a1[1]) + (a1[2] * a1[2] + a1[3] * a1[3])));
            const float mean = s1 * (1.f / 512.f), var = fmaxf(s2 * (1.f / 512.f) - mean * mean, 0.f), rstd = 1.0f / sqrtf(var + EPS);
            f32x4 y0 = (a0 - mean) * rstd * lg0 + lb0, y1 = (a1 - mean) * rstd * lg1 + lb1;
#pragma unroll
            for (int i = 0; i < 4; ++i) { y0[i] = pg8::silu_f(y0[i]); y1[i] = pg8::silu_f(y1[i]); }
            *(pg8::u32x4*)(Cb + (size_t)(rowbase + r) * 512 + 8 * lane) = pg8::pack8(y0, y1);
        }
    }
    const float* state = A.in[4]; const int gt = F.vcu * 512 + tid_, GT = F.G * 512;
    for (int i = gt; i < DEC_B * (HIST - DEC_S) * 512; i += GT) { const int b = i / ((HIST - DEC_S) * 512), rem = i - b * ((HIST - DEC_S) * 512); out[OFF_CS + (size_t)b * HIST * 512 + rem] = state[(size_t)(b * HIST + DEC_S) * 512 + rem]; }
}
typedef float f32x4v __attribute__((ext_vector_type(4))); typedef float f32x2w __attribute__((ext_vector_type(2)));
constexpr float DEC_THR = 8.0f;
__device__ __forceinline__ void decode_items(Frame& F, const Args& A, const int item_first, const int item_end) {
    const GAS float *ck = (const GAS float*)A.in[2], *cv = (const GAS float*)A.in[3], *subln = (const GAS float*)A.in[12]; const GAS int* pt = (const GAS int*)A.in[5]; const GAS float* outf = (const GAS float*)A.out; GAS unsigned char* wsb = (GAS unsigned char*)A.ws;
    asm volatile("" : "+s"(ck), "+s"(cv), "+s"(subln), "+s"(pt), "+s"(outf), "+s"(wsb));
    const GAS bf16 *Qb = (const GAS bf16*)(wsb + WS_Q), *GAb = (const GAS bf16*)(wsb + WS_GA); GAS bf16* Mb = (GAS bf16*)(wsb + WS_M);
    int tid_ = F.wave * 64 + lane_id(); asm volatile("" : "+v"(tid_)); const int lane = tid_ & 63, wave = __builtin_amdgcn_readfirstlane(tid_ >> 6), c16 = lane & 15, g = lane >> 4;
    LAS float* Om = (LAS float*)(F.lds + RING_OFF);
    LAS float* ML = (LAS float*)(F.lds + RING_OFF + 65536);
    for (int item = item_first; item < item_end; item += F.G) {
        const int b = item >> 2, h = item & 3;
        bf16x8 qf[4];
        { const int qi = c16 & 7, mp = c16 >> 3; const GAS bf16* qrow = Qb + (size_t)(MP + b * DEC_S + qi) * 512 + h * 128 + mp * 64 + 4 * g;
            typedef unsigned u32x2 __attribute__((ext_vector_type(2)));
            const u32x2 a0 = *(const GAS u32x2*)(qrow), a1 = *(const GAS u32x2*)(qrow + 16), b0 = *(const GAS u32x2*)(qrow + 32), b1 = *(const GAS u32x2*)(qrow + 48);
            const v4u fa = {a0.x, a0.y, a1.x, a1.y}, fb = {b0.x, b0.y, b1.x, b1.y}, z = {0u, 0u, 0u, 0u};
            qf[0] = __builtin_bit_cast(bf16x8, mp ? z : fa); qf[1] = __builtin_bit_cast(bf16x8, mp ? z : fb);
            qf[2] = __builtin_bit_cast(bf16x8, mp ? fa : z); qf[3] = __builtin_bit_cast(bf16x8, mp ? fb : z); }
        LAS bf16x8* qlds = (LAS bf16x8*)(F.lds + RING_OFF + 73728 + wave * 4096) + lane;
#pragma unroll
        for (int kk = 0; kk < 4; ++kk) qlds[64 * kk] = qf[kk];
        const int ph0 = __builtin_amdgcn_readfirstlane(pt[b * NPAGES + 2 * wave]), ph1 = __builtin_amdgcn_readfirstlane(pt[b * NPAGES + 2 * wave + 1]);
        f32x4v acc[2][4];
#pragma unroll
        for (int jj = 0; jj < 2; ++jj)
#pragma unroll
            for (int rr = 0; rr < 4; ++rr) acc[jj][rr] = (f32x4v){0.f, 0.f, 0.f, 0.f};
        float mref = -INFINITY, lsum = 0.f;
        const int kperm = 4 * (4 * c16 + g);
        f32x4v KA[8], VA[8], KB[8], VB[8];
#define DEC_ISSUE_K(KX, tt_) do { const int pg_ = (tt_) < 8 ? ph0 : ph1; const size_t tb_ = ((size_t)pg_ * 128 + ((tt_) & 7) * 16) * 512 + h * 128; \
        const GAS float* kp_ = ck + tb_ + (size_t)(lane >> 2) * 512 + 4 * (lane & 3); \
        _Pragma("unroll") for (int j_ = 0; j_ < 8; ++j_) KX[j_] = (*(const GAS f32x4v*)(kp_ + 16 * j_)); } while (0)
#define DEC_ISSUE_V(VX, tt_) do { const int pg_ = (tt_) < 8 ? ph0 : ph1; const size_t tb_ = ((size_t)pg_ * 128 + ((tt_) & 7) * 16) * 512 + h * 128; \
        const GAS float* vp_ = cv + tb_ + (size_t)(4 * g) * 512 + 4 * c16; \
        _Pragma("unroll") for (int r_ = 0; r_ < 4; ++r_) { VX[2 * r_] = (*(const GAS f32x4v*)(vp_ + r_ * 512)); VX[2 * r_ + 1] = (*(const GAS f32x4v*)(vp_ + r_ * 512 + 64)); } } while (0)
#define DEC_TILE(KX, VX, MASKED, NEXT_OK, tn_) do { \
        bf16x8 ka_[4]; \
        _Pragma("unroll") for (int kk_ = 0; kk_ < 4; ++kk_) { const v4u w_ = {attn128::cvtpk_s(KX[2 * kk_][0], KX[2 * kk_][1]), attn128::cvtpk_s(KX[2 * kk_][2], KX[2 * kk_][3]), attn128::cvtpk_s(KX[2 * kk_ + 1][0], KX[2 * kk_ + 1][1]), attn128::cvtpk_s(KX[2 * kk_ + 1][2], KX[2 * kk_ + 1][3])}; v4u x_; _Pragma("unroll") for (int e_ = 0; e_ < 4; ++e_) x_[e_] = (unsigned)__builtin_amdgcn_ds_bpermute(kperm, (int)w_[e_]); ka_[kk_] = __builtin_bit_cast(bf16x8, x_); } \
        if (NEXT_OK) DEC_ISSUE_K(KX, tn_); \
        f32x4v s_ = {0.f, 0.f, 0.f, 0.f}; \
        _Pragma("unroll") for (int kk_ = 0; kk_ < 4; ++kk_) s_ = __builtin_amdgcn_mfma_f32_16x16x32_bf16(ka_[kk_], qlds[64 * kk_], s_, 0, 0, 0); \
        if (MASKED) { const int qi_ = c16 & 7; _Pragma("unroll") for (int r_ = 0; r_ < 4; ++r_) if (4 * g + r_ > qi_) s_[r_] = -INFINITY; } \
        float tm_ = fmaxf(fmaxf(s_[0], s_[1]), fmaxf(s_[2], s_[3])); tm_ = xrow_max(tm_); \
        if (__any(tm_ > mref + DEC_THR)) { const float mn_ = fmaxf(mref, tm_), al_ = __builtin_amdgcn_exp2f(mref - mn_); mref = mn_; lsum *= al_; \
            _Pragma("unroll") for (int jj_ = 0; jj_ < 2; ++jj_) _Pragma("unroll") for (int rr_ = 0; rr_ < 4; ++rr_) acc[jj_][rr_] *= al_; } \
        float p_[4]; \
        _Pragma("unroll") for (int r_ = 0; r_ < 4; ++r_) { p_[r_] = __builtin_amdgcn_exp2f(s_[r_] - mref); lsum += p_[r_]; } \
        const v4u pb_ = {attn128::cvtpk_s(p_[0], p_[1]), attn128::cvtpk_s(p_[2], p_[3]), 0u, 0u}; \
        _Pragma("unroll") for (int jj_ = 0; jj_ < 2; ++jj_) _Pragma("unroll") for (int rr_ = 0; rr_ < 4; ++rr_) { \
            const v4u va_ = {attn128::cvtpk_s(VX[jj_][rr_], VX[2 + jj_][rr_]), attn128::cvtpk_s(VX[4 + jj_][rr_], VX[6 + jj_][rr_]), 0u, 0u}; \
            acc[jj_][rr_] = __builtin_amdgcn_mfma_f32_16x16x32_bf16(__builtin_bit_cast(bf16x8, va_), __builtin_bit_cast(bf16x8, pb_), acc[jj_][rr_], 0, 0, 0); } \
        if (NEXT_OK) DEC_ISSUE_V(VX, tn_); } while (0)
        DEC_ISSUE_K(KA, 0); DEC_ISSUE_V(VA, 0); DEC_ISSUE_K(KB, 1); DEC_ISSUE_V(VB, 1);
        for (int tt = 0; tt < 16; tt += 2) {
            DEC_TILE(KA, VA, false, tt + 2 < 16, tt + 2);
            DEC_TILE(KB, VB, false, tt + 3 < 16, tt + 3);
        }
        if (wave == 7) {
            const GAS float* kp = outf + OFF_KS + (size_t)(b * DEC_S + ((lane >> 2) < 7 ? (lane >> 2) : 7)) * 512 + h * 128 + 4 * (lane & 3);
#pragma unroll
            for (int j = 0; j < 8; ++j) KA[j] = *(const GAS f32x4v*)(kp + 16 * j);
#pragma unroll
            for (int r = 0; r < 4; ++r) { const int key = 4 * g + r < 7 ? 4 * g + r : 7; const GAS float* vp = outf + OFF_VS + (size_t)(b * DEC_S + key) * 512 + h * 128 + 4 * c16;
                VA[2 * r] = *(const GAS f32x4v*)(vp); VA[2 * r + 1] = *(const GAS f32x4v*)(vp + 64); }
            DEC_TILE(KA, VA, true, false, 0);
        }
#undef DEC_ISSUE_K
#undef DEC_ISSUE_V
#undef DEC_TILE
        const float lt = xrow_sum(lsum);
        if (g == 0) { ML[(wave * 16 + c16) * 2] = mref; ML[(wave * 16 + c16) * 2 + 1] = lt; }
#pragma unroll
        for (int jj = 0; jj < 2; ++jj)
#pragma unroll
            for (int e = 0; e < 4; ++e) *(LAS f32x4v*)(Om + (size_t)((wave * 16 + c16) * 128 + 64 * jj + 16 * g + 4 * e)) = (f32x4v){acc[jj][0][e], acc[jj][1][e], acc[jj][2][e], acc[jj][3][e]};
        __syncthreads();
        { const int qi = wave; float on[2][2];
#pragma unroll
            for (int mp = 0; mp < 2; ++mp) { const int col = mp * 8 + qi; float M = -INFINITY;
#pragma unroll
                for (int w = 0; w < 8; ++w) M = fmaxf(M, ML[(w * 16 + col) * 2]);
                float L = 0.f, o0 = 0.f, o1 = 0.f;
#pragma unroll
                for (int w = 0; w < 8; ++w) { const float wt = __builtin_amdgcn_exp2f(ML[(w * 16 + col) * 2] - M); L = fmaf(wt, ML[(w * 16 + col) * 2 + 1], L);
                    const f32x2w ov = *(const LAS f32x2w*)(Om + (size_t)((w * 16 + col) * 128 + 2 * lane)); o0 = fmaf(wt, ov.x, o0); o1 = fmaf(wt, ov.y, o1); }
                const float inv = 1.0f / L; on[mp][0] = o0 * inv; on[mp][1] = o1 * inv; }
            const float lam = compute_lam(F, A);
            const float d0 = on[0][0] - lam * on[1][0], d1 = on[0][1] - lam * on[1][1];
            const float rs = 1.0f / sqrtf(wave_sum(d0 * d0 + d1 * d1) * (1.f / 128.f) + EPS);
            const size_t row = (size_t)(MP + b * DEC_S + qi); const int cc = h * 128 + 2 * lane;
            const unsigned gaw = *(const GAS unsigned*)(GAb + row * 512 + cc);
            const float y0 = d0 * rs * subln[2 * lane] * __uint_as_float(gaw << 16), y1 = d1 * rs * subln[2 * lane + 1] * __uint_as_float(gaw & 0xffff0000u);
            *(GAS unsigned*)(Mb + row * 1024 + cc) = pk2(y0, y1); }
        __syncthreads();
    }
}
__device__ __forceinline__ void attn_post(Frame& F, const Args& A, const int blk) {
    const float lam = compute_lam(F, A);
    const float* subln = A.in[12]; const bf16 *O1b = WSP(bf16, WS_O1), *O2b = WSP(bf16, WS_O2), *GAb = WSP(bf16, WS_GA); bf16* Mb = WSP(bf16, WS_M);
    int tid_ = F.wave * 64 + lane_id(); asm volatile("" : "+v"(tid_)); const int lane = tid_ & 63, wv = __builtin_amdgcn_readfirstlane(tid_ >> 6);
    const f32x4 sg0 = *(const f32x4*)(subln + (8 * lane & 127)), sg1 = *(const f32x4*)(subln + (8 * lane & 127) + 4);
    const int row0 = (blk >> 7) * SEQ + (blk & 31) * 256 + (lane >> 4), col = ((blk >> 5) & 3) * 128 + 8 * (lane & 15);
    for (int trip = wv; trip < 16; trip += NWAVES) {
        v4u a[4], b[4], gq[4];
#pragma unroll
        for (int r = 0; r < 4; ++r) { const size_t ro = (size_t)(row0 + 16 * trip + 4 * r) * 512 + col; a[r] = *(const v4u*)(O1b + ro); b[r] = *(const v4u*)(O2b + ro); gq[r] = *(const v4u*)(GAb + ro); }
#pragma unroll
        for (int r = 0; r < 4; ++r) {
            float o[8], gg[8]; float ss = 0.f;
#pragma unroll
            for (int i = 0; i < 4; ++i) { const unsigned aw = a[r][i], bw = b[r][i], gw_ = gq[r][i];
                o[2 * i] = __uint_as_float(aw << 16) - lam * __uint_as_float(bw << 16); o[2 * i + 1] = __uint_as_float(aw & 0xffff0000u) - lam * __uint_as_float(bw & 0xffff0000u);
                gg[2 * i] = __uint_as_float(gw_ << 16); gg[2 * i + 1] = __uint_as_float(gw_ & 0xffff0000u);
                ss += o[2 * i] * o[2 * i] + o[2 * i + 1] * o[2 * i + 1]; }
            ss = row16_sum(ss);
            const float rs = 1.0f / sqrtf(ss * (1.f / 128.f) + EPS);
            v4u w; w.x = pk2(o[0] * rs * sg0[0] * gg[0], o[1] * rs * sg0[1] * gg[1]); w.y = pk2(o[2] * rs * sg0[2] * gg[2], o[3] * rs * sg0[3] * gg[3]);
            w.z = pk2(o[4] * rs * sg1[0] * gg[4], o[5] * rs * sg1[1] * gg[5]); w.w = pk2(o[6] * rs * sg1[2] * gg[6], o[7] * rs * sg1[3] * gg[7]);
            { bf16* mp_ = Mb + (size_t)(row0 + 16 * trip + 4 * r) * 1024 + col; asm volatile("global_store_dwordx4 %0, %1, off sc1\n\ts_nop 1" :: "v"(mp_), "v"(w) : "memory"); } }
    }
}
template <bool PROMPT> __device__ __forceinline__ void final_norm(Frame& F, const Args& A, const int first_cu) {
    if (PROMPT && (int)blockIdx.x < first_cu) return;
    const float* part = WSP(float, WS_PART); const float* xs = A.in[1]; float* out = A.out;
    int tid_ = F.wave * 64 + lane_id(); asm volatile("" : "+v"(tid_)); const int lane = tid_ & 63, gw = ((int)blockIdx.x - first_cu) * NWAVES + __builtin_amdgcn_readfirstlane(tid_ >> 6), NGW = ((int)F.G - first_cu) * NWAVES;
    f32x4 gv[4];
#pragma unroll
    for (int j = 0; j < 4; ++j) gv[j] = *((const f32x4*)A.in[20] + lane + 64 * j);
    if constexpr (PROMPT) { const float* xp = A.in[0]; const bf16* mix = WSP(bf16, WS_MIX); typedef unsigned u32x2 __attribute__((ext_vector_type(2)));
      for (int grp = gw; grp < MP / 4; grp += NGW) {
        f32x4 y[4][4]; u32x2 mw[4][4];
#pragma unroll
        for (int r = 0; r < 4; ++r)
#pragma unroll
            for (int j = 0; j < 4; ++j) { y[r][j] = *((const f32x4*)(xp + (size_t)(4 * grp + r) * D_MODEL) + lane + 64 * j); mw[r][j] = *((const u32x2*)(mix + (size_t)(4 * grp + r) * D_MODEL) + lane + 64 * j); }
#pragma unroll
        for (int r = 0; r < 4; ++r) { float ss = 0.f;
#pragma unroll
            for (int j = 0; j < 4; ++j) { y[r][j][0] += __uint_as_float(mw[r][j].x << 16); y[r][j][1] += __uint_as_float(mw[r][j].x & 0xffff0000u); y[r][j][2] += __uint_as_float(mw[r][j].y << 16); y[r][j][3] += __uint_as_float(mw[r][j].y & 0xffff0000u);
                ss += (y[r][j][0] * y[r][j][0] + y[r][j][1] * y[r][j][1]) + (y[r][j][2] * y[r][j][2] + y[r][j][3] * y[r][j][3]); }
            const float rs = 1.0f / sqrtf(wave_sum(ss) * (1.f / D_MODEL) + EPS);
#pragma unroll
            for (int j = 0; j < 4; ++j) { const f32x4 yo_ = y[r][j] * rs * gv[j]; float* yp_ = out + (size_t)(4 * grp + r) * D_MODEL + 4 * (lane + 64 * j); asm volatile("global_store_dwordx4 %0, %1, off sc1\n\ts_nop 1" :: "v"(yp_), "v"(yo_) : "memory"); } }
      } }
    else for (int row = first_cu + 2 * (gw & 7), rend = row + 2; row < rend; ++row) {
        f32x4 y[4]; float ss = 0.f;
#pragma unroll
        for (int j = 0; j < 4; ++j) { const size_t o = (size_t)row * D_MODEL + 4 * lane + 256 * j;
            y[j] = *(const f32x4*)(xs + o) + ((*(const f32x4*)(part + o) + *(const f32x4*)(part + o + (size_t)MS * D_MODEL)) + (*(const f32x4*)(part + o + 2 * (size_t)MS * D_MODEL) + *(const f32x4*)(part + o + 3 * (size_t)MS * D_MODEL)));
            ss += (y[j][0] * y[j][0] + y[j][1] * y[j][1]) + (y[j][2] * y[j][2] + y[j][3] * y[j][3]); }
        const float rs = 1.0f / sqrtf(wave_sum(ss) * (1.f / D_MODEL) + EPS);
#pragma unroll
        for (int j = 0; j < 4; ++j) *((f32x4*)(out + OFF_YS + (size_t)row * D_MODEL) + lane + 64 * j) = y[j] * rs * gv[j];
    }
}

__global__ void __launch_bounds__(NWAVES * 64, 2) hymba_fwd(Args args) {
    extern __shared__ __attribute__((aligned(16))) unsigned char lds[];
    Frame F;
    F.lds = (LAS unsigned char*)lds;
    F.MISC = (volatile LAS unsigned*)(F.lds + MISC_OFF);
    F.wave = __builtin_amdgcn_readfirstlane((int)threadIdx.x >> 6);
    F.G = gridDim.x; { const int bx = blockIdx.x; F.vcu = (F.G % 8 == 0) ? (bx % 8) * (F.G / 8) + bx / 8 : bx; }
    const Args& A = args;
    F.ctl = (gu32*)(A.ws + WS_CTL);
    for (int u = F.wave * 64 + lane_id(); u < (LDS_BYTES - LDSCTL_OFF) / 4; u += NWAVES * 64) ((LAS unsigned*)(F.lds + LDSCTL_OFF))[u] = 0u;
    __syncthreads();
    XcdBarrier bar = xcd_barrier_post((unsigned*)(F.ctl + CW_BAR), F.MISC + 8, F.wave);

#ifndef SKIP_P0
    p0_prologue(F, A);
#endif
    xcd_barrier(bar);
#ifndef SKIP_G1
    { pg8::Gemm g{WSP(bf16, WS_XN), WSP(bf16, WS_WIN), MT, D_IN, D_MODEL, D_MODEL}; pg8::StaticOrder S; S.init(MT, D_IN, F.G, (int)blockIdx.x);
      pg8::EpiIn E{WSP(bf16, WS_Q), WSP(bf16, WS_K), WSP(bf16, WS_V), WSP(bf16, WS_GA), WSP(bf16, WS_GC), WSP(bf16, WS_U), A.out};
      pg8::gemm_phase<pg8::EpiIn, pg8::StaticOrder, false, PG8_SP2>(F.lds + RING_OFF, g, S, E, F.wave); }
#endif
    p1_idle_transposes(F, A);
    xcd_barrier(bar);
#ifndef SKIP_CONV
    conv_phase(F, A);
#endif
    asm volatile("s_waitcnt vmcnt(0)" ::: "memory");
    __syncthreads();
    if (F.wave == 0 && lane_id() == 0) {
        xcd_arrive((unsigned*)F.ctl, CW_XCONV, CW_CONV, bar.x, F.MISC[8]); }
    {
      const attn128::bf16 *Qp = WSP(const attn128::bf16, WS_Q), *Kp = WSP(const attn128::bf16, WS_K), *Vp = WSP(const attn128::bf16, WS_V);
      const int grp = F.vcu >> 4, s16 = F.vcu & 15, ab = grp >> 3, ah = (grp >> 1) & 3, amap = grp & 1;
      const int cmb = ((F.vcu & 31) * 3) >> 5; const bool rev = cmb != 1 || (grp & 1) != 0; const int sa = cmb, sb = cmb;
      for (int i = 0; i < 3; ++i) {
          if (i == sa) decode_items(F, A, F.vcu, DEC_B * 4);
          if (i < 2) { const int qb = ((i == 0) != rev) ? s16 : 31 - s16;
              attn128::bf16* Op = amap ? WSP(attn128::bf16, WS_O2) : WSP(attn128::bf16, WS_O1);
              if (attn128::attn_unit<8, true>(ab, ah * 128 + amap * 64, ah * 128, qb, Qp, Kp, Vp, Op, (char*)lds + RING_OFF, F.wave))
                  (void)attn128::attn_unit<8, false>(ab, ah * 128 + amap * 64, ah * 128, qb, Qp, Kp, Vp, Op, (char*)lds + RING_OFF, F.wave);
              asm volatile("s_waitcnt vmcnt(0)" ::: "memory");
              __syncthreads();
              if (F.wave == 0 && lane_id() == 0) { const int blk = (grp >> 1) * 32 + qb;
                  if (xb_add((unsigned*)(F.ctl + CW_PAIR + 16 * blk), 1u) == 1u) { const unsigned qi = xb_add((unsigned*)(F.ctl + CW_QTAIL), 1u);
                      __hip_atomic_store((unsigned*)(F.ctl + CW_QUEUE + 8 * (qi & 255u)), (unsigned)blk + 1u, RLX_AGENT); } } }

      }
    }
    asm volatile("s_waitcnt vmcnt(0)" ::: "memory");
    __syncthreads();
    if (F.wave == 0 && lane_id() == 0) {
        unsigned* tb = (unsigned*)(F.ctl + CW_BAR);
        const unsigned t = xb_add((unsigned*)(F.ctl + CW_TICKET), 1u);
        if (t < (unsigned)((MT / 256) * 2)) { XB_SPIN(xb_ld((unsigned*)(F.ctl + CW_CONV)) < (unsigned)F.G, tb); __builtin_amdgcn_fence(__ATOMIC_ACQUIRE, "agent"); asm volatile("s_waitcnt vmcnt(0)" ::: "memory"); }
        F.MISC[12] = t; }
    __syncthreads();
    { pg8::Gemm g{WSP(bf16, WS_C), WSP(bf16, WS_WPW), MT, 512, 512, 512}; pg8::TicketOrder S{__builtin_amdgcn_readfirstlane((int)F.MISC[12])};
      pg8::EpiPw2 E{A.in[18], WSP(bf16, WS_GC), WSP(bf16, WS_M)};
      pg8::gemm_phase<pg8::EpiPw2, pg8::TicketOrder, PG8_ALIGN, PG8_SP2>(F.lds + RING_OFF, g, S, E, F.wave); }
    { const int t_ = __builtin_amdgcn_readfirstlane((int)F.MISC[12]);
      if (t_ < 128) {
          asm volatile("s_waitcnt vmcnt(0)" ::: "memory");
          __syncthreads();
          if (F.wave == 0 && lane_id() == 0) panel_post((unsigned*)F.ctl, t_ >> 1); } }
    for (;;) {
        __syncthreads();
        if (F.wave == 0 && lane_id() == 0) { unsigned* tb = (unsigned*)(F.ctl + CW_BAR);
            const unsigned qi = xb_add((unsigned*)(F.ctl + CW_QHEAD), 1u); unsigned e = 0u;
            if (qi < 256u) { unsigned* qe = (unsigned*)(F.ctl + CW_QUEUE + 8 * qi); XB_SPIN((e = xb_ld(qe)) == 0u, tb);
                __builtin_amdgcn_fence(__ATOMIC_ACQUIRE, "agent"); asm volatile("s_waitcnt vmcnt(0)" ::: "memory"); }
            F.MISC[13] = e; }
        __syncthreads();
        const int e = __builtin_amdgcn_readfirstlane((int)F.MISC[13]);
        if (e == 0) break;
        attn_post(F, A, e - 1);
        asm volatile("s_waitcnt vmcnt(0)" ::: "memory");
        __syncthreads();
        if (F.wave == 0 && lane_id() == 0) panel_post((unsigned*)F.ctl, ((e - 1) >> 7) * 32 + ((e - 1) & 31));
    }
    for (;;) {
        __syncthreads();
        if (F.wave == 0 && lane_id() == 0) { unsigned* tb = (unsigned*)(F.ctl + CW_BAR);
            const unsigned qi = xb_add((unsigned*)(F.ctl + CW_PHEAD), 1u); unsigned e = 0u;
            if (qi < 256u) { unsigned* qe = (unsigned*)(F.ctl + CW_PQ + 4 * qi); XB_SPIN((e = xb_ld(qe)) == 0u, tb);
                __builtin_amdgcn_fence(__ATOMIC_ACQUIRE, "agent"); asm volatile("s_waitcnt vmcnt(0)" ::: "memory"); }
            F.MISC[13] = e; }
        __syncthreads();
        const int e = __builtin_amdgcn_readfirstlane((int)F.MISC[13]);
        if (e == 0) break;
        { pg8::Gemm g{WSP(bf16, WS_M), WSP(bf16, WS_WOUT), MP, D_MODEL, D_MODEL, D_MODEL}; pg8::OneUnit S{(e - 1) >> 2, (e - 1) & 3};
          pg8::EpiOut E{WSP(bf16, WS_MIX)};
          pg8::gemm_phase<pg8::EpiOut, pg8::OneUnit, PG8_ALIGN, PG8_SP2>(F.lds + RING_OFF, g, S, E, F.wave); }
    }
    xcd_barrier(bar);
    { const int c = (int)blockIdx.x, kc = c & 3;
      pg8::Gemm g{WSP(bf16, WS_M) + kc * 256, WSP(bf16, WS_WOUT) + kc * 256, MT, D_MODEL, 256, D_MODEL}; pg8::SampleOrder S{c};
      pg8::EpiPart E{WSP(float, WS_PART) + (size_t)kc * MS * D_MODEL};
      pg8::gemm_phase<pg8::EpiPart, pg8::SampleOrder, PG8_ALIGN, PG8_SP2>(F.lds + RING_OFF, g, S, E, F.wave); }
    if ((int)blockIdx.x < 64) {
        const int rb = (int)blockIdx.x >> 4;
        asm volatile("s_waitcnt vmcnt(0)" ::: "memory");
        __syncthreads();
        if (F.wave == 0 && lane_id() == 0) {
            unsigned* cnt = (unsigned*)(F.ctl + CW_SROW + 64 * rb); unsigned* tb = (unsigned*)(F.ctl + CW_BAR);
            __builtin_amdgcn_fence(__ATOMIC_RELEASE, "agent");
            asm volatile("s_waitcnt vmcnt(0)" ::: "memory");
            (void)xb_add(cnt, 1u);
            XB_SPIN(xb_ld(cnt) < 16u, tb);
            __builtin_amdgcn_fence(__ATOMIC_ACQUIRE, "agent");
            asm volatile("s_waitcnt vmcnt(0)" ::: "memory");
        }
        __syncthreads();
        final_norm<false>(F, A, rb * 256 + ((int)blockIdx.x & 15) * 16);
    }
#ifndef SKIP_FIN
    else final_norm<true>(F, A, 64);
#endif
}

extern "C" void kernel_launch(void* const* d_in, const int* in_sizes, int n_in, void* d_out, int out_size, void* d_ws, size_t ws_size, hipStream_t stream) {
    static int grid = 0;
    if (grid == 0) {
        if (n_in != 21 || in_sizes[0] != MP * D_MODEL || (size_t)out_size != OUT_TOTAL || ws_size < WS_END) { fprintf(stderr, "kernel_launch: unexpected problem (n_in %d, in0 %d, out %d, ws %zu); nothing launched\n", n_in, n_in > 0 ? in_sizes[0] : -1, out_size, ws_size); grid = -1; return; }
        int dev = 0, cus = 0, per_cu = 0;
        if (hipGetDevice(&dev) != hipSuccess || hipDeviceGetAttribute(&cus, hipDeviceAttributeMultiprocessorCount, dev) != hipSuccess) { fprintf(stderr, "kernel_launch: device query failed\n"); grid = -1; return; }
        if (hipFuncSetAttribute((const void*)hymba_fwd, hipFuncAttributeMaxDynamicSharedMemorySize, LDS_BYTES) != hipSuccess) { fprintf(stderr, "kernel_launch: hipFuncSetAttribute failed\n"); grid = -1; return; }
        if (hipOccupancyMaxActiveBlocksPerMultiprocessor(&per_cu, (const void*)hymba_fwd, NWAVES * 64, LDS_BYTES) != hipSuccess || per_cu < 1)
            fprintf(stderr, "kernel_launch: note: occupancy query reports %d workgroups per CU\n", per_cu);
        (void)hipGetLastError();
        grid = cus;
        if (grid != 256) fprintf(stderr, "kernel_launch: %d CUs; the attention unit deal is written for 256\n", grid);
    }
    if (grid < 0) return;
    if (hipMemsetAsync((char*)d_ws + WS_CTL, 0, CTL_ZERO_BYTES, stream) != hipSuccess) { fprintf(stderr, "kernel_launch: memset failed\n"); return; }
    Args a{};
    for (int i = 0; i < 21; ++i) a.in[i] = (const float*)d_in[i];
    a.out = (float*)d_out; a.ws = (unsigned char*)d_ws;
    hipLaunchKernelGGL(hymba_fwd, dim3(grid), dim3(NWAVES * 64), LDS_BYTES, stream, a);
    const hipError_t le = hipPeekAtLastError();
    if (le != hipSuccess) fprintf(stderr, "kernel_launch: launch failed: %s\n", hipGetErrorName(le));
}
```

```cpp
#include <hip/hip_runtime.h>
#include <cstdio>
#include <cstdint>
constexpr int D_MODEL = 1024, SEQ = 8192, NBATCH = 2, MP = NBATCH * SEQ;
constexpr int DEC_B = 128, DEC_S = 8, MS = DEC_B * DEC_S;
constexpr int MT = MP + MS;
constexpr int D_IN = 3584, CONV_W = 31, HIST = 30, NPAGES = 16;
constexpr float EPS = 1e-5f, LOG2E = 1.4426950408889634f;
constexpr float QSCALE = 0.125f * LOG2E;
constexpr size_t OFF_YP = 0, OFF_YS = OFF_YP + (size_t)MP * D_MODEL, OFF_KP = OFF_YS + (size_t)MS * D_MODEL, OFF_VP = OFF_KP + (size_t)MP * 512, OFF_CP = OFF_VP + (size_t)MP * 512,
    OFF_KS = OFF_CP + (size_t)NBATCH * HIST * 512, OFF_VS = OFF_KS + (size_t)MS * 512, OFF_CS = OFF_VS + (size_t)MS * 512, OUT_TOTAL = OFF_CS + (size_t)DEC_B * HIST * 512;
static_assert(OUT_TOTAL == 37648384, "output size");
constexpr int UP_SEQ = SEQ + HIST, USMP0 = NBATCH * UP_SEQ, US_SEQ = HIST + DEC_S, U_ROWS = USMP0 + DEC_B * US_SEQ;
__host__ __device__ __forceinline__ int u_row(int row) { return row < MP ? row + HIST * ((row >> 13) + 1) : USMP0 + ((row - MP) >> 3) * US_SEQ + HIST + ((row - MP) & 7); }
__device__ __forceinline__ int lane_id() { int l; asm volatile("v_mbcnt_lo_u32_b32 %0, -1, 0\n\tv_mbcnt_hi_u32_b32 %0, -1, %0" : "=v"(l)); return l; }
namespace pg8 {
#define PG8_LAS __attribute__((address_space(3)))
typedef unsigned short bf16_t;
typedef short bf16x8 __attribute__((ext_vector_type(8)));
typedef float f32x4 __attribute__((ext_vector_type(4)));
typedef unsigned u32x4 __attribute__((ext_vector_type(4)));
constexpr int BM = 256, BK = 64, HALF = 128, HTB = HALF * BK * 2  , STAGE_BYTES = 8 * HTB, NXCD = 8, WGM = 8;

__host__ __device__ __forceinline__ int lds_byte(int r, int c) { const int st = (r >> 4) * 2 + (c >> 5), rr = r & 15, cc = c & 31, ob = rr * 64 + cc * 2; return st * 1024 + (ob ^ (((ob >> 9) & 1) << 5)); }
__host__ __device__ __forceinline__ void stage_rc(int b, int& R, int& C) { const int st = b / 1024, sb = b % 1024, swz = sb ^ (((sb >> 9) & 1) << 5); R = (st >> 1) * 16 + swz / 64; C = (st & 1) * 32 + (swz % 64) / 2; }
__host__ __device__ __forceinline__ int perm32(int rho) { const int n = rho >> 4, i = rho & 15; return 8 * (i >> 2) + 4 * n + (i & 3); }

struct Unit { int pm, pn; };
struct Gemm { const bf16_t* A; const bf16_t* Bt; int M, N, K, ld; };

struct StaticOrder {
    int nM, nN, nwg, G, c;
    __host__ __device__ void init(int M, int N, int G_, int c_) { nM = M / BM; nN = N / BM; nwg = nM * nN; G = G_; c = c_; }
    __host__ __device__ bool next(int i, Unit& u) const {
        const long L = (long)i * G + c; if (L >= nwg) return false;
        int wgid = (int)L; { const int q = nwg / NXCD, r = nwg % NXCD, xcd = wgid % NXCD, off = wgid / NXCD; wgid = (xcd < r ? xcd * (q + 1) : r * (q + 1) + (xcd - r) * q) + off; }
        const int nig = WGM * nN, gid = wgid / nig, fm = gid * WGM, gsz = (nM - fm) < WGM ? (nM - fm) : WGM;
        u.pm = fm + ((wgid % nig) % gsz); u.pn = (wgid % nig) / gsz; return true;
    }
    __device__ __forceinline__ void a_ready(const Unit&) const {}
    __device__ __forceinline__ void done(const Unit&) const {}
};
__device__ __forceinline__ unsigned cvt_pk_bf16(float lo, float hi) { unsigned r; asm volatile("v_cvt_pk_bf16_f32 %0, %1, %2" : "=v"(r) : "v"(lo), "v"(hi)); return r; }
typedef float f32x2 __attribute__((ext_vector_type(2)));
__device__ __forceinline__ float sigm_f(float x) { return __builtin_amdgcn_rcpf(1.0f + __builtin_amdgcn_exp2f(-LOG2E * x)); }
__device__ __forceinline__ float silu_f(float x) { return x * sigm_f(x); }
__device__ __forceinline__ u32x4 pack8(const f32x4 v0, const f32x4 v1) { u32x4 w; w.x = cvt_pk_bf16(v0[0], v0[1]); w.y = cvt_pk_bf16(v0[2], v0[3]); w.z = cvt_pk_bf16(v1[0], v1[1]); w.w = cvt_pk_bf16(v1[2], v1[3]); return w; }
#define ST16_WT(p, v) asm volatile("global_store_dwordx4 %0, %1, off sc1\n\ts_nop 1" :: "v"(p), "v"(v) : "memory")
struct EpiIn {
    static constexpr bool PERM = true, AFTER_DRAIN = false;
    bf16_t *Qb, *Kb, *Vb, *GAb, *GCb; bf16_t* U; float* out;
    __device__ __forceinline__ void operator()(const f32x4 (&acc)[2][2][4][2], const Unit& u, int wr, int wc, int fr, int fq) const {
        const int row0 = u.pm * BM + wr * 64 + fr, pn = u.pn, cw = wc * 32 + 8 * fq;
        if (pn < 2 || pn == 6 || pn == 7 || pn >= 12) {
            bf16_t* base; int mode;
            if (pn < 2) { base = Qb + pn * 256; mode = 0; } else if (pn < 8) { base = GAb + (pn - 6) * 256; mode = 1; } else { base = GCb + (pn - 12) * 256; mode = 2; }
#pragma unroll
            for (int ai = 0; ai < 2; ++ai)
#pragma unroll
                for (int m = 0; m < 4; ++m) { bf16_t* rowp = base + (size_t)(row0 + ai * HALF + m * 16) * 512 + cw;
#pragma unroll
                    for (int bj = 0; bj < 2; ++bj) { f32x4 v0 = acc[ai][bj][m][0], v1 = acc[ai][bj][m][1];
                        if (mode == 0) { v0 = v0 * QSCALE; v1 = v1 * QSCALE; }
                        else { const float sc = mode == 1 ? 0.8f : 1.0f;
#pragma unroll
                            for (int i = 0; i < 4; ++i) { v0[i] = silu_f(v0[i]) * sc; v1[i] = silu_f(v1[i]) * sc; } }
                        *(u32x4*)(rowp + bj * HALF) = pack8(v0, v1); } }
        } else if (pn < 6) {
            const int t = (pn - 2) >> 1, cb = ((pn - 2) & 1) * 256 + cw; const bool smp = u.pm >= MP / BM;
            bf16_t* bb = (t ? Vb : Kb) + cb;
            float* fb = out + (smp ? (t ? OFF_VS : OFF_KS) - (size_t)MP * 512 : (t ? OFF_VP : OFF_KP)) + cb;
#pragma unroll
            for (int ai = 0; ai < 2; ++ai)
#pragma unroll
                for (int m = 0; m < 4; ++m) { const size_t ro = (size_t)(row0 + ai * HALF + m * 16) * 512;
#pragma unroll
                    for (int bj = 0; bj < 2; ++bj) { const f32x4 v0 = acc[ai][bj][m][0], v1 = acc[ai][bj][m][1];
                        *(f32x4*)(fb + ro + bj * HALF) = v0; *(f32x4*)(fb + ro + bj * HALF + 4) = v1; *(u32x4*)(bb + ro + bj * HALF) = pack8(v0, v1); } }
        } else {
            bf16_t* ub = U + 128 * (pn - 8) + cw; const int ccol = 128 * (pn - 8) + cw;
            const bool outs = (u.pm & 31) == 31 || u.pm >= MP / BM;
#pragma unroll
            for (int ai = 0; ai < 2; ++ai)
#pragma unroll
                for (int m = 0; m < 4; ++m) { const int row = row0 + ai * HALF + m * 16; const size_t ro = (size_t)u_row(row) * 512; f32x4 o[2];
#pragma unroll
                    for (int n = 0; n < 2; ++n) { const f32x4 a = acc[ai][0][m][n], b = acc[ai][1][m][n];
#pragma unroll
                        for (int i = 0; i < 4; ++i) o[n][i] = a[i] * sigm_f(b[i]); }
                    *(u32x4*)(ub + ro) = pack8(o[0], o[1]);
                    if (outs) { long od = -1;
                        if (row < MP) { const int t = row & (SEQ - 1); if (t >= SEQ - HIST) od = (long)OFF_CP + ((long)(row >> 13) * HIST + (t - (SEQ - HIST))) * 512; }
                        else { const int rs = row - MP; od = (long)OFF_CS + ((long)(rs >> 3) * HIST + (HIST - DEC_S) + (rs & 7)) * 512; }
                        if (od >= 0) { *(f32x4*)(out + od + ccol) = o[0]; *(f32x4*)(out + od + ccol + 4) = o[1]; } } }
        }
    }
};
struct EpiPw2 {
    static constexpr bool PERM = true, AFTER_DRAIN = false;
    const float* bias; const bf16_t* GCb; bf16_t* Mb;
    __device__ __forceinline__ void operator()(const f32x4 (&acc)[2][2][4][2], const Unit& u, int wr, int wc, int fr, int fq) const {
        const int row0 = u.pm * BM + wr * 64 + fr, c0 = u.pn * BM + wc * 32 + 8 * fq;
        f32x4 bv[2][2];
#pragma unroll
        for (int bj = 0; bj < 2; ++bj)
#pragma unroll
            for (int n = 0; n < 2; ++n) bv[bj][n] = *(const f32x4*)(bias + c0 + bj * HALF + 4 * n);
#pragma unroll
        for (int ai = 0; ai < 2; ++ai)
#pragma unroll
            for (int m = 0; m < 4; ++m) { const size_t r = (size_t)(row0 + ai * HALF + m * 16);
#pragma unroll
                for (int bj = 0; bj < 2; ++bj) { const u32x4 gw = *(const u32x4*)(GCb + r * 512 + c0 + bj * HALF);
                    f32x4 g0, g1; g0[0] = __uint_as_float(gw.x << 16); g0[1] = __uint_as_float(gw.x & 0xffff0000u); g0[2] = __uint_as_float(gw.y << 16); g0[3] = __uint_as_float(gw.y & 0xffff0000u);
                    g1[0] = __uint_as_float(gw.z << 16); g1[1] = __uint_as_float(gw.z & 0xffff0000u); g1[2] = __uint_as_float(gw.w << 16); g1[3] = __uint_as_float(gw.w & 0xffff0000u);
                    const f32x4 v0 = (acc[ai][bj][m][0] + bv[bj][0]) * g0, v1 = (acc[ai][bj][m][1] + bv[bj][1]) * g1;
                    { const u32x4 pw_ = pack8(v0, v1); ST16_WT(Mb + r * 1024 + 512 + c0 + bj * HALF, pw_); } } }
    }
};
struct EpiOut {
    static constexpr bool PERM = true, AFTER_DRAIN = false;
    bf16_t* mix;
    __device__ __forceinline__ void operator()(const f32x4 (&acc)[2][2][4][2], const Unit& u, int wr, int wc, int fr, int fq) const {
        const int row0 = u.pm * BM + wr * 64 + fr, c0 = u.pn * BM + wc * 32 + 8 * fq;
#pragma unroll
        for (int ai = 0; ai < 2; ++ai)
#pragma unroll
            for (int m = 0; m < 4; ++m) { bf16_t* rowp = mix + (size_t)(row0 + ai * HALF + m * 16) * D_MODEL + c0;
#pragma unroll
                for (int bj = 0; bj < 2; ++bj) *(u32x4*)(rowp + bj * HALF) = pack8(acc[ai][bj][m][0], acc[ai][bj][m][1]); }
    }
};
struct EpiPart {
    static constexpr bool PERM = true, AFTER_DRAIN = false;
    float* part;
    __device__ __forceinline__ void operator()(const f32x4 (&acc)[2][2][4][2], const Unit& u, int wr, int wc, int fr, int fq) const {
        const int row0 = (u.pm - MP / BM) * BM + wr * 64 + fr, c0 = u.pn * BM + wc * 32 + 8 * fq;
#pragma unroll
        for (int ai = 0; ai < 2; ++ai)
#pragma unroll
            for (int m = 0; m < 4; ++m) { const size_t r = (size_t)(row0 + ai * HALF + m * 16);
#pragma unroll
                for (int bj = 0; bj < 2; ++bj)
#pragma unroll
                    for (int n = 0; n < 2; ++n) *(f32x4*)(part + r * D_MODEL + c0 + bj * HALF + 4 * n) = acc[ai][bj][m][n]; }
    }
};
struct SampleOrder {
    int c;
    __device__ __forceinline__ bool next(int i, Unit& u) const { if (i > 0 || c >= 64) return false; u.pm = MP / BM + (c >> 4); u.pn = (c >> 2) & 3; return true; }
    __device__ __forceinline__ void a_ready(const Unit&) const {}
    __device__ __forceinline__ void done(const Unit&) const {}
};
struct TicketOrder {
    int t;
    __device__ __forceinline__ bool next(int i, Unit& u) const { if (i > 0 || t >= (MT / BM) * 2) return false; u.pm = t >> 1; u.pn = t & 1; return true; }
    __device__ __forceinline__ void a_ready(const Unit&) const {}
    __device__ __forceinline__ void done(const Unit&) const {}
};
struct OneUnit {
    int pm, pn;
    __device__ __forceinline__ bool next(int i, Unit& u) const { if (i > 0) return false; u.pm = pm; u.pn = pn; return true; }
    __device__ __forceinline__ void a_ready(const Unit&) const {}
    __device__ __forceinline__ void done(const Unit&) const {}
};
template <class Epi, class Sched, bool ALIGN_EPI = false, bool SP2 = false>
__device__ __forceinline__ void gemm_phase(PG8_LAS unsigned char* lds, const Gemm g, const Sched& S, const Epi& E, const int g_wave) {
    int tid = g_wave * 64 + lane_id(); asm volatile("" : "+v"(tid));
    const int wid = __builtin_amdgcn_readfirstlane(tid >> 6), lane = tid & 63, wr = wid >> 2, wc = wid & 3, fr = lane & 15, fq = lane >> 4;
    const int K = g.K, LD = g.ld, nt = K / BK;
    unsigned voffA[2], voffB[2];
#pragma unroll
    for (int i = 0; i < 2; ++i) { int R, C; stage_rc(tid * 16 + i * 8192, R, C); const int Rb = Epi::PERM ? ((R & ~31) + perm32(R & 31)) : R;
        voffA[i] = (unsigned)(R * LD + C) * 2u; voffB[i] = (unsigned)(Rb * LD + C) * 2u; }
    const size_t kstep = (size_t)(BK * 2);
    const size_t hstep = (size_t)HALF * LD * 2;
    const size_t tstep = 2 * hstep;
    const unsigned ldsw = (unsigned)wid * 1024u;
    const int aoff = lds_byte(wr * 64 + fr, fq * 8), boff = lds_byte(wc * 32 + fr, fq * 8);
#define PG8_SA(b, h) (((b) * 2 + (h)) * HTB)
#define PG8_SB(b, h) ((4 + (b) * 2 + (h)) * HTB)
#define PG8_STAGE(bufoff, gbase, voff) do { _Pragma("unroll") for (int _i = 0; _i < 2; ++_i) \
        __builtin_amdgcn_global_load_lds((const unsigned*)((const char*)(gbase) + (voff)[_i]), (PG8_LAS unsigned*)(lds + (bufoff) + ldsw + _i * 8192), 16, 0, 0); } while (0)
#define PG8_LDA(dst, b, h) do { _Pragma("unroll") for (int m = 0; m < 4; ++m) _Pragma("unroll") for (int k = 0; k < 2; ++k) dst[m][k] = *(const PG8_LAS bf16x8*)(lds + PG8_SA(b, h) + aoff + m * 2048 + k * 1024); } while (0)
#define PG8_LDB(dst, b, h) do { _Pragma("unroll") for (int n = 0; n < 2; ++n) _Pragma("unroll") for (int k = 0; k < 2; ++k) dst[n][k] = *(const PG8_LAS bf16x8*)(lds + PG8_SB(b, h) + boff + n * 2048 + k * 1024); } while (0)
#define PG8_MMA(ai, bj, At, Bt) do { __builtin_amdgcn_s_setprio(1); _Pragma("unroll") for (int m = 0; m < 4; ++m) _Pragma("unroll") for (int n = 0; n < 2; ++n) _Pragma("unroll") for (int k = 0; k < 2; ++k) \
        acc[ai][bj][m][n] = __builtin_amdgcn_mfma_f32_16x16x32_bf16(Bt[n][k], At[m][k], acc[ai][bj][m][n], 0, 0, 0); __builtin_amdgcn_s_setprio(0); } while (0)
#define PG8_WAIT_V(n) asm volatile("s_waitcnt vmcnt(" #n ")" ::: "memory")
#define PG8_WAIT_L(n) asm volatile("s_waitcnt lgkmcnt(" #n ")" ::: "memory")
#define PG8_BAR __builtin_amdgcn_s_barrier()
#define PG8_SCHED __builtin_amdgcn_sched_barrier(0)
    Unit cur, nxt; int ui = 0;
    if (!S.next(0, cur)) return;
    f32x4 acc[2][2][4][2];
#pragma unroll
    for (int a = 0; a < 2; ++a)
#pragma unroll
        for (int b = 0; b < 2; ++b)
#pragma unroll
            for (int m = 0; m < 4; ++m)
#pragma unroll
                for (int n = 0; n < 2; ++n) acc[a][b][m][n] = (f32x4){0.f, 0.f, 0.f, 0.f};
    bf16x8 At[4][2], B0[2][2], B1[2][2];
    const char* cA = (const char*)g.A + (size_t)cur.pm * tstep; const char* cB = (const char*)g.Bt + (size_t)cur.pn * tstep;
    S.a_ready(cur);
    if constexpr (SP2) {
        PG8_STAGE(PG8_SB(0, 0), cB, voffB); PG8_STAGE(PG8_SB(0, 1), cB + hstep, voffB); PG8_STAGE(PG8_SA(0, 0), cA, voffA); PG8_STAGE(PG8_SA(0, 1), cA + hstep, voffA);
        if (wr == 1) PG8_BAR;
        PG8_WAIT_V(2); PG8_BAR;
        PG8_STAGE(PG8_SB(1, 0), cB + kstep, voffB); PG8_STAGE(PG8_SA(1, 0), cA + kstep, voffA); PG8_STAGE(PG8_SB(1, 1), cB + hstep + kstep, voffB);
        PG8_WAIT_V(6); PG8_BAR;
    } else {
        PG8_STAGE(PG8_SB(0, 0), cB, voffB); PG8_STAGE(PG8_SA(0, 0), cA, voffA); PG8_STAGE(PG8_SB(0, 1), cB + hstep, voffB); PG8_STAGE(PG8_SA(0, 1), cA + hstep, voffA);
        if (wr == 1) PG8_BAR;
        PG8_WAIT_V(4); PG8_BAR;
        PG8_STAGE(PG8_SB(1, 0), cB + kstep, voffB); PG8_STAGE(PG8_SA(1, 0), cA + kstep, voffA); PG8_STAGE(PG8_SB(1, 1), cB + hstep + kstep, voffB);
        PG8_WAIT_V(6); PG8_BAR;
    }
    for (;;) {
        const bool has_next = S.next(ui + 1, nxt);
        const char* nA = has_next ? (const char*)g.A + (size_t)nxt.pm * tstep : cA; const char* nB = has_next ? (const char*)g.Bt + (size_t)nxt.pn * tstep : cB;
        for (int t = 0; t < nt; t += 2) {
            const bool last = (t == nt - 2);
            const char* a1 = cA + (size_t)(t + 1) * kstep;
            const char* a2 = last ? nA : cA + (size_t)(t + 2) * kstep; const char* b2 = last ? nB : cB + (size_t)(t + 2) * kstep;
            const char* a3 = a2 + kstep; const char* b3 = b2 + kstep;
            if (last && has_next) S.a_ready(nxt);
            if constexpr (SP2) {
            PG8_LDB(B0, 0, 0); PG8_LDB(B1, 0, 1); PG8_SCHED; PG8_LDA(At, 0, 0); PG8_STAGE(PG8_SA(1, 1), a1 + hstep, voffA);
            PG8_WAIT_V(8); PG8_WAIT_L(0); PG8_BAR; PG8_MMA(0, 0, At, B0); PG8_MMA(0, 1, At, B1); PG8_BAR; PG8_SCHED;
            PG8_LDA(At, 0, 1); PG8_STAGE(PG8_SB(0, 0), b2, voffB); PG8_STAGE(PG8_SB(0, 1), b2 + hstep, voffB); PG8_STAGE(PG8_SA(0, 0), a2, voffA);
            PG8_WAIT_V(8); PG8_WAIT_L(0); PG8_BAR; PG8_MMA(1, 0, At, B0); PG8_MMA(1, 1, At, B1); PG8_BAR; PG8_SCHED;
            PG8_LDB(B0, 1, 0); PG8_LDB(B1, 1, 1); PG8_SCHED; PG8_LDA(At, 1, 0); PG8_STAGE(PG8_SA(0, 1), a2 + hstep, voffA);
            PG8_WAIT_V(8); PG8_WAIT_L(0); PG8_BAR; PG8_MMA(0, 0, At, B0); PG8_MMA(0, 1, At, B1); PG8_BAR; PG8_SCHED;
            PG8_LDA(At, 1, 1); PG8_STAGE(PG8_SB(1, 0), b3, voffB); PG8_STAGE(PG8_SB(1, 1), b3 + hstep, voffB); PG8_STAGE(PG8_SA(1, 0), a3, voffA);
            PG8_WAIT_V(8); PG8_WAIT_L(0); PG8_BAR; PG8_MMA(1, 0, At, B0); PG8_MMA(1, 1, At, B1); PG8_BAR; PG8_SCHED;
            } else {
            PG8_LDB(B0, 0, 0); PG8_SCHED; PG8_LDA(At, 0, 0); PG8_STAGE(PG8_SA(1, 1), a1 + hstep, voffA);
            PG8_WAIT_L(8); PG8_BAR; PG8_WAIT_L(0); PG8_MMA(0, 0, At, B0); PG8_BAR; PG8_SCHED;
            PG8_LDB(B1, 0, 1); PG8_STAGE(PG8_SB(0, 0), b2, voffB);
            PG8_BAR; PG8_WAIT_L(0); PG8_MMA(0, 1, At, B1); PG8_BAR;
            PG8_LDA(At, 0, 1); PG8_STAGE(PG8_SA(0, 0), a2, voffA);
            PG8_BAR; PG8_WAIT_L(0); PG8_MMA(1, 0, At, B0); PG8_BAR; PG8_SCHED;
            PG8_STAGE(PG8_SB(0, 1), b2 + hstep, voffB);
            PG8_WAIT_V(6); PG8_BAR; PG8_MMA(1, 1, At, B1); PG8_BAR;
            PG8_LDB(B0, 1, 0); PG8_SCHED; PG8_LDA(At, 1, 0); PG8_STAGE(PG8_SA(0, 1), a2 + hstep, voffA);
            PG8_WAIT_L(8); PG8_BAR; PG8_WAIT_L(0); PG8_MMA(0, 0, At, B0); PG8_BAR; PG8_SCHED;
            PG8_LDB(B1, 1, 1); PG8_STAGE(PG8_SB(1, 0), b3, voffB);
            PG8_BAR; PG8_WAIT_L(0); PG8_MMA(0, 1, At, B1); PG8_BAR;
            PG8_LDA(At, 1, 1); PG8_STAGE(PG8_SA(1, 0), a3, voffA);
            PG8_BAR; PG8_WAIT_L(0); PG8_MMA(1, 0, At, B0); PG8_BAR; PG8_SCHED;
            PG8_STAGE(PG8_SB(1, 1), b3 + hstep, voffB);
            PG8_WAIT_V(6); PG8_BAR; PG8_MMA(1, 1, At, B1); PG8_BAR;
            }
        }
        if constexpr (ALIGN_EPI) { if (wr == 0) PG8_BAR; }
        if constexpr (!Epi::AFTER_DRAIN) { E(acc, cur, wr, wc, fr, fq); S.done(cur); }
        if (!has_next) break;
#pragma unroll
        for (int a = 0; a < 2; ++a)
#pragma unroll
            for (int b = 0; b < 2; ++b)
#pragma unroll
                for (int m = 0; m < 4; ++m)
#pragma unroll
                    for (int n = 0; n < 2; ++n) acc[a][b][m][n] = (f32x4){0.f, 0.f, 0.f, 0.f};
        cur = nxt; cA = nA; cB = nB; ++ui;
        if constexpr (ALIGN_EPI) { if (wr == 1) PG8_BAR; }
    }
    PG8_WAIT_V(0);
    if constexpr (!ALIGN_EPI) { if (wr == 0) PG8_BAR; }
    PG8_BAR;
    if constexpr (Epi::AFTER_DRAIN) { E.fused(acc, cur, wr, wc, fr, fq, lds, wid, lane); S.done(cur); }
#undef PG8_SA
#undef PG8_SB
#undef PG8_STAGE
#undef PG8_LDA
#undef PG8_LDB
#undef PG8_MMA
#undef PG8_WAIT_V
#undef PG8_WAIT_L
#undef PG8_BAR
#undef PG8_SCHED
}
}
#ifndef PG8_SP2
#define PG8_SP2 true
#endif
#ifndef PG8_ALIGN
#define PG8_ALIGN true
#endif
#include <hip/hip_bf16.h>
#include <cmath>
namespace attn128 {
using bf16=__hip_bfloat16;
using bf16x8=__attribute__((ext_vector_type(8)))short;
using s16x4=__attribute__((ext_vector_type(4)))short;
using f32x16=__attribute__((ext_vector_type(16)))float;
using u32x4=__attribute__((ext_vector_type(4)))unsigned;
constexpr int BATCH=2,NHEAD=8,SEQ=8192,D=64,DV=128,DM=512;
constexpr int NW=8,QBLK=32,QB=QBLK*NW,KVBLK=64,NQB=SEQ/QB;
constexpr int ATTN_PITCH=DM, ATTN_UNIT_ROWS=QB;
__device__ __forceinline__ int crow(int r,int hi){return (r&3)+8*(r>>2)+4*hi;}
#define SBAR() __builtin_amdgcn_sched_barrier(0)
__device__ __forceinline__ void cmask(f32x16&p0,f32x16&p1,int jb,int qrel,int hi){
  const float NEG=-INFINITY; int kb=64*jb+4*hi;
  #pragma unroll
  for(int r=0;r<16;++r){int kv=kb+(r&3)+8*(r>>2); if(kv>qrel)p0[r]=NEG; if(kv+32>qrel)p1[r]=NEG;}
}

constexpr int NSLOT=3, SLOTB=8192;
constexpr int LDS_K=0, LDS_V=NSLOT*SLOTB, LDS_WS=3*NSLOT*SLOTB, LDS_OST=LDS_WS+NW*64*4, LDS_BYTES=LDS_OST+NW*4096;
constexpr float C2=0.125f*1.4426950408889634f;
__device__ __forceinline__ void glds16(const void*gsrc,unsigned lds_dst){unsigned keep;
  asm volatile("s_mov_b32 %0, m0\n\ts_mov_b32 m0, %2\n\ts_nop 0\n\tglobal_load_lds_dwordx4 %1, off\n\ts_mov_b32 m0, %0":"=&s"(keep):"v"(gsrc),"s"(lds_dst):"memory");}
__device__ __forceinline__ float max3f(float a,float b,float c){float r;asm("v_max3_f32 %0, %1, %2, %3":"=v"(r):"v"(a),"v"(b),"v"(c));return r;}
__device__ __forceinline__ float max2f(float a,float b){float r;asm("v_max_f32_e32 %0, %1, %2":"=v"(r):"v"(a),"v"(b));return r;}
__device__ __forceinline__ float fadd_s(float a,float b){float r;asm("v_add_f32_e32 %0, %1, %2":"=v"(r):"v"(a),"v"(b));return r;}
__device__ __forceinline__ float fsub_s(float a,float b){float r;asm("v_sub_f32_e32 %0, %1, %2":"=v"(r):"v"(a),"v"(b));return r;}
typedef float f32x2_t __attribute__((ext_vector_type(2))); typedef __bf16 bf16x2_t __attribute__((ext_vector_type(2)));
__device__ __forceinline__ unsigned cvtpk_s(float lo,float hi){f32x2_t v={lo,hi};bf16x2_t b=__builtin_convertvector(v,bf16x2_t);return __builtin_bit_cast(unsigned,b);}
#define WAIT_BAR(N) asm volatile("s_waitcnt vmcnt(" #N ") lgkmcnt(0)\n\ts_barrier":::"memory")

__device__ __forceinline__ void qkt(f32x16&p0,f32x16&p1,const char*Kslot,const bf16x8*qr,int r32,int hi){
  const char*kb=Kslot+hi*1024+r32*16;
  #pragma unroll
  for(int d0=0;d0<4;++d0){
    const bf16x8 b0=*reinterpret_cast<const bf16x8*>(kb+d0*2048);
    const bf16x8 b1=*reinterpret_cast<const bf16x8*>(kb+d0*2048+512);
    if(d0==0){p0=__builtin_amdgcn_mfma_f32_32x32x16_bf16(b0,qr[0],f32x16{},0,0,0);p1=__builtin_amdgcn_mfma_f32_32x32x16_bf16(b1,qr[0],f32x16{},0,0,0);}
    else{p0=__builtin_amdgcn_mfma_f32_32x32x16_bf16(b0,qr[d0],p0,0,0,0);p1=__builtin_amdgcn_mfma_f32_32x32x16_bf16(b1,qr[d0],p1,0,0,0);}}
}
typedef __attribute__((address_space(3))) const char* lds_cptr;
typedef short v4i16_t __attribute__((ext_vector_type(4)));
__device__ __forceinline__ void kload8(bf16x8*kf,lds_cptr kp){
  kf[0]=*(const __attribute__((address_space(3))) bf16x8*)(kp);      kf[1]=*(const __attribute__((address_space(3))) bf16x8*)(kp+512);
  kf[2]=*(const __attribute__((address_space(3))) bf16x8*)(kp+2048); kf[3]=*(const __attribute__((address_space(3))) bf16x8*)(kp+2560);
  kf[4]=*(const __attribute__((address_space(3))) bf16x8*)(kp+4096); kf[5]=*(const __attribute__((address_space(3))) bf16x8*)(kp+4608);
  kf[6]=*(const __attribute__((address_space(3))) bf16x8*)(kp+6144); kf[7]=*(const __attribute__((address_space(3))) bf16x8*)(kp+6656);
}
__device__ __forceinline__ void kload2(bf16x8*kf,lds_cptr kp,int j){ kf[2*j]=*(const __attribute__((address_space(3))) bf16x8*)(kp+j*2048); kf[2*j+1]=*(const __attribute__((address_space(3))) bf16x8*)(kp+j*2048+512); }
__device__ __forceinline__ s16x4 vtr(lds_cptr p){ return __builtin_bit_cast(s16x4,__builtin_amdgcn_ds_read_tr16_b64_v4i16((__attribute__((address_space(3))) v4i16_t*)p)); }
__device__ __forceinline__ float rowmax(const f32x16&p0,const f32x16&p1){
  float a=max3f(p0[0],p0[1],p1[0]),b=max3f(p0[2],p0[3],p1[1]);a=max3f(a,p1[2],p1[3]);
  #pragma unroll
  for(int r=4;r<16;r+=4){a=max3f(a,p0[r],p0[r+1]);b=max3f(b,p0[r+2],p0[r+3]);a=max3f(a,p1[r],p1[r+1]);b=max3f(b,p1[r+2],p1[r+3]);}
  const float m=max2f(a,b);
  auto rr=__builtin_amdgcn_permlane32_swap(__float_as_uint(m),__float_as_uint(m),false,false);
  return max2f(__uint_as_float(rr[0]),__uint_as_float(rr[1]));
}
__device__ __forceinline__ void pv(f32x16*o,int vb,bf16x8 pa0,bf16x8 pa1,bf16x8 pa2,bf16x8 pa3){
  #pragma unroll
  for(int d0=0;d0<4;++d0){s16x4 lo[4],hi[4];
    #pragma unroll
    for(int ks=0;ks<4;++ks){
      asm volatile("ds_read_b64_tr_b16 %0,%1 offset:%c2":"=&v"(lo[ks]):"v"(vb),"i"(d0*4096+ks*1024):"memory");
      asm volatile("ds_read_b64_tr_b16 %0,%1 offset:%c2":"=&v"(hi[ks]):"v"(vb),"i"(d0*4096+ks*1024+512):"memory");}
    asm volatile("s_waitcnt lgkmcnt(0)":::"memory");SBAR();
    #define PK(k) (bf16x8){lo[k][0],lo[k][1],lo[k][2],lo[k][3],hi[k][0],hi[k][1],hi[k][2],hi[k][3]}
    o[d0]=__builtin_amdgcn_mfma_f32_32x32x16_bf16(pa0,PK(0),o[d0],0,0,0);
    o[d0]=__builtin_amdgcn_mfma_f32_32x32x16_bf16(pa1,PK(1),o[d0],0,0,0);
    o[d0]=__builtin_amdgcn_mfma_f32_32x32x16_bf16(pa2,PK(2),o[d0],0,0,0);
    o[d0]=__builtin_amdgcn_mfma_f32_32x32x16_bf16(pa3,PK(3),o[d0],0,0,0);
    #undef PK
  }
}

#ifndef ATTN_STORE16
#define ATTN_STORE16(p,v) asm volatile("global_store_dwordx4 %0, %1, off sc1\n\ts_nop 1" :: "v"(p), "v"(v) : "memory")
#endif
template<int THRL,bool FAST> __device__ __forceinline__ bool attn_unit(int b,int qcol,int vcol,int qb,const bf16*Q,const bf16*__restrict__ K,const bf16*__restrict__ V,bf16*O,char*shm,const int g_wave){
  const int tid=g_wave*64+lane_id(),lane=tid&63,r32=lane&31,hi=lane>>5; const int wid=__builtin_amdgcn_readfirstlane(tid>>6);
  const long rowbase=(long)b*SEQ; const int q0=qb*QB;
  const bf16*Qw=Q+(rowbase+q0+wid*QBLK)*DM+qcol;
  const bf16*Kh=K+rowbase*DM+qcol,*Vh=V+rowbase*DM+vcol;
  const unsigned lds0=(unsigned)(uintptr_t)shm;
  float*wsf=(float*)(shm+LDS_WS)+wid*64;
  const bf16*ksrc=Kh+(long)lane*DM+wid*8;
  const bf16*vsrc=Vh+(long)(16*(wid&3)+(lane>>2))*DM+(wid>>2)*32+(lane&3)*8;
  const unsigned kdst=lds0+LDS_K+wid*1024, vdst=lds0+LDS_V+wid*1024;
  #define DMA_K(t,slot) glds16(ksrc+(long)(t)*KVBLK*DM,(unsigned)__builtin_amdgcn_readfirstlane(kdst+(slot)))
  #define DMA_V(t,slot) do{ glds16(vsrc+(long)(t)*KVBLK*DM,(unsigned)__builtin_amdgcn_readfirstlane(vdst+2*(slot))); glds16(vsrc+(long)(t)*KVBLK*DM+64,(unsigned)__builtin_amdgcn_readfirstlane(vdst+2*(slot)+8192)); }while(0)
  const int vb0=(int)(lds0+LDS_V)+((lane>>4)&1)*32+(lane&3)*8+(4*hi+((lane&15)>>2))*64;
  const char*Kbase=shm+LDS_K; bf16x8 kf[8];
  const lds_cptr shm3=(lds_cptr)shm; const lds_cptr kp0=shm3+LDS_K+hi*1024+r32*16; const lds_cptr vp0=shm3+LDS_V+((lane>>4)&1)*32+(lane&3)*8+(4*hi+((lane&15)>>2))*64;
  const int NT=(q0+QB)/KVBLK;
  volatile __attribute__((address_space(3))) unsigned*redo=(volatile __attribute__((address_space(3))) unsigned*)((__attribute__((address_space(3))) char*)shm+LDS_BYTES);
  if(FAST&&wid==0&&lane==0)*redo=0u;
  DMA_K(0,0);DMA_V(0,0);DMA_K(1,SLOTB);
  bf16x8 qr[4];
  #pragma unroll
  for(int d0=0;d0<4;++d0)qr[d0]=*reinterpret_cast<const bf16x8*>(&Qw[(long)r32*DM+d0*16+hi*8]);
  float mhat=0.f,l_reg=0.f;f32x16 o[4];o[0]=f32x16{};o[1]=f32x16{};o[2]=f32x16{};o[3]=f32x16{};
  const int qrel=wid*QBLK+r32;
  #define CMASK(P0,P1,t) do{int jb_=(t)-(NT-4); if(jb_>=0)cmask(P0,P1,jb_,qrel,hi);}while(0)
  bool resc=false;
  #define START(P0,P1) do{ resc=false; \
    if constexpr(!FAST){ const float rm=rowmax(P0,P1); const float dl=rm; mhat=fadd_s(mhat,dl); \
      _Pragma("unroll") for(int r=0;r<16;++r){P0[r]=fsub_s(P0[r],dl);P1[r]=fsub_s(P1[r],dl);} \
      } \
    _Pragma("unroll") for(int r=0;r<16;++r)P0[r]=__builtin_amdgcn_exp2f(P0[r]); }while(0)
  #define RESC() do{ if constexpr(!FAST) if(resc){ asm volatile("s_waitcnt lgkmcnt(0)":::"memory"); \
      _Pragma("unroll") for(int d_=0;d_<4;++d_) _Pragma("unroll") for(int r=0;r<16;++r)o[d_][r]*=wsf[crow(r,hi)]; } }while(0)
  f32x16 pA0,pA1,pB0,pB1;
  int sl_prev=0,sl_cur=0,sl_next=SLOTB;
  #define ROT() do{sl_prev=sl_cur;sl_cur=sl_next;sl_next=(sl_next==(NSLOT-1)*SLOTB)?0:sl_next+SLOTB;}while(0)
  DMA_K(2,2*SLOTB);
  WAIT_BAR(4);
  qkt(pA0,pA1,Kbase,qr,r32,hi);asm volatile("s_nop 15\n\ts_nop 7":"+v"(pA0),"+v"(pA1));CMASK(pA0,pA1,0);
  START(pA0,pA1);
  _Pragma("unroll") for(int r=0;r<16;++r)pA1[r]=__builtin_amdgcn_exp2f(pA1[r]);
  WAIT_BAR(0);
  DMA_K(3,0);DMA_V(1,SLOTB);
  ROT();
  kload8(kf,kp0+sl_cur);
  WAIT_BAR(3);
  s16x4 vlo[8],vhi[8]; u32x4 pw0,pw1,pw2,pw3;
  #define PKW(P,B) cvtpk_s(P[B],P[B+1])
  #define PAF(k) __builtin_bit_cast(bf16x8,pw##k)
  #define VFR(i) (bf16x8){vlo[(i)&7][0],vlo[(i)&7][1],vlo[(i)&7][2],vlo[(i)&7][3],vhi[(i)&7][0],vhi[(i)&7][1],vhi[(i)&7][2],vhi[(i)&7][3]}
  #define PIN(x) asm volatile("":"+v"(x))
  #define MX3(a,b,c) __builtin_fmaxf(__builtin_fmaxf((a),(b)),(c))
  #define GAPA(MF,A0,A1,A2,A3,W0,W1,PW) do{ MF; sacc+=A0; sacc+=A1; sacc+=A2; sacc+=A3; PIN(sacc); W0; W1; PIN(PW); SBAR(); }while(0)
  #define EX(v) __builtin_amdgcn_exp2f(v)
  #define GAPB(MF,X,B) do{ MF; if constexpr(FAST){ X[B]=EX(X[B]); X[B+1]=EX(X[B+1]); } else { X[B]=EX(X[B]-mhat); X[B+1]=EX(X[B+1]-mhat); } PIN(X); SBAR(); }while(0)
  #define VRD(i) do{ vlo[(i)&7]=vtr(vp_+(((i)>>2)*4096+((i)&3)*1024)); vhi[(i)&7]=vtr(vp_+(((i)>>2)*4096+((i)&3)*1024+512)); }while(0)
  #define VRDB(i) do{ VRD(i); SBAR(); }while(0)
  #define KRD(G,j) do{ if(G){ kload2(kf,kp0+sl_next,j); SBAR(); } }while(0)
  #define STEP(C0,C1,P0,P1,t,GK,GV,GL) do{ SBAR(); \
    const lds_cptr vp_=vp0+2*sl_prev; \
    VRD(0); SBAR(); float sacc=(P0[0]+P0[1]); \
    GAPA(C0=__builtin_amdgcn_mfma_f32_32x32x16_bf16(kf[0],qr[0],f32x16{},0,0,0), P0[2],P0[3],P0[4],P0[5],     pw0[0]=PKW(P0,0), pw0[1]=PKW(P0,2), pw0); \
    GAPA(C1=__builtin_amdgcn_mfma_f32_32x32x16_bf16(kf[1],qr[0],f32x16{},0,0,0), P0[6],P0[7],P0[8],P0[9],     pw0[2]=PKW(P0,4), pw0[3]=PKW(P0,6), pw0); \
    VRD(1); SBAR(); GAPA(C0=__builtin_amdgcn_mfma_f32_32x32x16_bf16(kf[2],qr[1],C0,0,0,0),   P0[10],P0[11],P0[12],P0[13], pw1[0]=PKW(P0,8), pw1[1]=PKW(P0,10), pw1); \
    GAPA(C1=__builtin_amdgcn_mfma_f32_32x32x16_bf16(kf[3],qr[1],C1,0,0,0),   P0[14],P0[15],P1[0],P1[1],   pw1[2]=PKW(P0,12),pw1[3]=PKW(P0,14), pw1); \
    VRD(2); SBAR(); GAPA(C0=__builtin_amdgcn_mfma_f32_32x32x16_bf16(kf[4],qr[2],C0,0,0,0),   P1[2],P1[3],P1[4],P1[5],     pw2[0]=PKW(P1,0), pw2[1]=PKW(P1,2), pw2); \
    GAPA(C1=__builtin_amdgcn_mfma_f32_32x32x16_bf16(kf[5],qr[2],C1,0,0,0),   P1[6],P1[7],P1[8],P1[9],     pw2[2]=PKW(P1,4), pw2[3]=PKW(P1,6), pw2); \
    VRD(3); SBAR(); GAPA(C0=__builtin_amdgcn_mfma_f32_32x32x16_bf16(kf[6],qr[3],C0,0,0,0),   P1[10],P1[11],P1[12],P1[13], pw3[0]=PKW(P1,8), pw3[1]=PKW(P1,10), pw3); \
    GAPA(C1=__builtin_amdgcn_mfma_f32_32x32x16_bf16(kf[7],qr[3],C1,0,0,0),   P1[14],P1[15],0.f,0.f,       pw3[2]=PKW(P1,12),pw3[3]=PKW(P1,14), pw3); \
    l_reg+=sacc; \
    if(GK){DMA_K((t)+3,sl_cur);} if(GV){DMA_V((t)+1,sl_next);} \
    CMASK(C0,C1,t); \
    if constexpr(!FAST){ float a=MX3(C0[0],C0[1],C1[0]),b=MX3(C0[2],C0[3],C1[1]); a=MX3(a,C1[2],C1[3]); \
      _Pragma("unroll") for(int r=4;r<16;r+=4){a=MX3(a,C0[r],C0[r+1]);b=MX3(b,C0[r+2],C0[r+3]);a=MX3(a,C1[r],C1[r+1]);b=MX3(b,C1[r+2],C1[r+3]);} \
      float rm=__builtin_fmaxf(a,b); { auto rr=__builtin_amdgcn_permlane32_swap(__float_as_uint(rm),__float_as_uint(rm),false,false); rm=__builtin_fmaxf(__uint_as_float(rr[0]),__uint_as_float(rr[1])); } \
      resc=false; const float rel_=rm-mhat;     \
      if(__builtin_expect(__any(rel_>(float)THRL),0)){ const float dl=__builtin_fmaxf(rel_,0.f); mhat+=dl; \
        const float f=__builtin_amdgcn_exp2f(-dl); l_reg*=f; if(hi==0)wsf[r32]=f; resc=true; } } \
    SBAR(); \
      \
    GAPB(o[0]=__builtin_amdgcn_mfma_f32_32x32x16_bf16(PAF(0),VFR(0),o[0],0,0,0), C0,0);   VRDB(4); \
    GAPB(o[0]=__builtin_amdgcn_mfma_f32_32x32x16_bf16(PAF(1),VFR(1),o[0],0,0,0), C0,2);   VRDB(5); \
    GAPB(o[0]=__builtin_amdgcn_mfma_f32_32x32x16_bf16(PAF(2),VFR(2),o[0],0,0,0), C0,4);   VRDB(6); \
    GAPB(o[0]=__builtin_amdgcn_mfma_f32_32x32x16_bf16(PAF(3),VFR(3),o[0],0,0,0), C0,6);   VRDB(7); \
    GAPB(o[1]=__builtin_amdgcn_mfma_f32_32x32x16_bf16(PAF(0),VFR(4),o[1],0,0,0), C0,8);   VRDB(8); \
    GAPB(o[1]=__builtin_amdgcn_mfma_f32_32x32x16_bf16(PAF(1),VFR(5),o[1],0,0,0), C0,10);  VRDB(9); \
    GAPB(o[1]=__builtin_amdgcn_mfma_f32_32x32x16_bf16(PAF(2),VFR(6),o[1],0,0,0), C0,12);  VRDB(10); \
    GAPB(o[1]=__builtin_amdgcn_mfma_f32_32x32x16_bf16(PAF(3),VFR(7),o[1],0,0,0), C0,14);  VRDB(11); \
    GAPB(o[2]=__builtin_amdgcn_mfma_f32_32x32x16_bf16(PAF(0),VFR(8),o[2],0,0,0), C1,0);   VRDB(12); \
    GAPB(o[2]=__builtin_amdgcn_mfma_f32_32x32x16_bf16(PAF(1),VFR(9),o[2],0,0,0), C1,2);   VRDB(13); \
    GAPB(o[2]=__builtin_amdgcn_mfma_f32_32x32x16_bf16(PAF(2),VFR(10),o[2],0,0,0), C1,4);  VRDB(14); \
    GAPB(o[2]=__builtin_amdgcn_mfma_f32_32x32x16_bf16(PAF(3),VFR(11),o[2],0,0,0), C1,6);  VRDB(15); \
    KRD(GL,0); GAPB(o[3]=__builtin_amdgcn_mfma_f32_32x32x16_bf16(PAF(0),VFR(12),o[3],0,0,0), C1,8); \
    KRD(GL,1); GAPB(o[3]=__builtin_amdgcn_mfma_f32_32x32x16_bf16(PAF(1),VFR(13),o[3],0,0,0), C1,10); \
    KRD(GL,2); GAPB(o[3]=__builtin_amdgcn_mfma_f32_32x32x16_bf16(PAF(2),VFR(14),o[3],0,0,0), C1,12); \
    KRD(GL,3); GAPB(o[3]=__builtin_amdgcn_mfma_f32_32x32x16_bf16(PAF(3),VFR(15),o[3],0,0,0), C1,14); \
    }while(0)
  int t=1;
  #undef CMASK
  #define CMASK(P0,P1,t) do{}while(0)
  for(;t+5<NT;t+=2){
    STEP(pB0,pB1,pA0,pA1,t,true,true,true);     WAIT_BAR(3); RESC(); ROT();
    STEP(pA0,pA1,pB0,pB1,t+1,true,true,true);   WAIT_BAR(3); RESC(); ROT();
  }
  #undef CMASK
  #define CMASK(P0,P1,t) do{int jb_=(t)-(NT-4); if(jb_>=0)cmask(P0,P1,jb_,qrel,hi);}while(0)
  #define ENDW(tt) do{ if((tt)+3<NT){WAIT_BAR(3);} else if((tt)+2<NT){WAIT_BAR(2);} else {WAIT_BAR(0);} }while(0)
  for(;t+1<NT;t+=2){
    STEP(pB0,pB1,pA0,pA1,t,(t+3<NT),(t+1<NT),(t+1<NT));       ENDW(t);   RESC(); ROT();
    STEP(pA0,pA1,pB0,pB1,t+1,(t+4<NT),(t+2<NT),(t+2<NT));     ENDW(t+1); RESC(); ROT();
  }
  STEP(pB0,pB1,pA0,pA1,NT-1,false,false,false); RESC();
  { float sacc=pB0[0]+pB0[1]; _Pragma("unroll") for(int r=2;r<16;++r)sacc+=pB0[r]; _Pragma("unroll") for(int r=0;r<16;++r)sacc+=pB1[r]; l_reg+=sacc;
    pw0=(u32x4){PKW(pB0,0),PKW(pB0,2),PKW(pB0,4),PKW(pB0,6)};pw1=(u32x4){PKW(pB0,8),PKW(pB0,10),PKW(pB0,12),PKW(pB0,14)};pw2=(u32x4){PKW(pB1,0),PKW(pB1,2),PKW(pB1,4),PKW(pB1,6)};pw3=(u32x4){PKW(pB1,8),PKW(pB1,10),PKW(pB1,12),PKW(pB1,14)};
    SBAR(); pv(o,vb0+2*sl_cur,PAF(0),PAF(1),PAF(2),PAF(3)); }
  #undef PKW
  #undef PAF
  #undef VFR
  #undef PIN
  #undef MX3
  #undef GAPA
  #undef GAPB
  #undef EX
  #undef VRD
  #undef VRDB
  #undef KRD
  #undef STEP
  #undef ENDW
  {auto rr=__builtin_amdgcn_permlane32_swap(__float_as_uint(l_reg),__float_as_uint(l_reg),false,false);l_reg=__uint_as_float(rr[0])+__uint_as_float(rr[1]);}
  if(FAST){ if(__any(!(l_reg>1e-30f&&l_reg<1e30f))&&lane==0)*redo=1u; }
  if(hi==0)wsf[32+r32]=l_reg;asm volatile("s_waitcnt lgkmcnt(0)":::"memory");
  float rli[16];
  #pragma unroll
  for(int r=0;r<16;++r)rli[r]=__builtin_amdgcn_rcpf(wsf[32+crow(r,hi)]);
  bf16*Ow=O+(rowbase+q0+wid*QBLK)*DM+vcol;
  { bf16*stg=(bf16*)(shm+LDS_OST)+wid*2048;
    #pragma unroll
    for(int ps=0;ps<2;++ps){
      #pragma unroll
      for(int r=0;r<16;++r){const int orow=crow(r,hi);
        #pragma unroll
        for(int d0=0;d0<2;++d0)stg[orow*64+d0*32+r32]=__float2bfloat16(o[2*ps+d0][r]*rli[r]);}
      asm volatile("s_waitcnt lgkmcnt(0)":::"memory");
      #pragma unroll
      for(int i=0;i<4;++i){const int row=i*8+(lane>>3),ch=lane&7; const u32x4 v=*(const u32x4*)(stg+row*64+ch*8); ATTN_STORE16(Ow+(long)row*DM+ps*64+ch*8,v);}
      asm volatile("s_waitcnt lgkmcnt(0)":::"memory"); } }
  asm volatile("s_waitcnt lgkmcnt(0)\n\ts_barrier":::"memory");
  bool again=false;
  if(FAST){ again=(*redo!=0u); asm volatile("s_waitcnt lgkmcnt(0)\n\ts_barrier":::"memory"); }
  #undef DMA_K
  #undef DMA_V
  #undef CMASK
  #undef START
  #undef RESC
  #undef ROT
  return again;
}
constexpr int ATTN_LDS_BYTES=LDS_BYTES;
struct AttnTensors { const bf16* Q; const bf16* K; const bf16* V; bf16* O1; bf16* O2; };
#undef SBAR
#undef WAIT_BAR
}
#define GAS __attribute__((address_space(1)))
#define LAS __attribute__((address_space(3)))
typedef unsigned short bf16;
typedef unsigned v4u __attribute__((ext_vector_type(4)));
typedef float f32x4 __attribute__((ext_vector_type(4)));
typedef short bf16x8 __attribute__((ext_vector_type(8)));
typedef GAS unsigned gu32;
typedef GAS unsigned long long gu64;
#define RLX_AGENT __ATOMIC_RELAXED, __HIP_MEMORY_SCOPE_AGENT
#define LDS_WAIT() asm volatile("s_waitcnt lgkmcnt(0)" ::: "memory")
#define VM_WAIT() asm volatile("s_waitcnt vmcnt(0)" ::: "memory")
__device__ __forceinline__ unsigned long long rt() { return __builtin_amdgcn_s_memrealtime(); }
__device__ __forceinline__ unsigned f2bf(float f) { unsigned u = __builtin_bit_cast(unsigned, f); return (u + 0x7fffu + ((u >> 16) & 1u)) >> 16; }
__device__ __forceinline__ unsigned pk2(float lo, float hi) { return f2bf(lo) | (f2bf(hi) << 16); }
#define XB_TMO      128
#define XB_XCNT(j)  (256  + 64 * (j))
#define XB_XSUB(j)  (1280 + 64 * (j))
#define XB_XGEN(j)  (2304 + 64 * (j))
#define XB_TOP      3328
#define XB_TOPGEN   3392
#define XCD_BAR_WORDS 3456
#define XB_SPIN_CAP (1u << 18)

__device__ __forceinline__ unsigned xb_ld(unsigned* p)              { return __hip_atomic_load(p, __ATOMIC_RELAXED, __HIP_MEMORY_SCOPE_AGENT); }
__device__ __forceinline__ unsigned xb_add(unsigned* p, unsigned v) { return __hip_atomic_fetch_add(p, v, __ATOMIC_RELAXED, __HIP_MEMORY_SCOPE_AGENT); }
__device__ __forceinline__ unsigned xb_xcc_id() { return (unsigned)__builtin_amdgcn_s_getreg((3 << 11) | 20) & 0xFu; }
#define XB_SPIN(cond, bar) do { unsigned _sp = 0; while (cond) { __builtin_amdgcn_s_sleep(1); \
    if ((++_sp & 255u) == 0u) { if (xb_ld(&(bar)[XB_TMO])) break; if (_sp > XB_SPIN_CAP) { atomicAdd(&(bar)[XB_TMO], 1u); break; } } } } while (0)

struct XcdBarrier {
    unsigned* bar; unsigned x; int wave;
    volatile LAS unsigned* st;
};

__device__ __forceinline__ XcdBarrier xcd_barrier_post(unsigned* bar, volatile LAS unsigned* st, const int g_wave) {
    XcdBarrier b; b.bar = bar; b.x = xb_xcc_id(); b.st = st; b.wave = g_wave;
    if (g_wave == 0 && lane_id() == 0) (void)xb_add(&bar[XB_XCNT(b.x)], 1u);
    return b;
}
__device__ __forceinline__ void xcd_barrier_complete(unsigned* bar, unsigned x, unsigned& nloc, unsigned& nx) {
    const unsigned G = gridDim.x * gridDim.y * gridDim.z;
    unsigned sum, cnt, mine, sp = 0u;
    for (;;) {
        sum = 0u; cnt = 0u; mine = 0u;
#pragma unroll
        for (unsigned j = 0; j < 16; ++j) { const unsigned c = xb_ld(&bar[XB_XCNT(j)]); sum += c; cnt += (c > 0u) ? 1u : 0u; mine = (j == x) ? c : mine; }
        if (sum == G) break;
        __builtin_amdgcn_s_sleep(1);
        if ((++sp & 255u) == 0u) { if (xb_ld(&bar[XB_TMO])) break; if (sp > XB_SPIN_CAP) { atomicAdd(&bar[XB_TMO], 1u); break; } }
    }
    nloc = mine > 0u ? mine : 1u; nx = cnt > 0u ? cnt : 1u;
}

__device__ __forceinline__ void xcd_barrier(const XcdBarrier& b) {
    asm volatile("s_waitcnt vmcnt(0)" ::: "memory");
    __syncthreads();
    if (b.wave == 0 && lane_id() == 0) {
        unsigned* bar = b.bar;
        __builtin_amdgcn_s_waitcnt(0);
        unsigned nloc = b.st[0], nx = b.st[1];
        if (nloc == 0u) { xcd_barrier_complete(bar, b.x, nloc, nx); b.st[0] = nloc; b.st[1] = nx; }
        const unsigned old = xb_add(&bar[XB_XSUB(b.x)], 1u);
        const unsigned gen = old / nloc;
        if (old + 1u == (gen + 1u) * nloc) {
            __builtin_amdgcn_fence(__ATOMIC_RELEASE, "agent");
            asm volatile("s_waitcnt vmcnt(0)" ::: "memory");
            const unsigned og = xb_add(&bar[XB_TOP], 1u);
            const unsigned tg = og / nx;
            if (og + 1u == (tg + 1u) * nx) xb_add(&bar[XB_TOPGEN], 1u);
            else XB_SPIN(xb_ld(&bar[XB_TOPGEN]) == tg, bar);
            __builtin_amdgcn_fence(__ATOMIC_ACQUIRE, "agent");
            xb_add(&bar[XB_XGEN(b.x)], 1u);
            asm volatile("s_waitcnt vmcnt(0)" ::: "memory");
        } else {
            XB_SPIN(xb_ld(&bar[XB_XGEN(b.x)]) == gen, bar);
            __builtin_amdgcn_fence(__ATOMIC_ACQUIRE, "agent");
            asm volatile("s_waitcnt vmcnt(0)" ::: "memory");
        }
    }
    __syncthreads();
}
__device__ __forceinline__ void xcd_arrive(unsigned* ctl, const int wstage, const int wtotal, const unsigned x, const unsigned nloc) {
    const unsigned old = xb_add(ctl + wstage + 64 * x, 1u);
    if (old + 1u == nloc) { __builtin_amdgcn_fence(__ATOMIC_RELEASE, "agent"); asm volatile("s_waitcnt vmcnt(0)" ::: "memory"); (void)xb_add(ctl + wtotal, nloc); }
}
constexpr size_t MiB = 1u << 20;
constexpr size_t WS_CTL = 0, CTL_ZERO_BYTES = 64 * 1024;
constexpr size_t WS_WIN = 2 * MiB;
constexpr size_t WS_WPW = 10 * MiB;
constexpr size_t WS_WOUT = 11 * MiB;
constexpr size_t WS_XN = 16 * MiB;
constexpr size_t WS_Q = 52 * MiB, WS_K = 70 * MiB, WS_V = 88 * MiB, WS_GA = 106 * MiB, WS_GC = 124 * MiB;
constexpr size_t WS_U = 142 * MiB;
constexpr size_t WS_C = 186 * MiB;
constexpr size_t WS_O1 = 204 * MiB, WS_O2 = 220 * MiB;
constexpr size_t WS_M = 236 * MiB;
constexpr size_t WS_PART = 272 * MiB;
constexpr size_t WS_MIX = 288 * MiB;
constexpr size_t WS_END = 320 * MiB;
static_assert(WS_XN + (size_t)MT * 1024 * 2 <= WS_Q && WS_Q + (size_t)MT * 512 * 2 <= WS_K && WS_U + (size_t)U_ROWS * 512 * 4 <= WS_C && WS_C + (size_t)MT * 512 * 2 <= WS_O1 && WS_M + (size_t)MT * 1024 * 2 <= WS_END, "d_ws map");
constexpr int CW_XCONV = 8192 + 64 * 8, CW_XATTN = 8192 + 64 * 24;
constexpr int CW_CONV = 8192 + 64 * 4, CW_ATTN = 8192 + 64 * 5, CW_TICKET = 8192 + 64 * 6;
constexpr int CW_PCNT = 6656, CW_PQ = 0, CW_PTAIL = 8192 + 64 * 62, CW_PHEAD = 8192 + 64 * 63;
constexpr int CW_PAIR = 12288;
constexpr int CW_QUEUE = 4608, CW_QTAIL = 8192 + 64 * 60, CW_QHEAD = 8192 + 64 * 61;
constexpr int CW_SROW = 8192;
constexpr int CW_BAR = 1024;
__device__ __forceinline__ void panel_post(unsigned* ctl, const int pm) {
    if (xb_add(ctl + CW_PCNT + 16 * pm, 1u) == 5u) { const unsigned j = xb_add(ctl + CW_PTAIL, 4u);
#pragma unroll
        for (unsigned pn = 0; pn < 4; ++pn) __hip_atomic_store(ctl + CW_PQ + 4 * ((j + pn) & 255u), (unsigned)pm * 4u + pn + 1u, RLX_AGENT); }
}
constexpr int NWAVES = 8;
constexpr int RING_OFF = 0, RING_BYTES = 131072;
constexpr int LDSCTL_OFF = RING_BYTES, MISC_OFF = LDSCTL_OFF + 320;
constexpr int LDS_BYTES = 147456;

struct Frame {
    LAS unsigned char* lds;
    volatile LAS unsigned* MISC;
    gu32* ctl;
    int wave;
    int vcu, G;
};
struct Args { const float* in[21]; float* out; unsigned char* ws; };
#define WSP(T, off) ((T*)(A.ws + (off)))
template <int CTRL> __device__ __forceinline__ float dppf(float x) { return __builtin_bit_cast(float, __builtin_amdgcn_mov_dpp(__builtin_bit_cast(int, x), CTRL, 0xf, 0xf, true)); }
__device__ __forceinline__ float xrow_sum(float x) {
    auto a = __builtin_amdgcn_permlane16_swap(__float_as_uint(x), __float_as_uint(x), false, false); x = __uint_as_float(a[0]) + __uint_as_float(a[1]);
    auto b = __builtin_amdgcn_permlane32_swap(__float_as_uint(x), __float_as_uint(x), false, false); return __uint_as_float(b[0]) + __uint_as_float(b[1]); }
__device__ __forceinline__ float xrow_max(float x) {
    auto a = __builtin_amdgcn_permlane16_swap(__float_as_uint(x), __float_as_uint(x), false, false); x = fmaxf(__uint_as_float(a[0]), __uint_as_float(a[1]));
    auto b = __builtin_amdgcn_permlane32_swap(__float_as_uint(x), __float_as_uint(x), false, false); return fmaxf(__uint_as_float(b[0]), __uint_as_float(b[1])); }
__device__ __forceinline__ float row16_sum(float v) {
    v += dppf<0xB1>(v); v += dppf<0x4E>(v); v += dppf<0x141>(v); v += dppf<0x140>(v); return v; }
__device__ __forceinline__ float wave_sum(float v) { return xrow_sum(row16_sum(v)); }
__device__ __forceinline__ void p0_transpose_item(const float* W, int K, int N, bf16* WT, int k0, int n0, int dst0, LAS float* scr, int lane) {
#pragma unroll 8
    for (int i = 0; i < 32; ++i) { const int kk = 2 * i + (lane >> 5); scr[kk * 33 + (lane & 31)] = W[(size_t)(k0 + kk) * N + n0 + (lane & 31)]; }
    LDS_WAIT(); asm volatile("" ::: "memory");
    const int c = lane & 7;
#pragma unroll
    for (int j = 0; j < 4; ++j) { const int n = (lane >> 3) + 8 * j; const LAS float* s = scr + (8 * c) * 33 + n;
        v4u o; o.x = pk2(s[0 * 33], s[1 * 33]); o.y = pk2(s[2 * 33], s[3 * 33]); o.z = pk2(s[4 * 33], s[5 * 33]); o.w = pk2(s[6 * 33], s[7 * 33]);
        *(GAS v4u*)(WT + (size_t)(dst0 + n) * K + k0 + 8 * c) = o; }
    LDS_WAIT(); asm volatile("" ::: "memory");
}
__device__ __forceinline__ int win_dst_row(int n0) {
    if (n0 < 2048 || n0 >= 3072) return n0;
    int j = n0 - 2048; const int isb = j >= 512; if (isb) j -= 512;
    return 2048 + 256 * (j >> 7) + 128 * isb + (j & 127);
}
__device__ __forceinline__ void rms_row_to_bf16(const float* xrow, const f32x4 (&gv)[4], bf16* orow, int lane) {
    const GAS f32x4* xr = (const GAS f32x4*)xrow + lane;
    f32x4 v[4]; float s = 0.f;
#pragma unroll
    for (int j = 0; j < 4; ++j) { v[j] = xr[64 * j]; s += (v[j].x * v[j].x + v[j].y * v[j].y) + (v[j].z * v[j].z + v[j].w * v[j].w); }
    const float rs = 1.0f / sqrtf(wave_sum(s) * (1.f / D_MODEL) + EPS);
    GAS unsigned long long* o8 = (GAS unsigned long long*)orow + lane;
#pragma unroll
    for (int j = 0; j < 4; ++j) o8[64 * j] = (unsigned long long)pk2(v[j].x * rs * gv[j].x, v[j].y * rs * gv[j].y) | ((unsigned long long)pk2(v[j].z * rs * gv[j].z, v[j].w * rs * gv[j].w) << 32);
}
__device__ __forceinline__ void p0_prologue(Frame& F, const Args& A) {
    const float *w_in = A.in[7], *w_pw2 = A.in[17], *w_out = A.in[19], *xp = A.in[0], *xs = A.in[1]; bf16 *Win_t = WSP(bf16, WS_WIN), *Wpw_t = WSP(bf16, WS_WPW), *Wout_t = WSP(bf16, WS_WOUT), *XN = WSP(bf16, WS_XN);
    LAS float* scr = (LAS float*)(F.lds + RING_OFF + F.wave * 16384);
    const int gw = F.vcu * NWAVES + F.wave, NGW = F.G * NWAVES;
    constexpr int I_IN = (1024 / 64) * (D_IN / 32), I_PW = (512 / 64) * (512 / 32), I_OUT = (1024 / 64) * (1024 / 32);
    f32x4 gv[4];
#pragma unroll
    for (int j = 0; j < 4; ++j) gv[j] = *((const f32x4*)A.in[6] + lane_id() + 64 * j);
#pragma nounroll
    for (int ph = 0; ph < 2; ++ph) {
    if (((F.wave & 1) != 0) == (ph != 0)) {
    for (int it = gw; it < I_IN; it += NGW) {
        int r = it;
        if (r < I_IN) { const int nblk = D_IN / 32, kb = r / nblk, nb = r % nblk; p0_transpose_item(w_in, 1024, D_IN, Win_t, 64 * kb, 32 * nb, win_dst_row(32 * nb), scr, lane_id()); continue; } r -= I_IN;
        if (r < I_PW) { const int kb = r / 16, nb = r % 16; p0_transpose_item(w_pw2, 512, 512, Wpw_t, 64 * kb, 32 * nb, 32 * nb, scr, lane_id()); continue; } r -= I_PW;
        { const int kb = r / 32, nb = r % 32; p0_transpose_item(w_out, 1024, 1024, Wout_t, 64 * kb, 32 * nb, 32 * nb, scr, lane_id()); }
    }
    { bf16* U = WSP(bf16, WS_U); const float* state = A.in[4];
      for (int r = gw; r < NBATCH * HIST + DEC_B * HIST; r += NGW) { f32x4 v0 = {0.f, 0.f, 0.f, 0.f}, v1 = v0; size_t dst;
          if (r < NBATCH * HIST) dst = (size_t)((r / HIST) * UP_SEQ + r % HIST) * 512;
          else { const int q = r - NBATCH * HIST, b = q / HIST, i = q % HIST; dst = (size_t)(USMP0 + b * US_SEQ + i) * 512; v0 = *(const f32x4*)(state + (size_t)q * 512 + 8 * lane_id()); v1 = *(const f32x4*)(state + (size_t)q * 512 + 8 * lane_id() + 4); }
          v4u w; w.x = pk2(v0[0], v0[1]); w.y = pk2(v0[2], v0[3]); w.z = pk2(v1[0], v1[1]); w.w = pk2(v1[2], v1[3]);
          *(v4u*)(U + dst + 8 * lane_id()) = w; } }
    } else
    { const int lane = lane_id();
      for (int grp = NGW - 1 - gw; grp < MT / 4; grp += NGW) {
          const int m0 = 4 * grp; const float* xb = m0 < MP ? xp + (size_t)m0 * D_MODEL : xs + (size_t)(m0 - MP) * D_MODEL;
          f32x4 v[4][4];
#pragma unroll
          for (int r = 0; r < 4; ++r)
#pragma unroll
              for (int j = 0; j < 4; ++j) v[r][j] = *((const GAS f32x4*)(xb + (size_t)r * D_MODEL) + lane + 64 * j);
#pragma unroll
          for (int r = 0; r < 4; ++r) { float ss = 0.f;
#pragma unroll
              for (int j = 0; j < 4; ++j) ss += (v[r][j].x * v[r][j].x + v[r][j].y * v[r][j].y) + (v[r][j].z * v[r][j].z + v[r][j].w * v[r][j].w);
              const float rs = 1.0f / sqrtf(wave_sum(ss) * (1.f / D_MODEL) + EPS);
              GAS unsigned long long* o8 = (GAS unsigned long long*)(XN + (size_t)(m0 + r) * D_MODEL) + lane;
#pragma unroll
              for (int j = 0; j < 4; ++j) o8[64 * j] = (unsigned long long)pk2(v[r][j].x * rs * gv[j].x, v[r][j].y * rs * gv[j].y) | ((unsigned long long)pk2(v[r][j].z * rs * gv[j].z, v[r][j].w * rs * gv[j].w) << 32); } } }
    }
}
__device__ __forceinline__ void p1_idle_transposes(Frame& F, const Args& A) {
    const int nwg = (MT / 256) * (D_IN / 256), G = (int)F.G, nidle = (4 * G > nwg && 3 * G < nwg) ? 4 * G - nwg : 0, first = nidle ? G - nidle : 0;
    if ((int)blockIdx.x < first) return;
    const float *w_pw2 = A.in[17], *w_out = A.in[19]; bf16 *Wpw_t = WSP(bf16, WS_WPW), *Wout_t = WSP(bf16, WS_WOUT);
    LAS float* scr = (LAS float*)(F.lds + RING_OFF + F.wave * 16384);
    constexpr int I_PW = (512 / 64) * (512 / 32), I_OUT = (1024 / 64) * (1024 / 32);
    for (int r = ((int)blockIdx.x - first) * NWAVES + F.wave; r < I_PW + I_OUT; r += (G - first) * NWAVES) {
        if (r < I_PW) { const int kb = r / 16, nb = r % 16; p0_transpose_item(w_pw2, 512, 512, Wpw_t, 64 * kb, 32 * nb, 32 * nb, scr, lane_id()); }
        else { const int q = r - I_PW, kb = q / 32, nb = q % 32; p0_transpose_item(w_out, 1024, 1024, Wout_t, 64 * kb, 32 * nb, 32 * nb, scr, lane_id()); }
    }
    { const float* state = A.in[4]; float* out = A.out; constexpr int RQ = (HIST - DEC_S) * 128;
      for (int i = ((int)blockIdx.x - first) * NWAVES * 64 + F.wave * 64 + lane_id(); i < DEC_B * RQ; i += (G - first) * NWAVES * 64) { const int b = i / RQ, rem = i - b * RQ;
          *((f32x4*)(out + OFF_CS + (size_t)b * HIST * 512) + rem) = *((const f32x4*)(state + (size_t)(b * HIST + DEC_S) * 512) + rem); } }
}
__device__ __forceinline__ float compute_lam(Frame& F, const Args& A) {
    const float a = wave_sum(A.in[8][lane_id()] * A.in[9][lane_id()]), b = wave_sum(A.in[10][lane_id()] * A.in[11][lane_id()]);
    return __builtin_bit_cast(float, __builtin_amdgcn_readfirstlane(__builtin_bit_cast(int, expf(a) - expf(b) + 0.2f)));
}
__device__ __forceinline__ void conv_phase(Frame& F, const Args& A) {
    int tid_ = F.wave * 64 + lane_id(); asm volatile("" : "+v"(tid_)); const int lane = tid_ & 63, wave = __builtin_amdgcn_readfirstlane(tid_ >> 6);
    const bf16* U = WSP(bf16, WS_U); float* out = A.out; bf16* Cb = WSP(bf16, WS_C);
    LAS float* wl = (LAS float*)(F.lds + RING_OFF);
    for (int i = tid_; i < CONV_W * 512; i += NWAVES * 64) wl[i] = A.in[13][i];
    __syncthreads();
    const int gw = F.vcu * NWAVES + wave, NGW = F.G * NWAVES;
    for (int k = 0; k < 3; ++k) {
        const int task = k < 2 ? gw + k * NGW : (wave == 0 ? MP / 4 + F.vcu : MP / 4 + 2 * DEC_B);
        if (task >= (k < 2 ? MP / 4 : MP / 4 + 2 * DEC_B)) continue;
        int rowbase, urow0;
        if (task < MP / 4) { const int b = task >> 11, t0 = (task & 2047) * 4; rowbase = b * SEQ + t0; urow0 = b * UP_SEQ + t0; }
        else { const int q = task - MP / 4, b = q >> 1, hf = q & 1; rowbase = MP + b * 8 + 4 * hf; urow0 = USMP0 + b * US_SEQ + 4 * hf; }
        const bf16* up = U + (size_t)urow0 * 512; const int lo = 8 * lane;
        f32x4 acc[4][2];
        { const f32x4 c0 = *(const f32x4*)(A.in[14] + 8 * lane), c1 = *(const f32x4*)(A.in[14] + 8 * lane + 4);
#pragma unroll
            for (int r = 0; r < 4; ++r) { acc[r][0] = c0; acc[r][1] = c1; } }
        f32x4 W[4][2]; v4u ubuf[4][4];
#define CONV_NS 34
#define CONV_LOAD(dst, s_) do { if ((s_) < CONV_NS) { const bf16* src_ = up + (size_t)(s_) * 512;   (dst) = *(const v4u*)(src_ + lo); } } while (0)
#define CONV_FMA(s_, r_, uu) do { if ((s_) - (r_) >= 0 && (s_) - (r_) < CONV_W) { acc[r_][0] += W[((s_) - (r_)) & 3][0] * (uu)[0]; acc[r_][1] += W[((s_) - (r_)) & 3][1] * (uu)[1]; } } while (0)
#define CONV_STEP(s_, uw) do { if ((s_) < CONV_NS) { f32x4 uu[2]; uu[0][0] = __uint_as_float((uw).x << 16); uu[0][1] = __uint_as_float((uw).x & 0xffff0000u); uu[0][2] = __uint_as_float((uw).y << 16); uu[0][3] = __uint_as_float((uw).y & 0xffff0000u); \
        uu[1][0] = __uint_as_float((uw).z << 16); uu[1][1] = __uint_as_float((uw).z & 0xffff0000u); uu[1][2] = __uint_as_float((uw).w << 16); uu[1][3] = __uint_as_float((uw).w & 0xffff0000u); if ((s_) < CONV_W) { W[(s_) & 3][0] = *(const LAS f32x4*)(wl + (s_) * 512 + 8 * lane); W[(s_) & 3][1] = *(const LAS f32x4*)(wl + (s_) * 512 + 8 * lane + 4); } \
        CONV_FMA(s_, 0, uu); CONV_FMA(s_, 1, uu); CONV_FMA(s_, 2, uu); CONV_FMA(s_, 3, uu); } } while (0)
#define CONV_GROUP(gq) do { CONV_LOAD(ubuf[((gq) + 3) & 3][0], 4 * (gq) + 12); CONV_LOAD(ubuf[((gq) + 3) & 3][1], 4 * (gq) + 13); CONV_LOAD(ubuf[((gq) + 3) & 3][2], 4 * (gq) + 14); CONV_LOAD(ubuf[((gq) + 3) & 3][3], 4 * (gq) + 15); \
        CONV_STEP(4 * (gq), ubuf[(gq) & 3][0]); CONV_STEP(4 * (gq) + 1, ubuf[(gq) & 3][1]); CONV_STEP(4 * (gq) + 2, ubuf[(gq) & 3][2]); CONV_STEP(4 * (gq) + 3, ubuf[(gq) & 3][3]); asm volatile("" ::: "memory"); } while (0)
        CONV_LOAD(ubuf[0][0], 0); CONV_LOAD(ubuf[0][1], 1); CONV_LOAD(ubuf[0][2], 2); CONV_LOAD(ubuf[0][3], 3); CONV_LOAD(ubuf[1][0], 4); CONV_LOAD(ubuf[1][1], 5); CONV_LOAD(ubuf[1][2], 6); CONV_LOAD(ubuf[1][3], 7);
        CONV_LOAD(ubuf[2][0], 8); CONV_LOAD(ubuf[2][1], 9); CONV_LOAD(ubuf[2][2], 10); CONV_LOAD(ubuf[2][3], 11);
        CONV_GROUP(0); CONV_GROUP(1); CONV_GROUP(2); CONV_GROUP(3); CONV_GROUP(4); CONV_GROUP(5); CONV_GROUP(6); CONV_GROUP(7); CONV_GROUP(8);
#undef CONV_LOAD
#undef CONV_FMA
#undef CONV_STEP
#undef CONV_GROUP
        const f32x4 lg0 = *(const f32x4*)(A.in[15] + 8 * lane), lg1 = *(const f32x4*)(A.in[15] + 8 * lane + 4), lb0 = *(const f32x4*)(A.in[16] + 8 * lane), lb1 = *(const f32x4*)(A.in[16] + 8 * lane + 4);
#pragma unroll
        for (int r = 0; r < 4; ++r) {
            const f32x4 a0 = acc[r][0], a1 = acc[r][1];
            const float s1 = wave_sum(((a0[0] + a0[1]) + (a0[2] + a0[3])) + ((a1[0] + a1[1]) + (a1[2] + a1[3])));
            const float s2 = wave_sum(((a0[0] * a0[0] + a0[1] * a0[1]) + (a0[2] * a0[2] + a0[3] * a0[3])) + ((a1[0] * a1[0] + a1[1] * a1[1]) + (a1[2] * a1[2] + a1[3] * a1[3])));
            const float mean = s1 * (1.f / 512.f), var = fmaxf(s2 * (1.f / 512.f) - mean * mean, 0.f), rstd = 1.0f / sqrtf(var + EPS);
            f32x4 y0 = (a0 - mean) * rstd * lg0 + lb0, y1 = (a1 - mean) * rstd * lg1 + lb1;
#pragma unroll
            for (int i = 0; i < 4; ++i) { y0[i] = pg8::silu_f(y0[i]); y1[i] = pg8::silu_f(y1[i]); }
            *(pg8::u32x4*)(Cb + (size_t)(rowbase + r) * 512 + 8 * lane) = pg8::pack8(y0, y1);
        }
    }
}
typedef float f32x4v __attribute__((ext_vector_type(4))); typedef float f32x2w __attribute__((ext_vector_type(2)));
constexpr float DEC_THR = 8.0f;
__device__ __forceinline__ void decode_items(Frame& F, const Args& A, const int item_first, const int item_end) {
    const GAS float *ck = (const GAS float*)A.in[2], *cv = (const GAS float*)A.in[3], *subln = (const GAS float*)A.in[12]; const GAS int* pt = (const GAS int*)A.in[5]; const GAS float* outf = (const GAS float*)A.out; GAS unsigned char* wsb = (GAS unsigned char*)A.ws;
    asm volatile("" : "+s"(ck), "+s"(cv), "+s"(subln), "+s"(pt), "+s"(outf), "+s"(wsb));
    const GAS bf16 *Qb = (const GAS bf16*)(wsb + WS_Q), *GAb = (const GAS bf16*)(wsb + WS_GA); GAS bf16* Mb = (GAS bf16*)(wsb + WS_M);
    int tid_ = F.wave * 64 + lane_id(); asm volatile("" : "+v"(tid_)); const int lane = tid_ & 63, wave = __builtin_amdgcn_readfirstlane(tid_ >> 6), c16 = lane & 15, g = lane >> 4;
    LAS float* Om = (LAS float*)(F.lds + RING_OFF);
    LAS float* ML = (LAS float*)(F.lds + RING_OFF + 65536);
    for (int item = item_first; item < item_end; item += F.G) {
        const int b = item >> 2, h = item & 3;
        bf16x8 qf[4];
        { const int qi = c16 & 7, mp = c16 >> 3; const GAS bf16* qrow = Qb + (size_t)(MP + b * DEC_S + qi) * 512 + h * 128 + mp * 64 + 4 * g;
            typedef unsigned u32x2 __attribute__((ext_vector_type(2)));
            const u32x2 a0 = *(const GAS u32x2*)(qrow), a1 = *(const GAS u32x2*)(qrow + 16), b0 = *(const GAS u32x2*)(qrow + 32), b1 = *(const GAS u32x2*)(qrow + 48);
            const v4u fa = {a0.x, a0.y, a1.x, a1.y}, fb = {b0.x, b0.y, b1.x, b1.y}, z = {0u, 0u, 0u, 0u};
            qf[0] = __builtin_bit_cast(bf16x8, mp ? z : fa); qf[1] = __builtin_bit_cast(bf16x8, mp ? z : fb);
            qf[2] = __builtin_bit_cast(bf16x8, mp ? fa : z); qf[3] = __builtin_bit_cast(bf16x8, mp ? fb : z); }
        LAS bf16x8* qlds = (LAS bf16x8*)(F.lds + RING_OFF + 73728 + wave * 4096) + lane;
#pragma unroll
        for (int kk = 0; kk < 4; ++kk) qlds[64 * kk] = qf[kk];
        const int ph0 = __builtin_amdgcn_readfirstlane(pt[b * NPAGES + 2 * wave]), ph1 = __builtin_amdgcn_readfirstlane(pt[b * NPAGES + 2 * wave + 1]);
        f32x4v acc[2][4];
#pragma unroll
        for (int jj = 0; jj < 2; ++jj)
#pragma unroll
            for (int rr = 0; rr < 4; ++rr) acc[jj][rr] = (f32x4v){0.f, 0.f, 0.f, 0.f};
        float mref = -INFINITY, lsum = 0.f;
        const int kperm = 4 * (4 * c16 + g);
        f32x4v KA[8], VA[8], KB[8], VB[8];
#define DEC_ISSUE_K(KX, tt_) do { const int pg_ = (tt_) < 8 ? ph0 : ph1; const size_t tb_ = ((size_t)pg_ * 128 + ((tt_) & 7) * 16) * 512 + h * 128; \
        const GAS float* kp_ = ck + tb_ + (size_t)(lane >> 2) * 512 + 4 * (lane & 3); \
        _Pragma("unroll") for (int j_ = 0; j_ < 8; ++j_) KX[j_] = (*(const GAS f32x4v*)(kp_ + 16 * j_)); } while (0)
#define DEC_ISSUE_V(VX, tt_) do { const int pg_ = (tt_) < 8 ? ph0 : ph1; const size_t tb_ = ((size_t)pg_ * 128 + ((tt_) & 7) * 16) * 512 + h * 128; \
        const GAS float* vp_ = cv + tb_ + (size_t)(4 * g) * 512 + 4 * c16; \
        _Pragma("unroll") for (int r_ = 0; r_ < 4; ++r_) { VX[2 * r_] = (*(const GAS f32x4v*)(vp_ + r_ * 512)); VX[2 * r_ + 1] = (*(const GAS f32x4v*)(vp_ + r_ * 512 + 64)); } } while (0)
#define DEC_TILE(KX, VX, MASKED, NEXT_OK, tn_) do { \
        bf16x8 ka_[4]; \
        _Pragma("unroll") for (int kk_ = 0; kk_ < 4; ++kk_) { const v4u w_ = {attn128::cvtpk_s(KX[2 * kk_][0], KX[2 * kk_][1]), attn128::cvtpk_s(KX[2 * kk_][2], KX[2 * kk_][3]), attn128::cvtpk_s(KX[2 * kk_ + 1][0], KX[2 * kk_ + 1][1]), attn128::cvtpk_s(KX[2 * kk_ + 1][2], KX[2 * kk_ + 1][3])}; v4u x_; _Pragma("unroll") for (int e_ = 0; e_ < 4; ++e_) x_[e_] = (unsigned)__builtin_amdgcn_ds_bpermute(kperm, (int)w_[e_]); ka_[kk_] = __builtin_bit_cast(bf16x8, x_); } \
        if (NEXT_OK) DEC_ISSUE_K(KX, tn_); \
        f32x4v s_ = {0.f, 0.f, 0.f, 0.f}; \
        _Pragma("unroll") for (int kk_ = 0; kk_ < 4; ++kk_) s_ = __builtin_amdgcn_mfma_f32_16x16x32_bf16(ka_[kk_], qlds[64 * kk_], s_, 0, 0, 0); \
        if (MASKED) { const int qi_ = c16 & 7; _Pragma("unroll") for (int r_ = 0; r_ < 4; ++r_) if (4 * g + r_ > qi_) s_[r_] = -INFINITY; } \
        float tm_ = fmaxf(fmaxf(s_[0], s_[1]), fmaxf(s_[2], s_[3])); tm_ = xrow_max(tm_); \
        if (__any(tm_ > mref + DEC_THR)) { const float mn_ = fmaxf(mref, tm_), al_ = __builtin_amdgcn_exp2f(mref - mn_); mref = mn_; lsum *= al_; \
            _Pragma("unroll") for (int jj_ = 0; jj_ < 2; ++jj_) _Pragma("unroll") for (int rr_ = 0; rr_ < 4; ++rr_) acc[jj_][rr_] *= al_; } \
        float p_[4]; \
        _Pragma("unroll") for (int r_ = 0; r_ < 4; ++r_) { p_[r_] = __builtin_amdgcn_exp2f(s_[r_] - mref); lsum += p_[r_]; } \
        const v4u pb_ = {attn128::cvtpk_s(p_[0], p_[1]), attn128::cvtpk_s(p_[2], p_[3]), 0u, 0u}; \
        _Pragma("unroll") for (int jj_ = 0; jj_ < 2; ++jj_) _Pragma("unroll") for (int rr_ = 0; rr_ < 4; ++rr_) { \
            const v4u va_ = {attn128::cvtpk_s(VX[jj_][rr_], VX[2 + jj_][rr_]), attn128::cvtpk_s(VX[4 + jj_][rr_], VX[6 + jj_][rr_]), 0u, 0u}; \
            acc[jj_][rr_] = __builtin_amdgcn_mfma_f32_16x16x32_bf16(__builtin_bit_cast(bf16x8, va_), __builtin_bit_cast(bf16x8, pb_), acc[jj_][rr_], 0, 0, 0); } \
        if (NEXT_OK) DEC_ISSUE_V(VX, tn_); } while (0)
        DEC_ISSUE_K(KA, 0); DEC_ISSUE_V(VA, 0); DEC_ISSUE_K(KB, 1); DEC_ISSUE_V(VB, 1);
        for (int tt = 0; tt < 16; tt += 2) {
            DEC_TILE(KA, VA, false, tt + 2 < 16, tt + 2);
            DEC_TILE(KB, VB, false, tt + 3 < 16, tt + 3);
        }
        if (wave == 7) {
            const GAS float* kp = outf + OFF_KS + (size_t)(b * DEC_S + ((lane >> 2) < 7 ? (lane >> 2) : 7)) * 512 + h * 128 + 4 * (lane & 3);
#pragma unroll
            for (int j = 0; j < 8; ++j) KA[j] = *(const GAS f32x4v*)(kp + 16 * j);
#pragma unroll
            for (int r = 0; r < 4; ++r) { const int key = 4 * g + r < 7 ? 4 * g + r : 7; const GAS float* vp = outf + OFF_VS + (size_t)(b * DEC_S + key) * 512 + h * 128 + 4 * c16;
                VA[2 * r] = *(const GAS f32x4v*)(vp); VA[2 * r + 1] = *(const GAS f32x4v*)(vp + 64); }
            DEC_TILE(KA, VA, true, false, 0);
        }
#undef DEC_ISSUE_K
#undef DEC_ISSUE_V
#undef DEC_TILE
        const float lt = xrow_sum(lsum);
        if (g == 0) { ML[(wave * 16 + c16) * 2] = mref; ML[(wave * 16 + c16) * 2 + 1] = lt; }
#pragma unroll
        for (int jj = 0; jj < 2; ++jj)
#pragma unroll
            for (int e = 0; e < 4; ++e) *(LAS f32x4v*)(Om + (size_t)((wave * 16 + c16) * 128 + 64 * jj + 16 * g + 4 * e)) = (f32x4v){acc[jj][0][e], acc[jj][1][e], acc[jj][2][e], acc[jj][3][e]};
        __syncthreads();
        { const int qi = wave; float on[2][2];
#pragma unroll
            for (int mp = 0; mp < 2; ++mp) { const int col = mp * 8 + qi; float M = -INFINITY;
#pragma unroll
                for (int w = 0; w < 8; ++w) M = fmaxf(M, ML[(w * 16 + col) * 2]);
                float L = 0.f, o0 = 0.f, o1 = 0.f;
#pragma unroll
                for (int w = 0; w < 8; ++w) { const float wt = __builtin_amdgcn_exp2f(ML[(w * 16 + col) * 2] - M); L = fmaf(wt, ML[(w * 16 + col) * 2 + 1], L);
                    const f32x2w ov = *(const LAS f32x2w*)(Om + (size_t)((w * 16 + col) * 128 + 2 * lane)); o0 = fmaf(wt, ov.x, o0); o1 = fmaf(wt, ov.y, o1); }
                const float inv = 1.0f / L; on[mp][0] = o0 * inv; on[mp][1] = o1 * inv; }
            const float lam = compute_lam(F, A);
            const float d0 = on[0][0] - lam * on[1][0], d1 = on[0][1] - lam * on[1][1];
            const float rs = 1.0f / sqrtf(wave_sum(d0 * d0 + d1 * d1) * (1.f / 128.f) + EPS);
            const size_t row = (size_t)(MP + b * DEC_S + qi); const int cc = h * 128 + 2 * lane;
            const unsigned gaw = *(const GAS unsigned*)(GAb + row * 512 + cc);
            const float y0 = d0 * rs * subln[2 * lane] * __uint_as_float(gaw << 16), y1 = d1 * rs * subln[2 * lane + 1] * __uint_as_float(gaw & 0xffff0000u);
            *(GAS unsigned*)(Mb + row * 1024 + cc) = pk2(y0, y1); }
        __syncthreads();
    }
}
__device__ __forceinline__ void attn_post(Frame& F, const Args& A, const int blk) {
    const float lam = compute_lam(F, A);
    const float* subln = A.in[12]; const bf16 *O1b = WSP(bf16, WS_O1), *O2b = WSP(bf16, WS_O2), *GAb = WSP(bf16, WS_GA); bf16* Mb = WSP(bf16, WS_M);
    int tid_ = F.wave * 64 + lane_id(); asm volatile("" : "+v"(tid_)); const int lane = tid_ & 63, wv = __builtin_amdgcn_readfirstlane(tid_ >> 6);
    const f32x4 sg0 = *(const f32x4*)(subln + (8 * lane & 127)), sg1 = *(const f32x4*)(subln + (8 * lane & 127) + 4);
    const int row0 = (blk >> 7) * SEQ + (blk & 31) * 256 + (lane >> 4), col = ((blk >> 5) & 3) * 128 + 8 * (lane & 15);
    for (int trip = wv; trip < 16; trip += NWAVES) {
        v4u a[4], b[4], gq[4];
#pragma unroll
        for (int r = 0; r < 4; ++r) { const size_t ro = (size_t)(row0 + 16 * trip + 4 * r) * 512 + col; a[r] = *(const v4u*)(O1b + ro); b[r] = *(const v4u*)(O2b + ro); gq[r] = *(const v4u*)(GAb + ro); }
#pragma unroll
        for (int r = 0; r < 4; ++r) {
            float o[8], gg[8]; float ss = 0.f;
#pragma unroll
            for (int i = 0; i < 4; ++i) { const unsigned aw = a[r][i], bw = b[r][i], gw_ = gq[r][i];
                o[2 * i] = __uint_as_float(aw << 16) - lam * __uint_as_float(bw << 16); o[2 * i + 1] = __uint_as_float(aw & 0xffff0000u) - lam * __uint_as_float(bw & 0xffff0000u);
                gg[2 * i] = __uint_as_float(gw_ << 16); gg[2 * i + 1] = __uint_as_float(gw_ & 0xffff0000u);
                ss += o[2 * i] * o[2 * i] + o[2 * i + 1] * o[2 * i + 1]; }
            ss = row16_sum(ss);
            const float rs = 1.0f / sqrtf(ss * (1.f / 128.f) + EPS);
            v4u w; w.x = pk2(o[0] * rs * sg0[0] * gg[0], o[1] * rs * sg0[1] * gg[1]); w.y = pk2(o[2] * rs * sg0[2] * gg[2], o[3] * rs * sg0[3] * gg[3]);
            w.z = pk2(o[4] * rs * sg1[0] * gg[4], o[5] * rs * sg1[1] * gg[5]); w.w = pk2(o[6] * rs * sg1[2] * gg[6], o[7] * rs * sg1[3] * gg[7]);
            { bf16* mp_ = Mb + (size_t)(row0 + 16 * trip + 4 * r) * 1024 + col; asm volatile("global_store_dwordx4 %0, %1, off sc1\n\ts_nop 1" :: "v"(mp_), "v"(w) : "memory"); } }
    }
}
template <bool PROMPT> __device__ __forceinline__ void final_norm(Frame& F, const Args& A, const int first_cu) {
    if (PROMPT && (int)blockIdx.x < first_cu) return;
    const float* part = WSP(float, WS_PART); const float* xs = A.in[1]; float* out = A.out;
    int tid_ = F.wave * 64 + lane_id(); asm volatile("" : "+v"(tid_)); const int lane = tid_ & 63, gw = ((int)blockIdx.x - first_cu) * NWAVES + __builtin_amdgcn_readfirstlane(tid_ >> 6), NGW = ((int)F.G - first_cu) * NWAVES;
    f32x4 gv[4];
#pragma unroll
    for (int j = 0; j < 4; ++j) gv[j] = *((const f32x4*)A.in[20] + lane + 64 * j);
    if constexpr (PROMPT) { const float* xp = A.in[0]; const bf16* mix = WSP(bf16, WS_MIX); typedef unsigned u32x2 __attribute__((ext_vector_type(2)));
      for (int grp = gw; grp < MP / 4; grp += NGW) {
        f32x4 y[4][4]; u32x2 mw[4][4];
#pragma unroll
        for (int r = 0; r < 4; ++r)
#pragma unroll
            for (int j = 0; j < 4; ++j) { y[r][j] = *((const f32x4*)(xp + (size_t)(4 * grp + r) * D_MODEL) + lane + 64 * j); mw[r][j] = *((const u32x2*)(mix + (size_t)(4 * grp + r) * D_MODEL) + lane + 64 * j); }
#pragma unroll
        for (int r = 0; r < 4; ++r) { float ss = 0.f;
#pragma unroll
            for (int j = 0; j < 4; ++j) { y[r][j][0] += __uint_as_float(mw[r][j].x << 16); y[r][j][1] += __uint_as_float(mw[r][j].x & 0xffff0000u); y[r][j][2] += __uint_as_float(mw[r][j].y << 16); y[r][j][3] += __uint_as_float(mw[r][j].y & 0xffff0000u);
                ss += (y[r][j][0] * y[r][j][0] + y[r][j][1] * y[r][j][1]) + (y[r][j][2] * y[r][j][2] + y[r][j][3] * y[r][j][3]); }
            const float rs = 1.0f / sqrtf(wave_sum(ss) * (1.f / D_MODEL) + EPS);
#pragma unroll
            for (int j = 0; j < 4; ++j) { const f32x4 yo_ = y[r][j] * rs * gv[j]; float* yp_ = out + (size_t)(4 * grp + r) * D_MODEL + 4 * (lane + 64 * j); asm volatile("global_store_dwordx4 %0, %1, off sc1\n\ts_nop 1" :: "v"(yp_), "v"(yo_) : "memory"); } }
      } }
    else for (int row = first_cu + 2 * (gw & 7), rend = row + 2; row < rend; ++row) {
        f32x4 y[4]; float ss = 0.f;
#pragma unroll
        for (int j = 0; j < 4; ++j) { const size_t o = (size_t)row * D_MODEL + 4 * lane + 256 * j;
            y[j] = *(const f32x4*)(xs + o) + ((*(const f32x4*)(part + o) + *(const f32x4*)(part + o + (size_t)MS * D_MODEL)) + (*(const f32x4*)(part + o + 2 * (size_t)MS * D_MODEL) + *(const f32x4*)(part + o + 3 * (size_t)MS * D_MODEL)));
            ss += (y[j][0] * y[j][0] + y[j][1] * y[j][1]) + (y[j][2] * y[j][2] + y[j][3] * y[j][3]); }
        const float rs = 1.0f / sqrtf(wave_sum(ss) * (1.f / D_MODEL) + EPS);
#pragma unroll
        for (int j = 0; j < 4; ++j) *((f32x4*)(out + OFF_YS + (size_t)row * D_MODEL) + lane + 64 * j) = y[j] * rs * gv[j];
    }
}

__global__ void __launch_bounds__(NWAVES * 64, 2) hymba_fwd(Args args) {
    extern __shared__ __attribute__((aligned(16))) unsigned char lds[];
    Frame F;
    F.lds = (LAS unsigned char*)lds;
    F.MISC = (volatile LAS unsigned*)(F.lds + MISC_OFF);
    F.wave = __builtin_amdgcn_readfirstlane((int)threadIdx.x >> 6);
    F.G = gridDim.x; { const int bx = blockIdx.x; F.vcu = (F.G % 8 == 0) ? (bx % 8) * (F.G / 8) + bx / 8 : bx; }
    const Args& A = args;
    F.ctl = (gu32*)(A.ws + WS_CTL);
    for (int u = F.wave * 64 + lane_id(); u < (LDS_BYTES - LDSCTL_OFF) / 4; u += NWAVES * 64) ((LAS unsigned*)(F.lds + LDSCTL_OFF))[u] = 0u;
    __syncthreads();
    XcdBarrier bar = xcd_barrier_post((unsigned*)(F.ctl + CW_BAR), F.MISC + 8, F.wave);

#ifndef SKIP_P0
    p0_prologue(F, A);
#endif
    xcd_barrier(bar);
#ifndef SKIP_G1
    { pg8::Gemm g{WSP(bf16, WS_XN), WSP(bf16, WS_WIN), MT, D_IN, D_MODEL, D_MODEL}; pg8::StaticOrder S; S.init(MT, D_IN, F.G, (int)blockIdx.x);
      pg8::EpiIn E{WSP(bf16, WS_Q), WSP(bf16, WS_K), WSP(bf16, WS_V), WSP(bf16, WS_GA), WSP(bf16, WS_GC), WSP(bf16, WS_U), A.out};
      pg8::gemm_phase<pg8::EpiIn, pg8::StaticOrder, false, PG8_SP2>(F.lds + RING_OFF, g, S, E, F.wave); }
#endif
    p1_idle_transposes(F, A);
    xcd_barrier(bar);
#ifndef SKIP_CONV
    conv_phase(F, A);
#endif
    asm volatile("s_waitcnt vmcnt(0)" ::: "memory");
    __syncthreads();
    if (F.wave == 0 && lane_id() == 0) {
        xcd_arrive((unsigned*)F.ctl, CW_XCONV, CW_CONV, bar.x, F.MISC[8]); }
    {
      const attn128::bf16 *Qp = WSP(const attn128::bf16, WS_Q), *Kp = WSP(const attn128::bf16, WS_K), *Vp = WSP(const attn128::bf16, WS_V);
      const int grp = F.vcu >> 4, s16 = F.vcu & 15, ab = grp >> 3, ah = (grp >> 1) & 3, amap = grp & 1;
      const int cmb = ((F.vcu & 31) * 3) >> 5; const bool rev = cmb != 1 || (grp & 1) != 0; const int sa = cmb, sb = cmb;
      for (int i = 0; i < 3; ++i) {
          if (i == sa) decode_items(F, A, F.vcu, DEC_B * 4);
          if (i < 2) { const int qb = ((i == 0) != rev) ? s16 : 31 - s16;
              attn128::bf16* Op = amap ? WSP(attn128::bf16, WS_O2) : WSP(attn128::bf16, WS_O1);
              if (attn128::attn_unit<8, true>(ab, ah * 128 + amap * 64, ah * 128, qb, Qp, Kp, Vp, Op, (char*)lds + RING_OFF, F.wave))
                  (void)attn128::attn_unit<8, false>(ab, ah * 128 + amap * 64, ah * 128, qb, Qp, Kp, Vp, Op, (char*)lds + RING_OFF, F.wave);
              asm volatile("s_waitcnt vmcnt(0)" ::: "memory");
              __syncthreads();
              if (F.wave == 0 && lane_id() == 0) { const int blk = (grp >> 1) * 32 + qb;
                  if (xb_add((unsigned*)(F.ctl + CW_PAIR + 16 * blk), 1u) == 1u) { const unsigned qi = xb_add((unsigned*)(F.ctl + CW_QTAIL), 1u);
                      __hip_atomic_store((unsigned*)(F.ctl + CW_QUEUE + 8 * (qi & 255u)), (unsigned)blk + 1u, RLX_AGENT); } } }

      }
    }
    asm volatile("s_waitcnt vmcnt(0)" ::: "memory");
    __syncthreads();
    if (F.wave == 0 && lane_id() == 0) {
        unsigned* tb = (unsigned*)(F.ctl + CW_BAR);
        const unsigned t = xb_add((unsigned*)(F.ctl + CW_TICKET), 1u);
        if (t < (unsigned)((MT / 256) * 2)) { XB_SPIN(xb_ld((unsigned*)(F.ctl + CW_CONV)) < (unsigned)F.G, tb); __builtin_amdgcn_fence(__ATOMIC_ACQUIRE, "agent"); asm volatile("s_waitcnt vmcnt(0)" ::: "memory"); }
        F.MISC[12] = t; }
    __syncthreads();
    { pg8::Gemm g{WSP(bf16, WS_C), WSP(bf16, WS_WPW), MT, 512, 512, 512}; pg8::TicketOrder S{__builtin_amdgcn_readfirstlane((int)F.MISC[12])};
      pg8::EpiPw2 E{A.in[18], WSP(bf16, WS_GC), WSP(bf16, WS_M)};
      pg8::gemm_phase<pg8::EpiPw2, pg8::TicketOrder, PG8_ALIGN, PG8_SP2>(F.lds + RING_OFF, g, S, E, F.wave); }
    { const int t_ = __builtin_amdgcn_readfirstlane((int)F.MISC[12]);
      if (t_ < 128) {
          asm volatile("s_waitcnt vmcnt(0)" ::: "memory");
          __syncthreads();
          if (F.wave == 0 && lane_id() == 0) panel_post((unsigned*)F.ctl, t_ >> 1); } }
    for (;;) {
        __syncthreads();
        if (F.wave == 0 && lane_id() == 0) { unsigned* tb = (unsigned*)(F.ctl + CW_BAR);
            const unsigned qi = xb_add((unsigned*)(F.ctl + CW_QHEAD), 1u); unsigned e = 0u;
            if (qi < 256u) { unsigned* qe = (unsigned*)(F.ctl + CW_QUEUE + 8 * qi); XB_SPIN((e = xb_ld(qe)) == 0u, tb);
                __builtin_amdgcn_fence(__ATOMIC_ACQUIRE, "agent"); asm volatile("s_waitcnt vmcnt(0)" ::: "memory"); }
            F.MISC[13] = e; }
        __syncthreads();
        const int e = __builtin_amdgcn_readfirstlane((int)F.MISC[13]);
        if (e == 0) break;
        attn_post(F, A, e - 1);
        asm volatile("s_waitcnt vmcnt(0)" ::: "memory");
        __syncthreads();
        if (F.wave == 0 && lane_id() == 0) panel_post((unsigned*)F.ctl, ((e - 1) >> 7) * 32 + ((e - 1) & 31));
    }
    for (;;) {
        __syncthreads();
        if (F.wave == 0 && lane_id() == 0) { unsigned* tb = (unsigned*)(F.ctl + CW_BAR);
            const unsigned qi = xb_add((unsigned*)(F.ctl + CW_PHEAD), 1u); unsigned e = 0u;
            if (qi < 256u) { unsigned* qe = (unsigned*)(F.ctl + CW_PQ + 4 * qi); XB_SPIN((e = xb_ld(qe)) == 0u, tb);
                __builtin_amdgcn_fence(__ATOMIC_ACQUIRE, "agent"); asm volatile("s_waitcnt vmcnt(0)" ::: "memory"); }
            F.MISC[13] = e; }
        __syncthreads();
        const int e = __builtin_amdgcn_readfirstlane((int)F.MISC[13]);
        if (e == 0) break;
        { pg8::Gemm g{WSP(bf16, WS_M), WSP(bf16, WS_WOUT), MP, D_MODEL, D_MODEL, D_MODEL}; pg8::OneUnit S{(e - 1) >> 2, (e - 1) & 3};
          pg8::EpiOut E{WSP(bf16, WS_MIX)};
          pg8::gemm_phase<pg8::EpiOut, pg8::OneUnit, PG8_ALIGN, PG8_SP2>(F.lds + RING_OFF, g, S, E, F.wave); }
    }
    xcd_barrier(bar);
    { const int c = (int)blockIdx.x, kc = c & 3;
      pg8::Gemm g{WSP(bf16, WS_M) + kc * 256, WSP(bf16, WS_WOUT) + kc * 256, MT, D_MODEL, 256, D_MODEL}; pg8::SampleOrder S{c};
      pg8::EpiPart E{WSP(float, WS_PART) + (size_t)kc * MS * D_MODEL};
      pg8::gemm_phase<pg8::EpiPart, pg8::SampleOrder, PG8_ALIGN, PG8_SP2>(F.lds + RING_OFF, g, S, E, F.wave); }
    if ((int)blockIdx.x < 64) {
        const int rb = (int)blockIdx.x >> 4;
        asm volatile("s_waitcnt vmcnt(0)" ::: "memory");
        __syncthreads();
        if (F.wave == 0 && lane_id() == 0) {
            unsigned* cnt = (unsigned*)(F.ctl + CW_SROW + 64 * rb); unsigned* tb = (unsigned*)(F.ctl + CW_BAR);
            __builtin_amdgcn_fence(__ATOMIC_RELEASE, "agent");
            asm volatile("s_waitcnt vmcnt(0)" ::: "memory");
            (void)xb_add(cnt, 1u);
            XB_SPIN(xb_ld(cnt) < 16u, tb);
            __builtin_amdgcn_fence(__ATOMIC_ACQUIRE, "agent");
            asm volatile("s_waitcnt vmcnt(0)" ::: "memory");
        }
        __syncthreads();
        final_norm<false>(F, A, rb * 256 + ((int)blockIdx.x & 15) * 16);
    }
#ifndef SKIP_FIN
    else final_norm<true>(F, A, 64);
#endif
}

extern "C" void kernel_launch(void* const* d_in, const int* in_sizes, int n_in, void* d_out, int out_size, void* d_ws, size_t ws_size, hipStream_t stream) {
    static int grid = 0;
    if (grid == 0) {
        if (n_in != 21 || in_sizes[0] != MP * D_MODEL || (size_t)out_size != OUT_TOTAL || ws_size < WS_END) { fprintf(stderr, "kernel_launch: unexpected problem (n_in %d, in0 %d, out %d, ws %zu); nothing launched\n", n_in, n_in > 0 ? in_sizes[0] : -1, out_size, ws_size); grid = -1; return; }
        int dev = 0, cus = 0, per_cu = 0;
        if (hipGetDevice(&dev) != hipSuccess || hipDeviceGetAttribute(&cus, hipDeviceAttributeMultiprocessorCount, dev) != hipSuccess) { fprintf(stderr, "kernel_launch: device query failed\n"); grid = -1; return; }
        if (hipFuncSetAttribute((const void*)hymba_fwd, hipFuncAttributeMaxDynamicSharedMemorySize, LDS_BYTES) != hipSuccess) { fprintf(stderr, "kernel_launch: hipFuncSetAttribute failed\n"); grid = -1; return; }
        if (hipOccupancyMaxActiveBlocksPerMultiprocessor(&per_cu, (const void*)hymba_fwd, NWAVES * 64, LDS_BYTES) != hipSuccess || per_cu < 1)
            fprintf(stderr, "kernel_launch: note: occupancy query reports %d workgroups per CU\n", per_cu);
        (void)hipGetLastError();
        grid = cus;
        if (grid != 256) fprintf(stderr, "kernel_launch: %d CUs; the attention unit deal is written for 256\n", grid);
    }
    if (grid < 0) return;
    if (hipMemsetAsync((char*)d_ws + WS_CTL, 0, CTL_ZERO_BYTES, stream) != hipSuccess) { fprintf(stderr, "kernel_launch: memset failed\n"); return; }
    Args a{};
    for (int i = 0; i < 21; ++i) a.in[i] = (const float*)d_in[i];
    a.out = (float*)d_out; a.ws = (unsigned char*)d_ws;
    hipLaunchKernelGGL(hymba_fwd, dim3(grid), dim3(NWAVES * 64), LDS_BYTES, stream, a);
    const hipError_t le = hipPeekAtLastError();
    if (le != hipSuccess) fprintf(stderr, "kernel_launch: launch failed: %s\n", hipGetErrorName(le));
}
```

```cpp
#include <hip/hip_runtime.h>
#include <cstdio>
#include <cstdint>
constexpr int D_MODEL = 1024, SEQ = 8192, NBATCH = 2, MP = NBATCH * SEQ;
constexpr int DEC_B = 128, DEC_S = 8, MS = DEC_B * DEC_S;
constexpr int MT = MP + MS;
constexpr int D_IN = 3584, CONV_W = 31, HIST = 30, NPAGES = 16;
constexpr float EPS = 1e-5f, LOG2E = 1.4426950408889634f;
constexpr float QSCALE = 0.125f * LOG2E;
constexpr size_t OFF_YP = 0, OFF_YS = OFF_YP + (size_t)MP * D_MODEL, OFF_KP = OFF_YS + (size_t)MS * D_MODEL, OFF_VP = OFF_KP + (size_t)MP * 512, OFF_CP = OFF_VP + (size_t)MP * 512,
    OFF_KS = OFF_CP + (size_t)NBATCH * HIST * 512, OFF_VS = OFF_KS + (size_t)MS * 512, OFF_CS = OFF_VS + (size_t)MS * 512, OUT_TOTAL = OFF_CS + (size_t)DEC_B * HIST * 512;
static_assert(OUT_TOTAL == 37648384, "output size");
constexpr int UP_SEQ = SEQ + HIST, USMP0 = NBATCH * UP_SEQ, US_SEQ = HIST + DEC_S, U_ROWS = USMP0 + DEC_B * US_SEQ;
__host__ __device__ __forceinline__ int u_row(int row) { return row < MP ? row + HIST * ((row >> 13) + 1) : USMP0 + ((row - MP) >> 3) * US_SEQ + HIST + ((row - MP) & 7); }
__device__ __forceinline__ int lane_id() { int l; asm volatile("v_mbcnt_lo_u32_b32 %0, -1, 0\n\tv_mbcnt_hi_u32_b32 %0, -1, %0" : "=v"(l)); return l; }
namespace pg8 {
#define PG8_LAS __attribute__((address_space(3)))
typedef unsigned short bf16_t;
typedef short bf16x8 __attribute__((ext_vector_type(8)));
typedef float f32x4 __attribute__((ext_vector_type(4)));
typedef unsigned u32x4 __attribute__((ext_vector_type(4)));
constexpr int BM = 256, BK = 64, HALF = 128, HTB = HALF * BK * 2  , STAGE_BYTES = 8 * HTB, NXCD = 8, WGM = 8;

__host__ __device__ __forceinline__ int lds_byte(int r, int c) { const int st = (r >> 4) * 2 + (c >> 5), rr = r & 15, cc = c & 31, ob = rr * 64 + cc * 2; return st * 1024 + (ob ^ (((ob >> 9) & 1) << 5)); }
__host__ __device__ __forceinline__ void stage_rc(int b, int& R, int& C) { const int st = b / 1024, sb = b % 1024, swz = sb ^ (((sb >> 9) & 1) << 5); R = (st >> 1) * 16 + swz / 64; C = (st & 1) * 32 + (swz % 64) / 2; }
__host__ __device__ __forceinline__ int perm32(int rho) { const int n = rho >> 4, i = rho & 15; return 8 * (i >> 2) + 4 * n + (i & 3); }

struct Unit { int pm, pn; };
struct Gemm { const bf16_t* A; const bf16_t* Bt; int M, N, K, ld; };

struct StaticOrder {
    int nM, nN, nwg, G, c;
    __host__ __device__ void init(int M, int N, int G_, int c_) { nM = M / BM; nN = N / BM; nwg = nM * nN; G = G_; c = c_; }
    __host__ __device__ bool next(int i, Unit& u) const {
        const long L = (long)i * G + c; if (L >= nwg) return false;
        int wgid = (int)L; { const int q = nwg / NXCD, r = nwg % NXCD, xcd = wgid % NXCD, off = wgid / NXCD; wgid = (xcd < r ? xcd * (q + 1) : r * (q + 1) + (xcd - r) * q) + off; }
        const int nig = WGM * nN, gid = wgid / nig, fm = gid * WGM, gsz = (nM - fm) < WGM ? (nM - fm) : WGM;
        u.pm = fm + ((wgid % nig) % gsz); u.pn = (wgid % nig) / gsz; return true;
    }
    __device__ __forceinline__ void a_ready(const Unit&) const {}
    __device__ __forceinline__ void done(const Unit&) const {}
};
__device__ __forceinline__ unsigned cvt_pk_bf16(float lo, float hi) { unsigned r; asm volatile("v_cvt_pk_bf16_f32 %0, %1, %2" : "=v"(r) : "v"(lo), "v"(hi)); return r; }
typedef float f32x2 __attribute__((ext_vector_type(2)));
__device__ __forceinline__ float sigm_f(float x) { return __builtin_amdgcn_rcpf(1.0f + __builtin_amdgcn_exp2f(-LOG2E * x)); }
__device__ __forceinline__ float silu_f(float x) { return x * sigm_f(x); }
__device__ __forceinline__ u32x4 pack8(const f32x4 v0, const f32x4 v1) { u32x4 w; w.x = cvt_pk_bf16(v0[0], v0[1]); w.y = cvt_pk_bf16(v0[2], v0[3]); w.z = cvt_pk_bf16(v1[0], v1[1]); w.w = cvt_pk_bf16(v1[2], v1[3]); return w; }
#define ST16_WT(p, v) asm volatile("global_store_dwordx4 %0, %1, off sc1\n\ts_nop 1" :: "v"(p), "v"(v) : "memory")
struct EpiIn {
    static constexpr bool PERM = true, AFTER_DRAIN = false;
    bf16_t *Qb, *Kb, *Vb, *GAb, *GCb; bf16_t* U; float* out;
    __device__ __forceinline__ void operator()(const f32x4 (&acc)[2][2][4][2], const Unit& u, int wr, int wc, int fr, int fq) const {
        const int row0 = u.pm * BM + wr * 64 + fr, pn = u.pn, cw = wc * 32 + 8 * fq;
        if (pn < 2 || pn == 6 || pn == 7 || pn >= 12) {
            bf16_t* base; int mode;
            if (pn < 2) { base = Qb + pn * 256; mode = 0; } else if (pn < 8) { base = GAb + (pn - 6) * 256; mode = 1; } else { base = GCb + (pn - 12) * 256; mode = 2; }
#pragma unroll
            for (int ai = 0; ai < 2; ++ai)
#pragma unroll
                for (int m = 0; m < 4; ++m) { bf16_t* rowp = base + (size_t)(row0 + ai * HALF + m * 16) * 512 + cw;
#pragma unroll
                    for (int bj = 0; bj < 2; ++bj) { f32x4 v0 = acc[ai][bj][m][0], v1 = acc[ai][bj][m][1];
                        if (mode == 0) { v0 = v0 * QSCALE; v1 = v1 * QSCALE; }
                        else { const float sc = mode == 1 ? 0.8f : 1.0f;
#pragma unroll
                            for (int i = 0; i < 4; ++i) { v0[i] = silu_f(v0[i]) * sc; v1[i] = silu_f(v1[i]) * sc; } }
                        *(u32x4*)(rowp + bj * HALF) = pack8(v0, v1); } }
        } else if (pn < 6) {
            const int t = (pn - 2) >> 1, cb = ((pn - 2) & 1) * 256 + cw; const bool smp = u.pm >= MP / BM;
            bf16_t* bb = (t ? Vb : Kb) + cb;
            float* fb = out + (smp ? (t ? OFF_VS : OFF_KS) - (size_t)MP * 512 : (t ? OFF_VP : OFF_KP)) + cb;
#pragma unroll
            for (int ai = 0; ai < 2; ++ai)
#pragma unroll
                for (int m = 0; m < 4; ++m) { const size_t ro = (size_t)(row0 + ai * HALF + m * 16) * 512;
#pragma unroll
                    for (int bj = 0; bj < 2; ++bj) { const f32x4 v0 = acc[ai][bj][m][0], v1 = acc[ai][bj][m][1];
                        *(f32x4*)(fb + ro + bj * HALF) = v0; *(f32x4*)(fb + ro + bj * HALF + 4) = v1; *(u32x4*)(bb + ro + bj * HALF) = pack8(v0, v1); } }
        } else {
            bf16_t* ub = U + 128 * (pn - 8) + cw; const int ccol = 128 * (pn - 8) + cw;
            const bool outs = (u.pm & 31) == 31 || u.pm >= MP / BM;
#pragma unroll
            for (int ai = 0; ai < 2; ++ai)
#pragma unroll
                for (int m = 0; m < 4; ++m) { const int row = row0 + ai * HALF + m * 16; const size_t ro = (size_t)u_row(row) * 512; f32x4 o[2];
#pragma unroll
                    for (int n = 0; n < 2; ++n) { const f32x4 a = acc[ai][0][m][n], b = acc[ai][1][m][n];
#pragma unroll
                        for (int i = 0; i < 4; ++i) o[n][i] = a[i] * sigm_f(b[i]); }
                    *(u32x4*)(ub + ro) = pack8(o[0], o[1]);
                    if (outs) { long od = -1;
                        if (row < MP) { const int t = row & (SEQ - 1); if (t >= SEQ - HIST) od = (long)OFF_CP + ((long)(row >> 13) * HIST + (t - (SEQ - HIST))) * 512; }
                        else { const int rs = row - MP; od = (long)OFF_CS + ((long)(rs >> 3) * HIST + (HIST - DEC_S) + (rs & 7)) * 512; }
                        if (od >= 0) { *(f32x4*)(out + od + ccol) = o[0]; *(f32x4*)(out + od + ccol + 4) = o[1]; } } }
        }
    }
};
struct EpiPw2 {
    static constexpr bool PERM = true, AFTER_DRAIN = false;
    const float* bias; const bf16_t* GCb; bf16_t* Mb;
    __device__ __forceinline__ void operator()(const f32x4 (&acc)[2][2][4][2], const Unit& u, int wr, int wc, int fr, int fq) const {
        const int row0 = u.pm * BM + wr * 64 + fr, c0 = u.pn * BM + wc * 32 + 8 * fq;
        f32x4 bv[2][2];
#pragma unroll
        for (int bj = 0; bj < 2; ++bj)
#pragma unroll
            for (int n = 0; n < 2; ++n) bv[bj][n] = *(const f32x4*)(bias + c0 + bj * HALF + 4 * n);
#pragma unroll
        for (int ai = 0; ai < 2; ++ai)
#pragma unroll
            for (int m = 0; m < 4; ++m) { const size_t r = (size_t)(row0 + ai * HALF + m * 16);
#pragma unroll
                for (int bj = 0; bj < 2; ++bj) { const u32x4 gw = *(const u32x4*)(GCb + r * 512 + c0 + bj * HALF);
                    f32x4 g0, g1; g0[0] = __uint_as_float(gw.x << 16); g0[1] = __uint_as_float(gw.x & 0xffff0000u); g0[2] = __uint_as_float(gw.y << 16); g0[3] = __uint_as_float(gw.y & 0xffff0000u);
                    g1[0] = __uint_as_float(gw.z << 16); g1[1] = __uint_as_float(gw.z & 0xffff0000u); g1[2] = __uint_as_float(gw.w << 16); g1[3] = __uint_as_float(gw.w & 0xffff0000u);
                    const f32x4 v0 = (acc[ai][bj][m][0] + bv[bj][0]) * g0, v1 = (acc[ai][bj][m][1] + bv[bj][1]) * g1;
                    { const u32x4 pw_ = pack8(v0, v1); ST16_WT(Mb + r * 1024 + 512 + c0 + bj * HALF, pw_); } } }
    }
};
struct EpiOut {
    static constexpr bool PERM = true, AFTER_DRAIN = false;
    bf16_t* mix;
    __device__ __forceinline__ void operator()(const f32x4 (&acc)[2][2][4][2], const Unit& u, int wr, int wc, int fr, int fq) const {
        const int row0 = u.pm * BM + wr * 64 + fr, c0 = u.pn * BM + wc * 32 + 8 * fq;
#pragma unroll
        for (int ai = 0; ai < 2; ++ai)
#pragma unroll
            for (int m = 0; m < 4; ++m) { bf16_t* rowp = mix + (size_t)(row0 + ai * HALF + m * 16) * D_MODEL + c0;
#pragma unroll
                for (int bj = 0; bj < 2; ++bj) *(u32x4*)(rowp + bj * HALF) = pack8(acc[ai][bj][m][0], acc[ai][bj][m][1]); }
    }
};
struct EpiPart {
    static constexpr bool PERM = true, AFTER_DRAIN = false;
    float* part;
    __device__ __forceinline__ void operator()(const f32x4 (&acc)[2][2][4][2], const Unit& u, int wr, int wc, int fr, int fq) const {
        const int row0 = (u.pm - MP / BM) * BM + wr * 64 + fr, c0 = u.pn * BM + wc * 32 + 8 * fq;
#pragma unroll
        for (int ai = 0; ai < 2; ++ai)
#pragma unroll
            for (int m = 0; m < 4; ++m) { const size_t r = (size_t)(row0 + ai * HALF + m * 16);
#pragma unroll
                for (int bj = 0; bj < 2; ++bj)
#pragma unroll
                    for (int n = 0; n < 2; ++n) *(f32x4*)(part + r * D_MODEL + c0 + bj * HALF + 4 * n) = acc[ai][bj][m][n]; }
    }
};
struct SampleOrder {
    int c;
    __device__ __forceinline__ bool next(int i, Unit& u) const { if (i > 0 || c >= 64) return false; u.pm = MP / BM + (c >> 4); u.pn = (c >> 2) & 3; return true; }
    __device__ __forceinline__ void a_ready(const Unit&) const {}
    __device__ __forceinline__ void done(const Unit&) const {}
};
struct TicketOrder {
    int t;
    __device__ __forceinline__ bool next(int i, Unit& u) const { if (i > 0 || t >= (MT / BM) * 2) return false; u.pm = t >> 1; u.pn = t & 1; return true; }
    __device__ __forceinline__ void a_ready(const Unit&) const {}
    __device__ __forceinline__ void done(const Unit&) const {}
};
struct OneUnit {
    int pm, pn;
    __device__ __forceinline__ bool next(int i, Unit& u) const { if (i > 0) return false; u.pm = pm; u.pn = pn; return true; }
    __device__ __forceinline__ void a_ready(const Unit&) const {}
    __device__ __forceinline__ void done(const Unit&) const {}
};
template <class Epi, class Sched, bool ALIGN_EPI = false, bool SP2 = false>
__device__ __forceinline__ void gemm_phase(PG8_LAS unsigned char* lds, const Gemm g, const Sched& S, const Epi& E, const int g_wave) {
    int tid = g_wave * 64 + lane_id(); asm volatile("" : "+v"(tid));
    const int wid = __builtin_amdgcn_readfirstlane(tid >> 6), lane = tid & 63, wr = wid >> 2, wc = wid & 3, fr = lane & 15, fq = lane >> 4;
    const int K = g.K, LD = g.ld, nt = K / BK;
    unsigned voffA[2], voffB[2];
#pragma unroll
    for (int i = 0; i < 2; ++i) { int R, C; stage_rc(tid * 16 + i * 8192, R, C); const int Rb = Epi::PERM ? ((R & ~31) + perm32(R & 31)) : R;
        voffA[i] = (unsigned)(R * LD + C) * 2u; voffB[i] = (unsigned)(Rb * LD + C) * 2u; }
    const size_t kstep = (size_t)(BK * 2);
    const size_t hstep = (size_t)HALF * LD * 2;
    const size_t tstep = 2 * hstep;
    const unsigned ldsw = (unsigned)wid * 1024u;
    const int aoff = lds_byte(wr * 64 + fr, fq * 8), boff = lds_byte(wc * 32 + fr, fq * 8);
#define PG8_SA(b, h) (((b) * 2 + (h)) * HTB)
#define PG8_SB(b, h) ((4 + (b) * 2 + (h)) * HTB)
#define PG8_STAGE(bufoff, gbase, voff) do { _Pragma("unroll") for (int _i = 0; _i < 2; ++_i) \
        __builtin_amdgcn_global_load_lds((const unsigned*)((const char*)(gbase) + (voff)[_i]), (PG8_LAS unsigned*)(lds + (bufoff) + ldsw + _i * 8192), 16, 0, 0); } while (0)
#define PG8_LDA(dst, b, h) do { _Pragma("unroll") for (int m = 0; m < 4; ++m) _Pragma("unroll") for (int k = 0; k < 2; ++k) dst[m][k] = *(const PG8_LAS bf16x8*)(lds + PG8_SA(b, h) + aoff + m * 2048 + k * 1024); } while (0)
#define PG8_LDB(dst, b, h) do { _Pragma("unroll") for (int n = 0; n < 2; ++n) _Pragma("unroll") for (int k = 0; k < 2; ++k) dst[n][k] = *(const PG8_LAS bf16x8*)(lds + PG8_SB(b, h) + boff + n * 2048 + k * 1024); } while (0)
#define PG8_MMA(ai, bj, At, Bt) do { __builtin_amdgcn_s_setprio(1); _Pragma("unroll") for (int m = 0; m < 4; ++m) _Pragma("unroll") for (int n = 0; n < 2; ++n) _Pragma("unroll") for (int k = 0; k < 2; ++k) \
        acc[ai][bj][m][n] = __builtin_amdgcn_mfma_f32_16x16x32_bf16(Bt[n][k], At[m][k], acc[ai][bj][m][n], 0, 0, 0); __builtin_amdgcn_s_setprio(0); } while (0)
#define PG8_WAIT_V(n) asm volatile("s_waitcnt vmcnt(" #n ")" ::: "memory")
#define PG8_WAIT_L(n) asm volatile("s_waitcnt lgkmcnt(" #n ")" ::: "memory")
#define PG8_BAR __builtin_amdgcn_s_barrier()
#define PG8_SCHED __builtin_amdgcn_sched_barrier(0)
    Unit cur, nxt; int ui = 0;
    if (!S.next(0, cur)) return;
    f32x4 acc[2][2][4][2];
#pragma unroll
    for (int a = 0; a < 2; ++a)
#pragma unroll
        for (int b = 0; b < 2; ++b)
#pragma unroll
            for (int m = 0; m < 4; ++m)
#pragma unroll
                for (int n = 0; n < 2; ++n) acc[a][b][m][n] = (f32x4){0.f, 0.f, 0.f, 0.f};
    bf16x8 At[4][2], B0[2][2], B1[2][2];
    const char* cA = (const char*)g.A + (size_t)cur.pm * tstep; const char* cB = (const char*)g.Bt + (size_t)cur.pn * tstep;
    S.a_ready(cur);
    if constexpr (SP2) {
        PG8_STAGE(PG8_SB(0, 0), cB, voffB); PG8_STAGE(PG8_SB(0, 1), cB + hstep, voffB); PG8_STAGE(PG8_SA(0, 0), cA, voffA); PG8_STAGE(PG8_SA(0, 1), cA + hstep, voffA);
        if (wr == 1) PG8_BAR;
        PG8_WAIT_V(2); PG8_BAR;
        PG8_STAGE(PG8_SB(1, 0), cB + kstep, voffB); PG8_STAGE(PG8_SA(1, 0), cA + kstep, voffA); PG8_STAGE(PG8_SB(1, 1), cB + hstep + kstep, voffB);
        PG8_WAIT_V(6); PG8_BAR;
    } else {
        PG8_STAGE(PG8_SB(0, 0), cB, voffB); PG8_STAGE(PG8_SA(0, 0), cA, voffA); PG8_STAGE(PG8_SB(0, 1), cB + hstep, voffB); PG8_STAGE(PG8_SA(0, 1), cA + hstep, voffA);
        if (wr == 1) PG8_BAR;
        PG8_WAIT_V(4); PG8_BAR;
        PG8_STAGE(PG8_SB(1, 0), cB + kstep, voffB); PG8_STAGE(PG8_SA(1, 0), cA + kstep, voffA); PG8_STAGE(PG8_SB(1, 1), cB + hstep + kstep, voffB);
        PG8_WAIT_V(6); PG8_BAR;
    }
    for (;;) {
        const bool has_next = S.next(ui + 1, nxt);
        const char* nA = has_next ? (const char*)g.A + (size_t)nxt.pm * tstep : cA; const char* nB = has_next ? (const char*)g.Bt + (size_t)nxt.pn * tstep : cB;
        for (int t = 0; t < nt; t += 2) {
            const bool last = (t == nt - 2);
            const char* a1 = cA + (size_t)(t + 1) * kstep;
            const char* a2 = last ? nA : cA + (size_t)(t + 2) * kstep; const char* b2 = last ? nB : cB + (size_t)(t + 2) * kstep;
            const char* a3 = a2 + kstep; const char* b3 = b2 + kstep;
            if (last && has_next) S.a_ready(nxt);
            if constexpr (SP2) {
            PG8_LDB(B0, 0, 0); PG8_LDB(B1, 0, 1); PG8_SCHED; PG8_LDA(At, 0, 0); PG8_STAGE(PG8_SA(1, 1), a1 + hstep, voffA);
            PG8_WAIT_V(8); PG8_WAIT_L(0); PG8_BAR; PG8_MMA(0, 0, At, B0); PG8_MMA(0, 1, At, B1); PG8_BAR; PG8_SCHED;
            PG8_LDA(At, 0, 1); PG8_STAGE(PG8_SB(0, 0), b2, voffB); PG8_STAGE(PG8_SB(0, 1), b2 + hstep, voffB); PG8_STAGE(PG8_SA(0, 0), a2, voffA);
            PG8_WAIT_V(8); PG8_WAIT_L(0); PG8_BAR; PG8_MMA(1, 0, At, B0); PG8_MMA(1, 1, At, B1); PG8_BAR; PG8_SCHED;
            PG8_LDB(B0, 1, 0); PG8_LDB(B1, 1, 1); PG8_SCHED; PG8_LDA(At, 1, 0); PG8_STAGE(PG8_SA(0, 1), a2 + hstep, voffA);
            PG8_WAIT_V(8); PG8_WAIT_L(0); PG8_BAR; PG8_MMA(0, 0, At, B0); PG8_MMA(0, 1, At, B1); PG8_BAR; PG8_SCHED;
            PG8_LDA(At, 1, 1); PG8_STAGE(PG8_SB(1, 0), b3, voffB); PG8_STAGE(PG8_SB(1, 1), b3 + hstep, voffB); PG8_STAGE(PG8_SA(1, 0), a3, voffA);
            PG8_WAIT_V(8); PG8_WAIT_L(0); PG8_BAR; PG8_MMA(1, 0, At, B0); PG8_MMA(1, 1, At, B1); PG8_BAR; PG8_SCHED;
            } else {
            PG8_LDB(B0, 0, 0); PG8_SCHED; PG8_LDA(At, 0, 0); PG8_STAGE(PG8_SA(1, 1), a1 + hstep, voffA);
            PG8_WAIT_L(8); PG8_BAR; PG8_WAIT_L(0); PG8_MMA(0, 0, At, B0); PG8_BAR; PG8_SCHED;
            PG8_LDB(B1, 0, 1); PG8_STAGE(PG8_SB(0, 0), b2, voffB);
            PG8_BAR; PG8_WAIT_L(0); PG8_MMA(0, 1, At, B1); PG8_BAR;
            PG8_LDA(At, 0, 1); PG8_STAGE(PG8_SA(0, 0), a2, voffA);
            PG8_BAR; PG8_WAIT_L(0); PG8_MMA(1, 0, At, B0); PG8_BAR; PG8_SCHED;
            PG8_STAGE(PG8_SB(0, 1), b2 + hstep, voffB);
            PG8_WAIT_V(6); PG8_BAR; PG8_MMA(1, 1, At, B1); PG8_BAR;
            PG8_LDB(B0, 1, 0); PG8_SCHED; PG8_LDA(At, 1, 0); PG8_STAGE(PG8_SA(0, 1), a2 + hstep, voffA);
            PG8_WAIT_L(8); PG8_BAR; PG8_WAIT_L(0); PG8_MMA(0, 0, At, B0); PG8_BAR; PG8_SCHED;
            PG8_LDB(B1, 1, 1); PG8_STAGE(PG8_SB(1, 0), b3, voffB);
            PG8_BAR; PG8_WAIT_L(0); PG8_MMA(0, 1, At, B1); PG8_BAR;
            PG8_LDA(At, 1, 1); PG8_STAGE(PG8_SA(1, 0), a3, voffA);
            PG8_BAR; PG8_WAIT_L(0); PG8_MMA(1, 0, At, B0); PG8_BAR; PG8_SCHED;
            PG8_STAGE(PG8_SB(1, 1), b3 + hstep, voffB);
            PG8_WAIT_V(6); PG8_BAR; PG8_MMA(1, 1, At, B1); PG8_BAR;
            }
        }
        if constexpr (ALIGN_EPI) { if (wr == 0) PG8_BAR; }
        if constexpr (!Epi::AFTER_DRAIN) { E(acc, cur, wr, wc, fr, fq); S.done(cur); }
        if (!has_next) break;
#pragma unroll
        for (int a = 0; a < 2; ++a)
#pragma unroll
            for (int b = 0; b < 2; ++b)
#pragma unroll
                for (int m = 0; m < 4; ++m)
#pragma unroll
                    for (int n = 0; n < 2; ++n) acc[a][b][m][n] = (f32x4){0.f, 0.f, 0.f, 0.f};
        cur = nxt; cA = nA; cB = nB; ++ui;
        if constexpr (ALIGN_EPI) { if (wr == 1) PG8_BAR; }
    }
    PG8_WAIT_V(0);
    if constexpr (!ALIGN_EPI) { if (wr == 0) PG8_BAR; }
    PG8_BAR;
    if constexpr (Epi::AFTER_DRAIN) { E.fused(acc, cur, wr, wc, fr, fq, lds, wid, lane); S.done(cur); }
#undef PG8_SA
#undef PG8_SB
#undef PG8_STAGE
#undef PG8_LDA
#undef PG8_LDB
#undef PG8_MMA
#undef PG8_WAIT_V
#undef PG8_WAIT_L
#undef PG8_BAR
#undef PG8_SCHED
}
}
#ifndef PG8_SP2
#define PG8_SP2 true
#endif
#ifndef PG8_ALIGN
#define PG8_ALIGN true
#endif
#include <hip/hip_bf16.h>
#include <cmath>
namespace attn128 {
using bf16=__hip_bfloat16;
using bf16x8=__attribute__((ext_vector_type(8)))short;
using s16x4=__attribute__((ext_vector_type(4)))short;
using f32x16=__attribute__((ext_vector_type(16)))float;
using u32x4=__attribute__((ext_vector_type(4)))unsigned;
constexpr int BATCH=2,NHEAD=8,SEQ=8192,D=64,DV=128,DM=512;
constexpr int NW=8,QBLK=32,QB=QBLK*NW,KVBLK=64,NQB=SEQ/QB;
constexpr int ATTN_PITCH=DM, ATTN_UNIT_ROWS=QB;
__device__ __forceinline__ int crow(int r,int hi){return (r&3)+8*(r>>2)+4*hi;}
#define SBAR() __builtin_amdgcn_sched_barrier(0)
__device__ __forceinline__ void cmask(f32x16&p0,f32x16&p1,int jb,int qrel,int hi){
  const float NEG=-INFINITY; int kb=64*jb+4*hi;
  #pragma unroll
  for(int r=0;r<16;++r){int kv=kb+(r&3)+8*(r>>2); if(kv>qrel)p0[r]=NEG; if(kv+32>qrel)p1[r]=NEG;}
}

constexpr int NSLOT=3, SLOTB=8192;
constexpr int LDS_K=0, LDS_V=NSLOT*SLOTB, LDS_WS=3*NSLOT*SLOTB, LDS_OST=LDS_WS+NW*64*4, LDS_BYTES=LDS_OST+NW*4096;
constexpr float C2=0.125f*1.4426950408889634f;
__device__ __forceinline__ void glds16(const void*gsrc,unsigned lds_dst){unsigned keep;
  asm volatile("s_mov_b32 %0, m0\n\ts_mov_b32 m0, %2\n\ts_nop 0\n\tglobal_load_lds_dwordx4 %1, off\n\ts_mov_b32 m0, %0":"=&s"(keep):"v"(gsrc),"s"(lds_dst):"memory");}
__device__ __forceinline__ float max3f(float a,float b,float c){float r;asm("v_max3_f32 %0, %1, %2, %3":"=v"(r):"v"(a),"v"(b),"v"(c));return r;}
__device__ __forceinline__ float max2f(float a,float b){float r;asm("v_max_f32_e32 %0, %1, %2":"=v"(r):"v"(a),"v"(b));return r;}
__device__ __forceinline__ float fadd_s(float a,float b){float r;asm("v_add_f32_e32 %0, %1, %2":"=v"(r):"v"(a),"v"(b));return r;}
__device__ __forceinline__ float fsub_s(float a,float b){float r;asm("v_sub_f32_e32 %0, %1, %2":"=v"(r):"v"(a),"v"(b));return r;}
typedef float f32x2_t __attribute__((ext_vector_type(2))); typedef __bf16 bf16x2_t __attribute__((ext_vector_type(2)));
__device__ __forceinline__ unsigned cvtpk_s(float lo,float hi){f32x2_t v={lo,hi};bf16x2_t b=__builtin_convertvector(v,bf16x2_t);return __builtin_bit_cast(unsigned,b);}
#define WAIT_BAR(N) asm volatile("s_waitcnt vmcnt(" #N ") lgkmcnt(0)\n\ts_barrier":::"memory")

__device__ __forceinline__ void qkt(f32x16&p0,f32x16&p1,const char*Kslot,const bf16x8*qr,int r32,int hi){
  const char*kb=Kslot+hi*1024+r32*16;
  #pragma unroll
  for(int d0=0;d0<4;++d0){
    const bf16x8 b0=*reinterpret_cast<const bf16x8*>(kb+d0*2048);
    const bf16x8 b1=*reinterpret_cast<const bf16x8*>(kb+d0*2048+512);
    if(d0==0){p0=__builtin_amdgcn_mfma_f32_32x32x16_bf16(b0,qr[0],f32x16{},0,0,0);p1=__builtin_amdgcn_mfma_f32_32x32x16_bf16(b1,qr[0],f32x16{},0,0,0);}
    else{p0=__builtin_amdgcn_mfma_f32_32x32x16_bf16(b0,qr[d0],p0,0,0,0);p1=__builtin_amdgcn_mfma_f32_32x32x16_bf16(b1,qr[d0],p1,0,0,0);}}
}
typedef __attribute__((address_space(3))) const char* lds_cptr;
typedef short v4i16_t __attribute__((ext_vector_type(4)));
__device__ __forceinline__ void kload8(bf16x8*kf,lds_cptr kp){
  kf[0]=*(const __attribute__((address_space(3))) bf16x8*)(kp);      kf[1]=*(const __attribute__((address_space(3))) bf16x8*)(kp+512);
  kf[2]=*(const __attribute__((address_space(3))) bf16x8*)(kp+2048); kf[3]=*(const __attribute__((address_space(3))) bf16x8*)(kp+2560);
  kf[4]=*(const __attribute__((address_space(3))) bf16x8*)(kp+4096); kf[5]=*(const __attribute__((address_space(3))) bf16x8*)(kp+4608);
  kf[6]=*(const __attribute__((address_space(3))) bf16x8*)(kp+6144); kf[7]=*(const __attribute__((address_space(3))) bf16x8*)(kp+6656);
}
__device__ __forceinline__ void kload2(bf16x8*kf,lds_cptr kp,int j){ kf[2*j]=*(const __attribute__((address_space(3))) bf16x8*)(kp+j*2048); kf[2*j+1]=*(const __attribute__((address_space(3))) bf16x8*)(kp+j*2048+512); }
__device__ __forceinline__ s16x4 vtr(lds_cptr p){ return __builtin_bit_cast(s16x4,__builtin_amdgcn_ds_read_tr16_b64_v4i16((__attribute__((address_space(3))) v4i16_t*)p)); }
__device__ __forceinline__ float rowmax(const f32x16&p0,const f32x16&p1){
  float a=max3f(p0[0],p0[1],p1[0]),b=max3f(p0[2],p0[3],p1[1]);a=max3f(a,p1[2],p1[3]);
  #pragma unroll
  for(int r=4;r<16;r+=4){a=max3f(a,p0[r],p0[r+1]);b=max3f(b,p0[r+2],p0[r+3]);a=max3f(a,p1[r],p1[r+1]);b=max3f(b,p1[r+2],p1[r+3]);}
  const float m=max2f(a,b);
  auto rr=__builtin_amdgcn_permlane32_swap(__float_as_uint(m),__float_as_uint(m),false,false);
  return max2f(__uint_as_float(rr[0]),__uint_as_float(rr[1]));
}
__device__ __forceinline__ void pv(f32x16*o,int vb,bf16x8 pa0,bf16x8 pa1,bf16x8 pa2,bf16x8 pa3){
  #pragma unroll
  for(int d0=0;d0<4;++d0){s16x4 lo[4],hi[4];
    #pragma unroll
    for(int ks=0;ks<4;++ks){
      asm volatile("ds_read_b64_tr_b16 %0,%1 offset:%c2":"=&v"(lo[ks]):"v"(vb),"i"(d0*4096+ks*1024):"memory");
      asm volatile("ds_read_b64_tr_b16 %0,%1 offset:%c2":"=&v"(hi[ks]):"v"(vb),"i"(d0*4096+ks*1024+512):"memory");}
    asm volatile("s_waitcnt lgkmcnt(0)":::"memory");SBAR();
    #define PK(k) (bf16x8){lo[k][0],lo[k][1],lo[k][2],lo[k][3],hi[k][0],hi[k][1],hi[k][2],hi[k][3]}
    o[d0]=__builtin_amdgcn_mfma_f32_32x32x16_bf16(pa0,PK(0),o[d0],0,0,0);
    o[d0]=__builtin_amdgcn_mfma_f32_32x32x16_bf16(pa1,PK(1),o[d0],0,0,0);
    o[d0]=__builtin_amdgcn_mfma_f32_32x32x16_bf16(pa2,PK(2),o[d0],0,0,0);
    o[d0]=__builtin_amdgcn_mfma_f32_32x32x16_bf16(pa3,PK(3),o[d0],0,0,0);
    #undef PK
  }
}

#ifndef ATTN_STORE16
#define ATTN_STORE16(p,v) asm volatile("global_store_dwordx4 %0, %1, off sc1\n\ts_nop 1" :: "v"(p), "v"(v) : "memory")
#endif
template<int THRL,bool FAST> __device__ __forceinline__ bool attn_unit(int b,int qcol,int vcol,int qb,const bf16*Q,const bf16*__restrict__ K,const bf16*__restrict__ V,bf16*O,char*shm,const int g_wave){
  const int tid=g_wave*64+lane_id(),lane=tid&63,r32=lane&31,hi=lane>>5; const int wid=__builtin_amdgcn_readfirstlane(tid>>6);
  const long rowbase=(long)b*SEQ; const int q0=qb*QB;
  const bf16*Qw=Q+(rowbase+q0+wid*QBLK)*DM+qcol;
  const bf16*Kh=K+rowbase*DM+qcol,*Vh=V+rowbase*DM+vcol;
  const unsigned lds0=(unsigned)(uintptr_t)shm;
  float*wsf=(float*)(shm+LDS_WS)+wid*64;
  const bf16*ksrc=Kh+(long)lane*DM+wid*8;
  const bf16*vsrc=Vh+(long)(16*(wid&3)+(lane>>2))*DM+(wid>>2)*32+(lane&3)*8;
  const unsigned kdst=lds0+LDS_K+wid*1024, vdst=lds0+LDS_V+wid*1024;
  #define DMA_K(t,slot) glds16(ksrc+(long)(t)*KVBLK*DM,(unsigned)__builtin_amdgcn_readfirstlane(kdst+(slot)))
  #define DMA_V(t,slot) do{ glds16(vsrc+(long)(t)*KVBLK*DM,(unsigned)__builtin_amdgcn_readfirstlane(vdst+2*(slot))); glds16(vsrc+(long)(t)*KVBLK*DM+64,(unsigned)__builtin_amdgcn_readfirstlane(vdst+2*(slot)+8192)); }while(0)
  const int vb0=(int)(lds0+LDS_V)+((lane>>4)&1)*32+(lane&3)*8+(4*hi+((lane&15)>>2))*64;
  const char*Kbase=shm+LDS_K; bf16x8 kf[8];
  const lds_cptr shm3=(lds_cptr)shm; const lds_cptr kp0=shm3+LDS_K+hi*1024+r32*16; const lds_cptr vp0=shm3+LDS_V+((lane>>4)&1)*32+(lane&3)*8+(4*hi+((lane&15)>>2))*64;
  const int NT=(q0+QB)/KVBLK;
  volatile __attribute__((address_space(3))) unsigned*redo=(volatile __attribute__((address_space(3))) unsigned*)((__attribute__((address_space(3))) char*)shm+LDS_BYTES);
  if(FAST&&wid==0&&lane==0)*redo=0u;
  DMA_K(0,0);DMA_V(0,0);DMA_K(1,SLOTB);
  bf16x8 qr[4];
  #pragma unroll
  for(int d0=0;d0<4;++d0)qr[d0]=*reinterpret_cast<const bf16x8*>(&Qw[(long)r32*DM+d0*16+hi*8]);
  float mhat=0.f,l_reg=0.f;f32x16 o[4];o[0]=f32x16{};o[1]=f32x16{};o[2]=f32x16{};o[3]=f32x16{};
  const int qrel=wid*QBLK+r32;
  #define CMASK(P0,P1,t) do{int jb_=(t)-(NT-4); if(jb_>=0)cmask(P0,P1,jb_,qrel,hi);}while(0)
  bool resc=false;
  #define START(P0,P1) do{ resc=false; \
    if constexpr(!FAST){ const float rm=rowmax(P0,P1); const float dl=rm; mhat=fadd_s(mhat,dl); \
      _Pragma("unroll") for(int r=0;r<16;++r){P0[r]=fsub_s(P0[r],dl);P1[r]=fsub_s(P1[r],dl);} \
      } \
    _Pragma("unroll") for(int r=0;r<16;++r)P0[r]=__builtin_amdgcn_exp2f(P0[r]); }while(0)
  #define RESC() do{ if constexpr(!FAST) if(resc){ asm volatile("s_waitcnt lgkmcnt(0)":::"memory"); \
      _Pragma("unroll") for(int d_=0;d_<4;++d_) _Pragma("unroll") for(int r=0;r<16;++r)o[d_][r]*=wsf[crow(r,hi)]; } }while(0)
  f32x16 pA0,pA1,pB0,pB1;
  int sl_prev=0,sl_cur=0,sl_next=SLOTB;
  #define ROT() do{sl_prev=sl_cur;sl_cur=sl_next;sl_next=(sl_next==(NSLOT-1)*SLOTB)?0:sl_next+SLOTB;}while(0)
  DMA_K(2,2*SLOTB);
  WAIT_BAR(4);
  qkt(pA0,pA1,Kbase,qr,r32,hi);asm volatile("s_nop 15\n\ts_nop 7":"+v"(pA0),"+v"(pA1));CMASK(pA0,pA1,0);
  START(pA0,pA1);
  _Pragma("unroll") for(int r=0;r<16;++r)pA1[r]=__builtin_amdgcn_exp2f(pA1[r]);
  WAIT_BAR(0);
  DMA_K(3,0);DMA_V(1,SLOTB);
  ROT();
  kload8(kf,kp0+sl_cur);
  WAIT_BAR(3);
  s16x4 vlo[8],vhi[8]; u32x4 pw0,pw1,pw2,pw3;
  #define PKW(P,B) cvtpk_s(P[B],P[B+1])
  #define PAF(k) __builtin_bit_cast(bf16x8,pw##k)
  #define VFR(i) (bf16x8){vlo[(i)&7][0],vlo[(i)&7][1],vlo[(i)&7][2],vlo[(i)&7][3],vhi[(i)&7][0],vhi[(i)&7][1],vhi[(i)&7][2],vhi[(i)&7][3]}
  #define PIN(x) asm volatile("":"+v"(x))
  #define MX3(a,b,c) __builtin_fmaxf(__builtin_fmaxf((a),(b)),(c))
  #define GAPA(MF,A0,A1,A2,A3,W0,W1,PW) do{ MF; sacc+=A0; sacc+=A1; sacc+=A2; sacc+=A3; PIN(sacc); W0; W1; PIN(PW); SBAR(); }while(0)
  #define EX(v) __builtin_amdgcn_exp2f(v)
  #define GAPB(MF,X,B) do{ MF; if constexpr(FAST){ X[B]=EX(X[B]); X[B+1]=EX(X[B+1]); } else { X[B]=EX(X[B]-mhat); X[B+1]=EX(X[B+1]-mhat); } PIN(X); SBAR(); }while(0)
  #define VRD(i) do{ vlo[(i)&7]=vtr(vp_+(((i)>>2)*4096+((i)&3)*1024)); vhi[(i)&7]=vtr(vp_+(((i)>>2)*4096+((i)&3)*1024+512)); }while(0)
  #define VRDB(i) do{ VRD(i); SBAR(); }while(0)
  #define KRD(G,j) do{ if(G){ kload2(kf,kp0+sl_next,j); SBAR(); } }while(0)
  #define STEP(C0,C1,P0,P1,t,GK,GV,GL) do{ SBAR(); \
    const lds_cptr vp_=vp0+2*sl_prev; \
    VRD(0); SBAR(); float sacc=(P0[0]+P0[1]); \
    GAPA(C0=__builtin_amdgcn_mfma_f32_32x32x16_bf16(kf[0],qr[0],f32x16{},0,0,0), P0[2],P0[3],P0[4],P0[5],     pw0[0]=PKW(P0,0), pw0[1]=PKW(P0,2), pw0); \
    GAPA(C1=__builtin_amdgcn_mfma_f32_32x32x16_bf16(kf[1],qr[0],f32x16{},0,0,0), P0[6],P0[7],P0[8],P0[9],     pw0[2]=PKW(P0,4), pw0[3]=PKW(P0,6), pw0); \
    VRD(1); SBAR(); GAPA(C0=__builtin_amdgcn_mfma_f32_32x32x16_bf16(kf[2],qr[1],C0,0,0,0),   P0[10],P0[11],P0[12],P0[13], pw1[0]=PKW(P0,8), pw1[1]=PKW(P0,10), pw1); \
    GAPA(C1=__builtin_amdgcn_mfma_f32_32x32x16_bf16(kf[3],qr[1],C1,0,0,0),   P0[14],P0[15],P1[0],P1[1],   pw1[2]=PKW(P0,12),pw1[3]=PKW(P0,14), pw1); \
    VRD(2); SBAR(); GAPA(C0=__builtin_amdgcn_mfma_f32_32x32x16_bf16(kf[4],qr[2],C0,0,0,0),   P1[2],P1[3],P1[4],P1[5],     pw2[0]=PKW(P1,0), pw2[1]=PKW(P1,2), pw2); \
    GAPA(C1=__builtin_amdgcn_mfma_f32_32x32x16_bf16(kf[5],qr[2],C1,0,0,0),   P1[6],P1[7],P1[8],P1[9],     pw2[2]=PKW(P1,4), pw2[3]=PKW(P1,6), pw2); \
    VRD(3); SBAR(); GAPA(C0=__builtin_amdgcn_mfma_f32_32x32x16_bf16(kf[6],qr[3],C0,0,0,0),   P1[10],P1[11],P1[12],P1[13], pw3[0]=PKW(P1,8), pw3[1]=PKW(P1,10), pw3); \
    GAPA(C1=__builtin_amdgcn_mfma_f32_32x32x16_bf16(kf[7],qr[3],C1,0,0,0),   P1[14],P1[15],0.f,0.f,       pw3[2]=PKW(P1,12),pw3[3]=PKW(P1,14), pw3); \
    l_reg+=sacc; \
    if(GK){DMA_K((t)+3,sl_cur);} if(GV){DMA_V((t)+1,sl_next);} \
    CMASK(C0,C1,t); \
    if constexpr(!FAST){ float a=MX3(C0[0],C0[1],C1[0]),b=MX3(C0[2],C0[3],C1[1]); a=MX3(a,C1[2],C1[3]); \
      _Pragma("unroll") for(int r=4;r<16;r+=4){a=MX3(a,C0[r],C0[r+1]);b=MX3(b,C0[r+2],C0[r+3]);a=MX3(a,C1[r],C1[r+1]);b=MX3(b,C1[r+2],C1[r+3]);} \
      float rm=__builtin_fmaxf(a,b); { auto rr=__builtin_amdgcn_permlane32_swap(__float_as_uint(rm),__float_as_uint(rm),false,false); rm=__builtin_fmaxf(__uint_as_float(rr[0]),__uint_as_float(rr[1])); } \
      resc=false; const float rel_=rm-mhat;     \
      if(__builtin_expect(__any(rel_>(float)THRL),0)){ const float dl=__builtin_fmaxf(rel_,0.f); mhat+=dl; \
        const float f=__builtin_amdgcn_exp2f(-dl); l_reg*=f; if(hi==0)wsf[r32]=f; resc=true; } } \
    SBAR(); \
      \
    GAPB(o[0]=__builtin_amdgcn_mfma_f32_32x32x16_bf16(PAF(0),VFR(0),o[0],0,0,0), C0,0);   VRDB(4); \
    GAPB(o[0]=__builtin_amdgcn_mfma_f32_32x32x16_bf16(PAF(1),VFR(1),o[0],0,0,0), C0,2);   VRDB(5); \
    GAPB(o[0]=__builtin_amdgcn_mfma_f32_32x32x16_bf16(PAF(2),VFR(2),o[0],0,0,0), C0,4);   VRDB(6); \
    GAPB(o[0]=__builtin_amdgcn_mfma_f32_32x32x16_bf16(PAF(3),VFR(3),o[0],0,0,0), C0,6);   VRDB(7); \
    GAPB(o[1]=__builtin_amdgcn_mfma_f32_32x32x16_bf16(PAF(0),VFR(4),o[1],0,0,0), C0,8);   VRDB(8); \
    GAPB(o[1]=__builtin_amdgcn_mfma_f32_32x32x16_bf16(PAF(1),VFR(5),o[1],0,0,0), C0,10);  VRDB(9); \
    GAPB(o[1]=__builtin_amdgcn_mfma_f32_32x32x16_bf16(PAF(2),VFR(6),o[1],0,0,0), C0,12);  VRDB(10); \
    GAPB(o[1]=__builtin_amdgcn_mfma_f32_32x32x16_bf16(PAF(3),VFR(7),o[1],0,0,0), C0,14);  VRDB(11); \
    GAPB(o[2]=__builtin_amdgcn_mfma_f32_32x32x16_bf16(PAF(0),VFR(8),o[2],0,0,0), C1,0);   VRDB(12); \
    GAPB(o[2]=__builtin_amdgcn_mfma_f32_32x32x16_bf16(PAF(1),VFR(9),o[2],0,0,0), C1,2);   VRDB(13); \
    GAPB(o[2]=__builtin_amdgcn_mfma_f32_32x32x16_bf16(PAF(2),VFR(10),o[2],0,0,0), C1,4);  VRDB(14); \
    GAPB(o[2]=__builtin_amdgcn_mfma_f32_32x32x16_bf16(PAF(3),VFR(11),o[2],0,0,0), C1,6);  VRDB(15); \
    KRD(GL,0); GAPB(o[3]=__builtin_amdgcn_mfma_f32_32x32x16_bf16(PAF(0),VFR(12),o[3],0,0,0), C1,8); \
    KRD(GL,1); GAPB(o[3]=__builtin_amdgcn_mfma_f32_32x32x16_bf16(PAF(1),VFR(13),o[3],0,0,0), C1,10); \
    KRD(GL,2); GAPB(o[3]=__builtin_amdgcn_mfma_f32_32x32x16_bf16(PAF(2),VFR(14),o[3],0,0,0), C1,12); \
    KRD(GL,3); GAPB(o[3]=__builtin_amdgcn_mfma_f32_32x32x16_bf16(PAF(3),VFR(15),o[3],0,0,0), C1,14); \
    }while(0)
  int t=1;
  #undef CMASK
  #define CMASK(P0,P1,t) do{}while(0)
  for(;t+5<NT;t+=2){
    STEP(pB0,pB1,pA0,pA1,t,true,true,true);     WAIT_BAR(3); RESC(); ROT();
    STEP(pA0,pA1,pB0,pB1,t+1,true,true,true);   WAIT_BAR(3); RESC(); ROT();
  }
  #undef CMASK
  #define CMASK(P0,P1,t) do{int jb_=(t)-(NT-4); if(jb_>=0)cmask(P0,P1,jb_,qrel,hi);}while(0)
  #define ENDW(tt) do{ if((tt)+3<NT){WAIT_BAR(3);} else if((tt)+2<NT){WAIT_BAR(2);} else {WAIT_BAR(0);} }while(0)
  for(;t+1<NT;t+=2){
    STEP(pB0,pB1,pA0,pA1,t,(t+3<NT),(t+1<NT),(t+1<NT));       ENDW(t);   RESC(); ROT();
    STEP(pA0,pA1,pB0,pB1,t+1,(t+4<NT),(t+2<NT),(t+2<NT));     ENDW(t+1); RESC(); ROT();
  }
  STEP(pB0,pB1,pA0,pA1,NT-1,false,false,false); RESC();
  { float sacc=pB0[0]+pB0[1]; _Pragma("unroll") for(int r=2;r<16;++r)sacc+=pB0[r]; _Pragma("unroll") for(int r=0;r<16;++r)sacc+=pB1[r]; l_reg+=sacc;
    pw0=(u32x4){PKW(pB0,0),PKW(pB0,2),PKW(pB0,4),PKW(pB0,6)};pw1=(u32x4){PKW(pB0,8),PKW(pB0,10),PKW(pB0,12),PKW(pB0,14)};pw2=(u32x4){PKW(pB1,0),PKW(pB1,2),PKW(pB1,4),PKW(pB1,6)};pw3=(u32x4){PKW(pB1,8),PKW(pB1,10),PKW(pB1,12),PKW(pB1,14)};
    SBAR(); pv(o,vb0+2*sl_cur,PAF(0),PAF(1),PAF(2),PAF(3)); }
  #undef PKW
  #undef PAF
  #undef VFR
  #undef PIN
  #undef MX3
  #undef GAPA
  #undef GAPB
  #undef EX
  #undef VRD
  #undef VRDB
  #undef KRD
  #undef STEP
  #undef ENDW
  {auto rr=__builtin_amdgcn_permlane32_swap(__float_as_uint(l_reg),__float_as_uint(l_reg),false,false);l_reg=__uint_as_float(rr[0])+__uint_as_float(rr[1]);}
  if(FAST){ if(__any(!(l_reg>1e-30f&&l_reg<1e30f))&&lane==0)*redo=1u; }
  if(hi==0)wsf[32+r32]=l_reg;asm volatile("s_waitcnt lgkmcnt(0)":::"memory");
  float rli[16];
  #pragma unroll
  for(int r=0;r<16;++r)rli[r]=__builtin_amdgcn_rcpf(wsf[32+crow(r,hi)]);
  bf16*Ow=O+(rowbase+q0+wid*QBLK)*DM+vcol;
  { bf16*stg=(bf16*)(shm+LDS_OST)+wid*2048;
    #pragma unroll
    for(int ps=0;ps<2;++ps){
      #pragma unroll
      for(int r=0;r<16;++r){const int orow=crow(r,hi);
        #pragma unroll
        for(int d0=0;d0<2;++d0)stg[orow*64+d0*32+r32]=__float2bfloat16(o[2*ps+d0][r]*rli[r]);}
      asm volatile("s_waitcnt lgkmcnt(0)":::"memory");
      #pragma unroll
      for(int i=0;i<4;++i){const int row=i*8+(lane>>3),ch=lane&7; const u32x4 v=*(const u32x4*)(stg+row*64+ch*8); ATTN_STORE16(Ow+(long)row*DM+ps*64+ch*8,v);}
      asm volatile("s_waitcnt lgkmcnt(0)":::"memory"); } }
  asm volatile("s_waitcnt lgkmcnt(0)\n\ts_barrier":::"memory");
  bool again=false;
  if(FAST){ again=(*redo!=0u); asm volatile("s_waitcnt lgkmcnt(0)\n\ts_barrier":::"memory"); }
  #undef DMA_K
  #undef DMA_V
  #undef CMASK
  #undef START
  #undef RESC
  #undef ROT
  return again;
}
constexpr int ATTN_LDS_BYTES=LDS_BYTES;
struct AttnTensors { const bf16* Q; const bf16* K; const bf16* V; bf16* O1; bf16* O2; };
#undef SBAR
#undef WAIT_BAR
}
#define GAS __attribute__((address_space(1)))
#define LAS __attribute__((address_space(3)))
typedef unsigned short bf16;
typedef unsigned v4u __attribute__((ext_vector_type(4)));
typedef float f32x4 __attribute__((ext_vector_type(4)));
typedef short bf16x8 __attribute__((ext_vector_type(8)));
typedef GAS unsigned gu32;
typedef GAS unsigned long long gu64;
#define RLX_AGENT __ATOMIC_RELAXED, __HIP_MEMORY_SCOPE_AGENT
#define LDS_WAIT() asm volatile("s_waitcnt lgkmcnt(0)" ::: "memory")
#define VM_WAIT() asm volatile("s_waitcnt vmcnt(0)" ::: "memory")
__device__ __forceinline__ unsigned long long rt() { return __builtin_amdgcn_s_memrealtime(); }
__device__ __forceinline__ unsigned f2bf(float f) { unsigned u = __builtin_bit_cast(unsigned, f); return (u + 0x7fffu + ((u >> 16) & 1u)) >> 16; }
__device__ __forceinline__ unsigned pk2(float lo, float hi) { return f2bf(lo) | (f2bf(hi) << 16); }
#define XB_TMO      128
#define XB_XCNT(j)  (256  + 64 * (j))
#define XB_XSUB(j)  (1280 + 64 * (j))
#define XB_XGEN(j)  (2304 + 64 * (j))
#define XB_TOP      3328
#define XB_TOPGEN   3392
#define XCD_BAR_WORDS 3456
#define XB_SPIN_CAP (1u << 18)

__device__ __forceinline__ unsigned xb_ld(unsigned* p)              { return __hip_atomic_load(p, __ATOMIC_RELAXED, __HIP_MEMORY_SCOPE_AGENT); }
__device__ __forceinline__ unsigned xb_add(unsigned* p, unsigned v) { return __hip_atomic_fetch_add(p, v, __ATOMIC_RELAXED, __HIP_MEMORY_SCOPE_AGENT); }
__device__ __forceinline__ unsigned xb_xcc_id() { return (unsigned)__builtin_amdgcn_s_getreg((3 << 11) | 20) & 0xFu; }
#define XB_SPIN(cond, bar) do { unsigned _sp = 0; while (cond) { __builtin_amdgcn_s_sleep(1); \
    if ((++_sp & 255u) == 0u) { if (xb_ld(&(bar)[XB_TMO])) break; if (_sp > XB_SPIN_CAP) { atomicAdd(&(bar)[XB_TMO], 1u); break; } } } } while (0)

struct XcdBarrier {
    unsigned* bar; unsigned x; int wave;
    volatile LAS unsigned* st;
};

__device__ __forceinline__ XcdBarrier xcd_barrier_post(unsigned* bar, volatile LAS unsigned* st, const int g_wave) {
    XcdBarrier b; b.bar = bar; b.x = xb_xcc_id(); b.st = st; b.wave = g_wave;
    if (g_wave == 0 && lane_id() == 0) (void)xb_add(&bar[XB_XCNT(b.x)], 1u);
    return b;
}
__device__ __forceinline__ void xcd_barrier_complete(unsigned* bar, unsigned x, unsigned& nloc, unsigned& nx) {
    const unsigned G = gridDim.x * gridDim.y * gridDim.z;
    unsigned sum, cnt, mine, sp = 0u;
    for (;;) {
        sum = 0u; cnt = 0u; mine = 0u;
#pragma unroll
        for (unsigned j = 0; j < 16; ++j) { const unsigned c = xb_ld(&bar[XB_XCNT(j)]); sum += c; cnt += (c > 0u) ? 1u : 0u; mine = (j == x) ? c : mine; }
        if (sum == G) break;
        __builtin_amdgcn_s_sleep(1);
        if ((++sp & 255u) == 0u) { if (xb_ld(&bar[XB_TMO])) break; if (sp > XB_SPIN_CAP) { atomicAdd(&bar[XB_TMO], 1u); break; } }
    }
    nloc = mine > 0u ? mine : 1u; nx = cnt > 0u ? cnt : 1u;
}

__device__ __forceinline__ void xcd_barrier(const XcdBarrier& b) {
    asm volatile("s_waitcnt vmcnt(0)" ::: "memory");
    __syncthreads();
    if (b.wave == 0 && lane_id() == 0) {
        unsigned* bar = b.bar;
        __builtin_amdgcn_s_waitcnt(0);
        unsigned nloc = b.st[0], nx = b.st[1];
        if (nloc == 0u) { xcd_barrier_complete(bar, b.x, nloc, nx); b.st[0] = nloc; b.st[1] = nx; }
        const unsigned old = xb_add(&bar[XB_XSUB(b.x)], 1u);
        const unsigned gen = old / nloc;
        if (old + 1u == (gen + 1u) * nloc) {
            __builtin_amdgcn_fence(__ATOMIC_RELEASE, "agent");
            asm volatile("s_waitcnt vmcnt(0)" ::: "memory");
            const unsigned og = xb_add(&bar[XB_TOP], 1u);
            const unsigned tg = og / nx;
            if (og + 1u == (tg + 1u) * nx) xb_add(&bar[XB_TOPGEN], 1u);
            else XB_SPIN(xb_ld(&bar[XB_TOPGEN]) == tg, bar);
            __builtin_amdgcn_fence(__ATOMIC_ACQUIRE, "agent");
            xb_add(&bar[XB_XGEN(b.x)], 1u);
            asm volatile("s_waitcnt vmcnt(0)" ::: "memory");
        } else {
            XB_SPIN(xb_ld(&bar[XB_XGEN(b.x)]) == gen, bar);
            __builtin_amdgcn_fence(__ATOMIC_ACQUIRE, "agent");
            asm volatile("s_waitcnt vmcnt(0)" ::: "memory");
        }
    }
    __syncthreads();
}
__device__ __forceinline__ void xcd_arrive(unsigned* ctl, const int wstage, const int wtotal, const unsigned x, const unsigned nloc) {
    const unsigned old = xb_add(ctl + wstage + 64 * x, 1u);
    if (old + 1u == nloc) { __builtin_amdgcn_fence(__ATOMIC_RELEASE, "agent"); asm volatile("s_waitcnt vmcnt(0)" ::: "memory"); (void)xb_add(ctl + wtotal, nloc); }
}
constexpr size_t MiB = 1u << 20;
constexpr size_t WS_CTL = 0, CTL_ZERO_BYTES = 64 * 1024;
constexpr size_t WS_WIN = 2 * MiB;
constexpr size_t WS_WPW = 10 * MiB;
constexpr size_t WS_WOUT = 11 * MiB;
constexpr size_t WS_XN = 16 * MiB;
constexpr size_t WS_Q = 52 * MiB, WS_K = 70 * MiB, WS_V = 88 * MiB, WS_GA = 106 * MiB, WS_GC = 124 * MiB;
constexpr size_t WS_U = 142 * MiB;
constexpr size_t WS_C = 186 * MiB;
constexpr size_t WS_O1 = 204 * MiB, WS_O2 = 220 * MiB;
constexpr size_t WS_M = 236 * MiB;
constexpr size_t WS_PART = 272 * MiB;
constexpr size_t WS_MIX = 288 * MiB;
constexpr size_t WS_END = 320 * MiB;
static_assert(WS_XN + (size_t)MT * 1024 * 2 <= WS_Q && WS_Q + (size_t)MT * 512 * 2 <= WS_K && WS_U + (size_t)U_ROWS * 512 * 4 <= WS_C && WS_C + (size_t)MT * 512 * 2 <= WS_O1 && WS_M + (size_t)MT * 1024 * 2 <= WS_END, "d_ws map");
constexpr int CW_XCONV = 8192 + 64 * 8, CW_XATTN = 8192 + 64 * 24;
constexpr int CW_CONV = 8192 + 64 * 4, CW_ATTN = 8192 + 64 * 5, CW_TICKET = 8192 + 64 * 6;
constexpr int CW_PCNT = 6656, CW_PQ = 0, CW_PTAIL = 8192 + 64 * 62, CW_PHEAD = 8192 + 64 * 63;
constexpr int CW_PAIR = 12288;
constexpr int CW_QUEUE = 4608, CW_QTAIL = 8192 + 64 * 60, CW_QHEAD = 8192 + 64 * 61;
constexpr int CW_SROW = 8192;
constexpr int CW_BAR = 1024;
__device__ __forceinline__ void panel_post(unsigned* ctl, const int pm) {
    if (xb_add(ctl + CW_PCNT + 16 * pm, 1u) == 5u) { const unsigned j = xb_add(ctl + CW_PTAIL, 4u);
#pragma unroll
        for (unsigned pn = 0; pn < 4; ++pn) __hip_atomic_store(ctl + CW_PQ + 4 * ((j + pn) & 255u), (unsigned)pm * 4u + pn + 1u, RLX_AGENT); }
}
constexpr int NWAVES = 8;
constexpr int RING_OFF = 0, RING_BYTES = 131072;
constexpr int LDSCTL_OFF = RING_BYTES, MISC_OFF = LDSCTL_OFF + 320;
constexpr int LDS_BYTES = 147456;

struct Frame {
    LAS unsigned char* lds;
    volatile LAS unsigned* MISC;
    gu32* ctl;
    int wave;
    int vcu, G;
};
struct Args { const float* in[21]; float* out; unsigned char* ws; };
#define WSP(T, off) ((T*)(A.ws + (off)))
template <int CTRL> __device__ __forceinline__ float dppf(float x) { return __builtin_bit_cast(float, __builtin_amdgcn_mov_dpp(__builtin_bit_cast(int, x), CTRL, 0xf, 0xf, true)); }
__device__ __forceinline__ float xrow_sum(float x) {
    auto a = __builtin_amdgcn_permlane16_swap(__float_as_uint(x), __float_as_uint(x), false, false); x = __uint_as_float(a[0]) + __uint_as_float(a[1]);
    auto b = __builtin_amdgcn_permlane32_swap(__float_as_uint(x), __float_as_uint(x), false, false); return __uint_as_float(b[0]) + __uint_as_float(b[1]); }
__device__ __forceinline__ float xrow_max(float x) {
    auto a = __builtin_amdgcn_permlane16_swap(__float_as_uint(x), __float_as_uint(x), false, false); x = fmaxf(__uint_as_float(a[0]), __uint_as_float(a[1]));
    auto b = __builtin_amdgcn_permlane32_swap(__float_as_uint(x), __float_as_uint(x), false, false); return fmaxf(__uint_as_float(b[0]), __uint_as_float(b[1])); }
__device__ __forceinline__ float row16_sum(float v) {
    v += dppf<0xB1>(v); v += dppf<0x4E>(v); v += dppf<0x141>(v); v += dppf<0x140>(v); return v; }
__device__ __forceinline__ float wave_sum(float v) { return xrow_sum(row16_sum(v)); }
__device__ __forceinline__ void p0_transpose_item(const float* W, int K, int N, bf16* WT, int k0, int n0, int dst0, LAS float* scr, int lane) {
#pragma unroll 8
    for (int i = 0; i < 32; ++i) { const int kk = 2 * i + (lane >> 5); scr[kk * 33 + (lane & 31)] = W[(size_t)(k0 + kk) * N + n0 + (lane & 31)]; }
    LDS_WAIT(); asm volatile("" ::: "memory");
    const int c = lane & 7;
#pragma unroll
    for (int j = 0; j < 4; ++j) { const int n = (lane >> 3) + 8 * j; const LAS float* s = scr + (8 * c) * 33 + n;
        v4u o; o.x = pk2(s[0 * 33], s[1 * 33]); o.y = pk2(s[2 * 33], s[3 * 33]); o.z = pk2(s[4 * 33], s[5 * 33]); o.w = pk2(s[6 * 33], s[7 * 33]);
        *(GAS v4u*)(WT + (size_t)(dst0 + n) * K + k0 + 8 * c) = o; }
    LDS_WAIT(); asm volatile("" ::: "memory");
}
__device__ __forceinline__ int win_dst_row(int n0) {
    if (n0 < 2048 || n0 >= 3072) return n0;
    int j = n0 - 2048; const int isb = j >= 512; if (isb) j -= 512;
    return 2048 + 256 * (j >> 7) + 128 * isb + (j & 127);
}
__device__ __forceinline__ void rms_row_to_bf16(const float* xrow, const f32x4 (&gv)[4], bf16* orow, int lane) {
    const GAS f32x4* xr = (const GAS f32x4*)xrow + lane;
    f32x4 v[4]; float s = 0.f;
#pragma unroll
    for (int j = 0; j < 4; ++j) { v[j] = xr[64 * j]; s += (v[j].x * v[j].x + v[j].y * v[j].y) + (v[j].z * v[j].z + v[j].w * v[j].w); }
    const float rs = 1.0f / sqrtf(wave_sum(s) * (1.f / D_MODEL) + EPS);
    GAS unsigned long long* o8 = (GAS unsigned long long*)orow + lane;
#pragma unroll
    for (int j = 0; j < 4; ++j) o8[64 * j] = (unsigned long long)pk2(v[j].x * rs * gv[j].x, v[j].y * rs * gv[j].y) | ((unsigned long long)pk2(v[j].z * rs * gv[j].z, v[j].w * rs * gv[j].w) << 32);
}
__device__ __forceinline__ void p0_prologue(Frame& F, const Args& A) {
    const float *w_in = A.in[7], *w_pw2 = A.in[17], *w_out = A.in[19], *xp = A.in[0], *xs = A.in[1]; bf16 *Win_t = WSP(bf16, WS_WIN), *Wpw_t = WSP(bf16, WS_WPW), *Wout_t = WSP(bf16, WS_WOUT), *XN = WSP(bf16, WS_XN);
    LAS float* scr = (LAS float*)(F.lds + RING_OFF + F.wave * 16384);
    const int gw = F.vcu * NWAVES + F.wave, NGW = F.G * NWAVES;
    constexpr int I_IN = (1024 / 64) * (D_IN / 32), I_PW = (512 / 64) * (512 / 32), I_OUT = (1024 / 64) * (1024 / 32);
    f32x4 gv[4];
#pragma unroll
    for (int j = 0; j < 4; ++j) gv[j] = *((const f32x4*)A.in[6] + lane_id() + 64 * j);
#pragma nounroll
    for (int ph = 0; ph < 2; ++ph) {
    if (((F.wave & 1) != 0) == (ph != 0)) {
    for (int it = gw; it < I_IN; it += NGW) {
        int r = it;
        if (r < I_IN) { const int nblk = D_IN / 32, kb = r / nblk, nb = r % nblk; p0_transpose_item(w_in, 1024, D_IN, Win_t, 64 * kb, 32 * nb, win_dst_row(32 * nb), scr, lane_id()); continue; } r -= I_IN;
        if (r < I_PW) { const int kb = r / 16, nb = r % 16; p0_transpose_item(w_pw2, 512, 512, Wpw_t, 64 * kb, 32 * nb, 32 * nb, scr, lane_id()); continue; } r -= I_PW;
        { const int kb = r / 32, nb = r % 32; p0_transpose_item(w_out, 1024, 1024, Wout_t, 64 * kb, 32 * nb, 32 * nb, scr, lane_id()); }
    }
    } else
    { const int lane = lane_id();
      for (int grp = NGW - 1 - gw; grp < MT / 4; grp += NGW) {
          const int m0 = 4 * grp; const float* xb = m0 < MP ? xp + (size_t)m0 * D_MODEL : xs + (size_t)(m0 - MP) * D_MODEL;
          f32x4 v[4][4];
#pragma unroll
          for (int r = 0; r < 4; ++r)
#pragma unroll
              for (int j = 0; j < 4; ++j) v[r][j] = *((const GAS f32x4*)(xb + (size_t)r * D_MODEL) + lane + 64 * j);
#pragma unroll
          for (int r = 0; r < 4; ++r) { float ss = 0.f;
#pragma unroll
              for (int j = 0; j < 4; ++j) ss += (v[r][j].x * v[r][j].x + v[r][j].y * v[r][j].y) + (v[r][j].z * v[r][j].z + v[r][j].w * v[r][j].w);
              const float rs = 1.0f / sqrtf(wave_sum(ss) * (1.f / D_MODEL) + EPS);
              GAS unsigned long long* o8 = (GAS unsigned long long*)(XN + (size_t)(m0 + r) * D_MODEL) + lane;
#pragma unroll
              for (int j = 0; j < 4; ++j) o8[64 * j] = (unsigned long long)pk2(v[r][j].x * rs * gv[j].x, v[r][j].y * rs * gv[j].y) | ((unsigned long long)pk2(v[r][j].z * rs * gv[j].z, v[r][j].w * rs * gv[j].w) << 32); } } }
    }
}
__device__ __forceinline__ void p1_idle_transposes(Frame& F, const Args& A) {
    const int nwg = (MT / 256) * (D_IN / 256), G = (int)F.G, nidle = (4 * G > nwg && 3 * G < nwg) ? 4 * G - nwg : 0, first = nidle ? G - nidle : 0;
    if ((int)blockIdx.x < first) return;
    const float *w_pw2 = A.in[17], *w_out = A.in[19]; bf16 *Wpw_t = WSP(bf16, WS_WPW), *Wout_t = WSP(bf16, WS_WOUT);
    LAS float* scr = (LAS float*)(F.lds + RING_OFF + F.wave * 16384);
    constexpr int I_PW = (512 / 64) * (512 / 32), I_OUT = (1024 / 64) * (1024 / 32);
    for (int r = ((int)blockIdx.x - first) * NWAVES + F.wave; r < I_PW + I_OUT; r += (G - first) * NWAVES) {
        if (r < I_PW) { const int kb = r / 16, nb = r % 16; p0_transpose_item(w_pw2, 512, 512, Wpw_t, 64 * kb, 32 * nb, 32 * nb, scr, lane_id()); }
        else { const int q = r - I_PW, kb = q / 32, nb = q % 32; p0_transpose_item(w_out, 1024, 1024, Wout_t, 64 * kb, 32 * nb, 32 * nb, scr, lane_id()); }
    }
    { bf16* U = WSP(bf16, WS_U); const float* state = A.in[4];
      for (int r = ((int)blockIdx.x - first) * NWAVES + F.wave; r < NBATCH * HIST + DEC_B * HIST; r += (G - first) * NWAVES) { f32x4 v0 = {0.f, 0.f, 0.f, 0.f}, v1 = v0; size_t dst;
          if (r < NBATCH * HIST) dst = (size_t)((r / HIST) * UP_SEQ + r % HIST) * 512;
          else { const int q = r - NBATCH * HIST, b = q / HIST, i = q % HIST; dst = (size_t)(USMP0 + b * US_SEQ + i) * 512; v0 = *(const f32x4*)(state + (size_t)q * 512 + 8 * lane_id()); v1 = *(const f32x4*)(state + (size_t)q * 512 + 8 * lane_id() + 4); }
          v4u w; w.x = pk2(v0[0], v0[1]); w.y = pk2(v0[2], v0[3]); w.z = pk2(v1[0], v1[1]); w.w = pk2(v1[2], v1[3]);
          *(v4u*)(U + dst + 8 * lane_id()) = w; } }
    { const float* state = A.in[4]; float* out = A.out; constexpr int RQ = (HIST - DEC_S) * 128;
      for (int i = ((int)blockIdx.x - first) * NWAVES * 64 + F.wave * 64 + lane_id(); i < DEC_B * RQ; i += (G - first) * NWAVES * 64) { const int b = i / RQ, rem = i - b * RQ;
          *((f32x4*)(out + OFF_CS + (size_t)b * HIST * 512) + rem) = *((const f32x4*)(state + (size_t)(b * HIST + DEC_S) * 512) + rem); } }
}
__device__ __forceinline__ float compute_lam(Frame& F, const Args& A) {
    const float a = wave_sum(A.in[8][lane_id()] * A.in[9][lane_id()]), b = wave_sum(A.in[10][lane_id()] * A.in[11][lane_id()]);
    return __builtin_bit_cast(float, __builtin_amdgcn_readfirstlane(__builtin_bit_cast(int, expf(a) - expf(b) + 0.2f)));
}
__device__ __forceinline__ void conv_phase(Frame& F, const Args& A) {
    int tid_ = F.wave * 64 + lane_id(); asm volatile("" : "+v"(tid_)); const int lane = tid_ & 63, wave = __builtin_amdgcn_readfirstlane(tid_ >> 6);
    const bf16* U = WSP(bf16, WS_U); float* out = A.out; bf16* Cb = WSP(bf16, WS_C);
    LAS float* wl = (LAS float*)(F.lds + RING_OFF);
    for (int i = tid_; i < CONV_W * 512; i += NWAVES * 64) wl[i] = A.in[13][i];
    __syncthreads();
    const int gw = F.vcu * NWAVES + wave, NGW = F.G * NWAVES;
    for (int k = 0; k < 3; ++k) {
        const int task = k < 2 ? gw + k * NGW : (wave == 0 ? MP / 4 + F.vcu : MP / 4 + 2 * DEC_B);
        if (task >= (k < 2 ? MP / 4 : MP / 4 + 2 * DEC_B)) continue;
        int rowbase, urow0;
        if (task < MP / 4) { const int b = task >> 11, t0 = (task & 2047) * 4; rowbase = b * SEQ + t0; urow0 = b * UP_SEQ + t0; }
        else { const int q = task - MP / 4, b = q >> 1, hf = q & 1; rowbase = MP + b * 8 + 4 * hf; urow0 = USMP0 + b * US_SEQ + 4 * hf; }
        const bf16* up = U + (size_t)urow0 * 512; const int lo = 8 * lane;
        f32x4 acc[4][2];
        { const f32x4 c0 = *(const f32x4*)(A.in[14] + 8 * lane), c1 = *(const f32x4*)(A.in[14] + 8 * lane + 4);
#pragma unroll
            for (int r = 0; r < 4; ++r) { acc[r][0] = c0; acc[r][1] = c1; } }
        f32x4 W[4][2]; v4u ubuf[4][4];
#define CONV_NS 34
#define CONV_LOAD(dst, s_) do { if ((s_) < CONV_NS) { const bf16* src_ = up + (size_t)(s_) * 512;   (dst) = *(const v4u*)(src_ + lo); } } while (0)
#define CONV_FMA(s_, r_, uu) do { if ((s_) - (r_) >= 0 && (s_) - (r_) < CONV_W) { acc[r_][0] += W[((s_) - (r_)) & 3][0] * (uu)[0]; acc[r_][1] += W[((s_) - (r_)) & 3][1] * (uu)[1]; } } while (0)
#define CONV_STEP(s_, uw) do { if ((s_) < CONV_NS) { f32x4 uu[2]; uu[0][0] = __uint_as_float((uw).x << 16); uu[0][1] = __uint_as_float((uw).x & 0xffff0000u); uu[0][2] = __uint_as_float((uw).y << 16); uu[0][3] = __uint_as_float((uw).y & 0xffff0000u); \
        uu[1][0] = __uint_as_float((uw).z << 16); uu[1][1] = __uint_as_float((uw).z & 0xffff0000u); uu[1][2] = __uint_as_float((uw).w << 16); uu[1][3] = __uint_as_float((uw).w & 0xffff0000u); if ((s_) < CONV_W) { W[(s_) & 3][0] = *(const LAS f32x4*)(wl + (s_) * 512 + 8 * lane); W[(s_) & 3][1] = *(const LAS f32x4*)(wl + (s_) * 512 + 8 * lane + 4); } \
        CONV_FMA(s_, 0, uu); CONV_FMA(s_, 1, uu); CONV_FMA(s_, 2, uu); CONV_FMA(s_, 3, uu); } } while (0)
#define CONV_GROUP(gq) do { CONV_LOAD(ubuf[((gq) + 3) & 3][0], 4 * (gq) + 12); CONV_LOAD(ubuf[((gq) + 3) & 3][1], 4 * (gq) + 13); CONV_LOAD(ubuf[((gq) + 3) & 3][2], 4 * (gq) + 14); CONV_LOAD(ubuf[((gq) + 3) & 3][3], 4 * (gq) + 15); \
        CONV_STEP(4 * (gq), ubuf[(gq) & 3][0]); CONV_STEP(4 * (gq) + 1, ubuf[(gq) & 3][1]); CONV_STEP(4 * (gq) + 2, ubuf[(gq) & 3][2]); CONV_STEP(4 * (gq) + 3, ubuf[(gq) & 3][3]); asm volatile("" ::: "memory"); } while (0)
        CONV_LOAD(ubuf[0][0], 0); CONV_LOAD(ubuf[0][1], 1); CONV_LOAD(ubuf[0][2], 2); CONV_LOAD(ubuf[0][3], 3); CONV_LOAD(ubuf[1][0], 4); CONV_LOAD(ubuf[1][1], 5); CONV_LOAD(ubuf[1][2], 6); CONV_LOAD(ubuf[1][3], 7);
        CONV_LOAD(ubuf[2][0], 8); CONV_LOAD(ubuf[2][1], 9); CONV_LOAD(ubuf[2][2], 10); CONV_LOAD(ubuf[2][3], 11);
        CONV_GROUP(0); CONV_GROUP(1); CONV_GROUP(2); CONV_GROUP(3); CONV_GROUP(4); CONV_GROUP(5); CONV_GROUP(6); CONV_GROUP(7); CONV_GROUP(8);
#undef CONV_LOAD
#undef CONV_FMA
#undef CONV_STEP
#undef CONV_GROUP
        const f32x4 lg0 = *(const f32x4*)(A.in[15] + 8 * lane), lg1 = *(const f32x4*)(A.in[15] + 8 * lane + 4), lb0 = *(const f32x4*)(A.in[16] + 8 * lane), lb1 = *(const f32x4*)(A.in[16] + 8 * lane + 4);
#pragma unroll
        for (int r = 0; r < 4; ++r) {
            const f32x4 a0 = acc[r][0], a1 = acc[r][1];
            const float s1 = wave_sum(((a0[0] + a0[1]) + (a0[2] + a0[3])) + ((a1[0] + a1[1]) + (a1[2] + a1[3])));
            const float s2 = wave_sum(((a0[0] * a0[0] + a0[1] * a0[1]) + (a0[2] * a0[2] + a0[3] * a0[3])) + ((a1[0] * a1[0] + a1[1] * a1[1]) + (a1[2] * a1[2] + a1[3] * a1[3])));
            const float mean = s1 * (1.f / 512.f), var = fmaxf(s2 * (1.f / 512.f) - mean * mean, 0.f), rstd = 1.0f / sqrtf(var + EPS);
            f32x4 y0 = (a0 - mean) * rstd * lg0 + lb0, y1 = (a1 - mean) * rstd * lg1 + lb1;
#pragma unroll
            for (int i = 0; i < 4; ++i) { y0[i] = pg8::silu_f(y0[i]); y1[i] = pg8::silu_f(y1[i]); }
            *(pg8::u32x4*)(Cb + (size_t)(rowbase + r) * 512 + 8 * lane) = pg8::pack8(y0, y1);
        }
    }
}
typedef float f32x4v __attribute__((ext_vector_type(4))); typedef float f32x2w __attribute__((ext_vector_type(2)));
constexpr float DEC_THR = 8.0f;
__device__ __forceinline__ void decode_items(Frame& F, const Args& A, const int item_first, const int item_end) {
    const GAS float *ck = (const GAS float*)A.in[2], *cv = (const GAS float*)A.in[3], *subln = (const GAS float*)A.in[12]; const GAS int* pt = (const GAS int*)A.in[5]; const GAS float* outf = (const GAS float*)A.out; GAS unsigned char* wsb = (GAS unsigned char*)A.ws;
    asm volatile("" : "+s"(ck), "+s"(cv), "+s"(subln), "+s"(pt), "+s"(outf), "+s"(wsb));
    const GAS bf16 *Qb = (const GAS bf16*)(wsb + WS_Q), *GAb = (const GAS bf16*)(wsb + WS_GA); GAS bf16* Mb = (GAS bf16*)(wsb + WS_M);
    int tid_ = F.wave * 64 + lane_id(); asm volatile("" : "+v"(tid_)); const int lane = tid_ & 63, wave = __builtin_amdgcn_readfirstlane(tid_ >> 6), c16 = lane & 15, g = lane >> 4;
    LAS float* Om = (LAS float*)(F.lds + RING_OFF);
    LAS float* ML = (LAS float*)(F.lds + RING_OFF + 65536);
    for (int item = item_first; item < item_end; item += F.G) {
        const int b = item >> 2, h = item & 3;
        bf16x8 qf[4];
        { const int qi = c16 & 7, mp = c16 >> 3; const GAS bf16* qrow = Qb + (size_t)(MP + b * DEC_S + qi) * 512 + h * 128 + mp * 64 + 4 * g;
            typedef unsigned u32x2 __attribute__((ext_vector_type(2)));
            const u32x2 a0 = *(const GAS u32x2*)(qrow), a1 = *(const GAS u32x2*)(qrow + 16), b0 = *(const GAS u32x2*)(qrow + 32), b1 = *(const GAS u32x2*)(qrow + 48);
            const v4u fa = {a0.x, a0.y, a1.x, a1.y}, fb = {b0.x, b0.y, b1.x, b1.y}, z = {0u, 0u, 0u, 0u};
            qf[0] = __builtin_bit_cast(bf16x8, mp ? z : fa); qf[1] = __builtin_bit_cast(bf16x8, mp ? z : fb);
            qf[2] = __builtin_bit_cast(bf16x8, mp ? fa : z); qf[3] = __builtin_bit_cast(bf16x8, mp ? fb : z); }
        LAS bf16x8* qlds = (LAS bf16x8*)(F.lds + RING_OFF + 73728 + wave * 4096) + lane;
#pragma unroll
        for (int kk = 0; kk < 4; ++kk) qlds[64 * kk] = qf[kk];
        const int ph0 = __builtin_amdgcn_readfirstlane(pt[b * NPAGES + 2 * wave]), ph1 = __builtin_amdgcn_readfirstlane(pt[b * NPAGES + 2 * wave + 1]);
        f32x4v acc[2][4];
#pragma unroll
        for (int jj = 0; jj < 2; ++jj)
#pragma unroll
            for (int rr = 0; rr < 4; ++rr) acc[jj][rr] = (f32x4v){0.f, 0.f, 0.f, 0.f};
        float mref = -INFINITY, lsum = 0.f;
        const int kperm = 4 * (4 * c16 + g);
        f32x4v KA[8], VA[8], KB[8], VB[8];
#define DEC_ISSUE_K(KX, tt_) do { const int pg_ = (tt_) < 8 ? ph0 : ph1; const size_t tb_ = ((size_t)pg_ * 128 + ((tt_) & 7) * 16) * 512 + h * 128; \
        const GAS float* kp_ = ck + tb_ + (size_t)(lane >> 2) * 512 + 4 * (lane & 3); \
        _Pragma("unroll") for (int j_ = 0; j_ < 8; ++j_) KX[j_] = (*(const GAS f32x4v*)(kp_ + 16 * j_)); } while (0)
#define DEC_ISSUE_V(VX, tt_) do { const int pg_ = (tt_) < 8 ? ph0 : ph1; const size_t tb_ = ((size_t)pg_ * 128 + ((tt_) & 7) * 16) * 512 + h * 128; \
        const GAS float* vp_ = cv + tb_ + (size_t)(4 * g) * 512 + 4 * c16; \
        _Pragma("unroll") for (int r_ = 0; r_ < 4; ++r_) { VX[2 * r_] = (*(const GAS f32x4v*)(vp_ + r_ * 512)); VX[2 * r_ + 1] = (*(const GAS f32x4v*)(vp_ + r_ * 512 + 64)); } } while (0)
#define DEC_TILE(KX, VX, MASKED, NEXT_OK, tn_) do { \
        bf16x8 ka_[4]; \
        _Pragma("unroll") for (int kk_ = 0; kk_ < 4; ++kk_) { const v4u w_ = {attn128::cvtpk_s(KX[2 * kk_][0], KX[2 * kk_][1]), attn128::cvtpk_s(KX[2 * kk_][2], KX[2 * kk_][3]), attn128::cvtpk_s(KX[2 * kk_ + 1][0], KX[2 * kk_ + 1][1]), attn128::cvtpk_s(KX[2 * kk_ + 1][2], KX[2 * kk_ + 1][3])}; v4u x_; _Pragma("unroll") for (int e_ = 0; e_ < 4; ++e_) x_[e_] = (unsigned)__builtin_amdgcn_ds_bpermute(kperm, (int)w_[e_]); ka_[kk_] = __builtin_bit_cast(bf16x8, x_); } \
        if (NEXT_OK) DEC_ISSUE_K(KX, tn_); \
        f32x4v s_ = {0.f, 0.f, 0.f, 0.f}; \
        _Pragma("unroll") for (int kk_ = 0; kk_ < 4; ++kk_) s_ = __builtin_amdgcn_mfma_f32_16x16x32_bf16(ka_[kk_], qlds[64 * kk_], s_, 0, 0, 0); \
        if (MASKED) { const int qi_ = c16 & 7; _Pragma("unroll") for (int r_ = 0; r_ < 4; ++r_) if (4 * g + r_ > qi_) s_[r_] = -INFINITY; } \
        float tm_ = fmaxf(fmaxf(s_[0], s_[1]), fmaxf(s_[2], s_[3])); tm_ = xrow_max(tm_); \
        if (__any(tm_ > mref + DEC_THR)) { const float mn_ = fmaxf(mref, tm_), al_ = __builtin_amdgcn_exp2f(mref - mn_); mref = mn_; lsum *= al_; \
            _Pragma("unroll") for (int jj_ = 0; jj_ < 2; ++jj_) _Pragma("unroll") for (int rr_ = 0; rr_ < 4; ++rr_) acc[jj_][rr_] *= al_; } \
        float p_[4]; \
        _Pragma("unroll") for (int r_ = 0; r_ < 4; ++r_) { p_[r_] = __builtin_amdgcn_exp2f(s_[r_] - mref); lsum += p_[r_]; } \
        const v4u pb_ = {attn128::cvtpk_s(p_[0], p_[1]), attn128::cvtpk_s(p_[2], p_[3]), 0u, 0u}; \
        _Pragma("unroll") for (int jj_ = 0; jj_ < 2; ++jj_) _Pragma("unroll") for (int rr_ = 0; rr_ < 4; ++rr_) { \
            const v4u va_ = {attn128::cvtpk_s(VX[jj_][rr_], VX[2 + jj_][rr_]), attn128::cvtpk_s(VX[4 + jj_][rr_], VX[6 + jj_][rr_]), 0u, 0u}; \
            acc[jj_][rr_] = __builtin_amdgcn_mfma_f32_16x16x32_bf16(__builtin_bit_cast(bf16x8, va_), __builtin_bit_cast(bf16x8, pb_), acc[jj_][rr_], 0, 0, 0); } \
        if (NEXT_OK) DEC_ISSUE_V(VX, tn_); } while (0)
        DEC_ISSUE_K(KA, 0); DEC_ISSUE_V(VA, 0); DEC_ISSUE_K(KB, 1); DEC_ISSUE_V(VB, 1);
        for (int tt = 0; tt < 16; tt += 2) {
            DEC_TILE(KA, VA, false, tt + 2 < 16, tt + 2);
            DEC_TILE(KB, VB, false, tt + 3 < 16, tt + 3);
        }
        if (wave == 7) {
            const GAS float* kp = outf + OFF_KS + (size_t)(b * DEC_S + ((lane >> 2) < 7 ? (lane >> 2) : 7)) * 512 + h * 128 + 4 * (lane & 3);
#pragma unroll
            for (int j = 0; j < 8; ++j) KA[j] = *(const GAS f32x4v*)(kp + 16 * j);
#pragma unroll
            for (int r = 0; r < 4; ++r) { const int key = 4 * g + r < 7 ? 4 * g + r : 7; const GAS float* vp = outf + OFF_VS + (size_t)(b * DEC_S + key) * 512 + h * 128 + 4 * c16;
                VA[2 * r] = *(const GAS f32x4v*)(vp); VA[2 * r + 1] = *(const GAS f32x4v*)(vp + 64); }
            DEC_TILE(KA, VA, true, false, 0);
        }
#undef DEC_ISSUE_K
#undef DEC_ISSUE_V
#undef DEC_TILE
        const float lt = xrow_sum(lsum);
        if (g == 0) { ML[(wave * 16 + c16) * 2] = mref; ML[(wave * 16 + c16) * 2 + 1] = lt; }
#pragma unroll
        for (int jj = 0; jj < 2; ++jj)
#pragma unroll
            for (int e = 0; e < 4; ++e) *(LAS f32x4v*)(Om + (size_t)((wave * 16 + c16) * 128 + 64 * jj + 16 * g + 4 * e)) = (f32x4v){acc[jj][0][e], acc[jj][1][e], acc[jj][2][e], acc[jj][3][e]};
        __syncthreads();
        { const int qi = wave; float on[2][2];
#pragma unroll
            for (int mp = 0; mp < 2; ++mp) { const int col = mp * 8 + qi; float M = -INFINITY;
#pragma unroll
                for (int w = 0; w < 8; ++w) M = fmaxf(M, ML[(w * 16 + col) * 2]);
                float L = 0.f, o0 = 0.f, o1 = 0.f;
#pragma unroll
                for (int w = 0; w < 8; ++w) { const float wt = __builtin_amdgcn_exp2f(ML[(w * 16 + col) * 2] - M); L = fmaf(wt, ML[(w * 16 + col) * 2 + 1], L);
                    const f32x2w ov = *(const LAS f32x2w*)(Om + (size_t)((w * 16 + col) * 128 + 2 * lane)); o0 = fmaf(wt, ov.x, o0); o1 = fmaf(wt, ov.y, o1); }
                const float inv = 1.0f / L; on[mp][0] = o0 * inv; on[mp][1] = o1 * inv; }
            const float lam = compute_lam(F, A);
            const float d0 = on[0][0] - lam * on[1][0], d1 = on[0][1] - lam * on[1][1];
            const float rs = 1.0f / sqrtf(wave_sum(d0 * d0 + d1 * d1) * (1.f / 128.f) + EPS);
            const size_t row = (size_t)(MP + b * DEC_S + qi); const int cc = h * 128 + 2 * lane;
            const unsigned gaw = *(const GAS unsigned*)(GAb + row * 512 + cc);
            const float y0 = d0 * rs * subln[2 * lane] * __uint_as_float(gaw << 16), y1 = d1 * rs * subln[2 * lane + 1] * __uint_as_float(gaw & 0xffff0000u);
            *(GAS unsigned*)(Mb + row * 1024 + cc) = pk2(y0, y1); }
        __syncthreads();
    }
}
__device__ __forceinline__ void attn_post(Frame& F, const Args& A, const int blk) {
    const float lam = compute_lam(F, A);
    const float* subln = A.in[12]; const bf16 *O1b = WSP(bf16, WS_O1), *O2b = WSP(bf16, WS_O2), *GAb = WSP(bf16, WS_GA); bf16* Mb = WSP(bf16, WS_M);
    int tid_ = F.wave * 64 + lane_id(); asm volatile("" : "+v"(tid_)); const int lane = tid_ & 63, wv = __builtin_amdgcn_readfirstlane(tid_ >> 6);
    const f32x4 sg0 = *(const f32x4*)(subln + (8 * lane & 127)), sg1 = *(const f32x4*)(subln + (8 * lane & 127) + 4);
    const int row0 = (blk >> 7) * SEQ + (blk & 31) * 256 + (lane >> 4), col = ((blk >> 5) & 3) * 128 + 8 * (lane & 15);
    for (int trip = wv; trip < 16; trip += NWAVES) {
        v4u a[4], b[4], gq[4];
#pragma unroll
        for (int r = 0; r < 4; ++r) { const size_t ro = (size_t)(row0 + 16 * trip + 4 * r) * 512 + col; a[r] = *(const v4u*)(O1b + ro); b[r] = *(const v4u*)(O2b + ro); gq[r] = *(const v4u*)(GAb + ro); }
#pragma unroll
        for (int r = 0; r < 4; ++r) {
            float o[8], gg[8]; float ss = 0.f;
#pragma unroll
            for (int i = 0; i < 4; ++i) { const unsigned aw = a[r][i], bw = b[r][i], gw_ = gq[r][i];
                o[2 * i] = __uint_as_float(aw << 16) - lam * __uint_as_float(bw << 16); o[2 * i + 1] = __uint_as_float(aw & 0xffff0000u) - lam * __uint_as_float(bw & 0xffff0000u);
                gg[2 * i] = __uint_as_float(gw_ << 16); gg[2 * i + 1] = __uint_as_float(gw_ & 0xffff0000u);
                ss += o[2 * i] * o[2 * i] + o[2 * i + 1] * o[2 * i + 1]; }
            ss = row16_sum(ss);
            const float rs = 1.0f / sqrtf(ss * (1.f / 128.f) + EPS);
            v4u w; w.x = pk2(o[0] * rs * sg0[0] * gg[0], o[1] * rs * sg0[1] * gg[1]); w.y = pk2(o[2] * rs * sg0[2] * gg[2], o[3] * rs * sg0[3] * gg[3]);
            w.z = pk2(o[4] * rs * sg1[0] * gg[4], o[5] * rs * sg1[1] * gg[5]); w.w = pk2(o[6] * rs * sg1[2] * gg[6], o[7] * rs * sg1[3] * gg[7]);
            { bf16* mp_ = Mb + (size_t)(row0 + 16 * trip + 4 * r) * 1024 + col; asm volatile("global_store_dwordx4 %0, %1, off sc1\n\ts_nop 1" :: "v"(mp_), "v"(w) : "memory"); } }
    }
}
template <bool PROMPT> __device__ __forceinline__ void final_norm(Frame& F, const Args& A, const int first_cu) {
    if (PROMPT && (int)blockIdx.x < first_cu) return;
    const float* part = WSP(float, WS_PART); const float* xs = A.in[1]; float* out = A.out;
    int tid_ = F.wave * 64 + lane_id(); asm volatile("" : "+v"(tid_)); const int lane = tid_ & 63, gw = ((int)blockIdx.x - first_cu) * NWAVES + __builtin_amdgcn_readfirstlane(tid_ >> 6), NGW = ((int)F.G - first_cu) * NWAVES;
    f32x4 gv[4];
#pragma unroll
    for (int j = 0; j < 4; ++j) gv[j] = *((const f32x4*)A.in[20] + lane + 64 * j);
    if constexpr (PROMPT) { const float* xp = A.in[0]; const bf16* mix = WSP(bf16, WS_MIX); typedef unsigned u32x2 __attribute__((ext_vector_type(2)));
      for (int grp = gw; grp < MP / 4; grp += NGW) {
        f32x4 y[4][4]; u32x2 mw[4][4];
#pragma unroll
        for (int r = 0; r < 4; ++r)
#pragma unroll
            for (int j = 0; j < 4; ++j) { y[r][j] = *((const f32x4*)(xp + (size_t)(4 * grp + r) * D_MODEL) + lane + 64 * j); mw[r][j] = *((const u32x2*)(mix + (size_t)(4 * grp + r) * D_MODEL) + lane + 64 * j); }
#pragma unroll
        for (int r = 0; r < 4; ++r) { float ss = 0.f;
#pragma unroll
            for (int j = 0; j < 4; ++j) { y[r][j][0] += __uint_as_float(mw[r][j].x << 16); y[r][j][1] += __uint_as_float(mw[r][j].x & 0xffff0000u); y[r][j][2] += __uint_as_float(mw[r][j].y << 16); y[r][j][3] += __uint_as_float(mw[r][j].y & 0xffff0000u);
                ss += (y[r][j][0] * y[r][j][0] + y[r][j][1] * y[r][j][1]) + (y[r][j][2] * y[r][j][2] + y[r][j][3] * y[r][j][3]); }
            const float rs = 1.0f / sqrtf(wave_sum(ss) * (1.f / D_MODEL) + EPS);
#pragma unroll
            for (int j = 0; j < 4; ++j) { const f32x4 yo_ = y[r][j] * rs * gv[j]; float* yp_ = out + (size_t)(4 * grp + r) * D_MODEL + 4 * (lane + 64 * j); asm volatile("global_store_dwordx4 %0, %1, off sc1\n\ts_nop 1" :: "v"(yp_), "v"(yo_) : "memory"); } }
      } }
    else for (int row = first_cu + 2 * (gw & 7), rend = row + 2; row < rend; ++row) {
        f32x4 y[4]; float ss = 0.f;
#pragma unroll
        for (int j = 0; j < 4; ++j) { const size_t o = (size_t)row * D_MODEL + 4 * lane + 256 * j;
            y[j] = *(const f32x4*)(xs + o) + ((*(const f32x4*)(part + o) + *(const f32x4*)(part + o + (size_t)MS * D_MODEL)) + (*(const f32x4*)(part + o + 2 * (size_t)MS * D_MODEL) + *(const f32x4*)(part + o + 3 * (size_t)MS * D_MODEL)));
            ss += (y[j][0] * y[j][0] + y[j][1] * y[j][1]) + (y[j][2] * y[j][2] + y[j][3] * y[j][3]); }
        const float rs = 1.0f / sqrtf(wave_sum(ss) * (1.f / D_MODEL) + EPS);
#pragma unroll
        for (int j = 0; j < 4; ++j) *((f32x4*)(out + OFF_YS + (size_t)row * D_MODEL) + lane + 64 * j) = y[j] * rs * gv[j];
    }
}

__global__ void __launch_bounds__(NWAVES * 64, 2) hymba_fwd(Args args) {
    extern __shared__ __attribute__((aligned(16))) unsigned char lds[];
    Frame F;
    F.lds = (LAS unsigned char*)lds;
    F.MISC = (volatile LAS unsigned*)(F.lds + MISC_OFF);
    F.wave = __builtin_amdgcn_readfirstlane((int)threadIdx.x >> 6);
    F.G = gridDim.x; { const int bx = blockIdx.x; F.vcu = (F.G % 8 == 0) ? (bx % 8) * (F.G / 8) + bx / 8 : bx; }
    const Args& A = args;
    F.ctl = (gu32*)(A.ws + WS_CTL);
    for (int u = F.wave * 64 + lane_id(); u < (LDS_BYTES - LDSCTL_OFF) / 4; u += NWAVES * 64) ((LAS unsigned*)(F.lds + LDSCTL_OFF))[u] = 0u;
    __syncthreads();
    XcdBarrier bar = xcd_barrier_post((unsigned*)(F.ctl + CW_BAR), F.MISC + 8, F.wave);

#ifndef SKIP_P0
    p0_prologue(F, A);
#endif
    xcd_barrier(bar);
#ifndef SKIP_G1
    { pg8::Gemm g{WSP(bf16, WS_XN), WSP(bf16, WS_WIN), MT, D_IN, D_MODEL, D_MODEL}; pg8::StaticOrder S; S.init(MT, D_IN, F.G, (int)blockIdx.x);
      pg8::EpiIn E{WSP(bf16, WS_Q), WSP(bf16, WS_K), WSP(bf16, WS_V), WSP(bf16, WS_GA), WSP(bf16, WS_GC), WSP(bf16, WS_U), A.out};
      pg8::gemm_phase<pg8::EpiIn, pg8::StaticOrder, false, PG8_SP2>(F.lds + RING_OFF, g, S, E, F.wave); }
#endif
    p1_idle_transposes(F, A);
    xcd_barrier(bar);
#ifndef SKIP_CONV
    conv_phase(F, A);
#endif
    asm volatile("s_waitcnt vmcnt(0)" ::: "memory");
    __syncthreads();
    if (F.wave == 0 && lane_id() == 0) {
        xcd_arrive((unsigned*)F.ctl, CW_XCONV, CW_CONV, bar.x, F.MISC[8]); }
    {
      const attn128::bf16 *Qp = WSP(const attn128::bf16, WS_Q), *Kp = WSP(const attn128::bf16, WS_K), *Vp = WSP(const attn128::bf16, WS_V);
      const int grp = F.vcu >> 4, s16 = F.vcu & 15, ab = grp >> 3, ah = (grp >> 1) & 3, amap = grp & 1;
      const int cmb = ((F.vcu & 31) * 3) >> 5; const bool rev = cmb != 1 || (grp & 1) != 0; const int sa = cmb, sb = cmb;
      for (int i = 0; i < 3; ++i) {
          if (i == sa) decode_items(F, A, F.vcu, DEC_B * 4);
          if (i < 2) { const int qb = ((i == 0) != rev) ? s16 : 31 - s16;
              attn128::bf16* Op = amap ? WSP(attn128::bf16, WS_O2) : WSP(attn128::bf16, WS_O1);
              if (attn128::attn_unit<8, true>(ab, ah * 128 + amap * 64, ah * 128, qb, Qp, Kp, Vp, Op, (char*)lds + RING_OFF, F.wave))
                  (void)attn128::attn_unit<8, false>(ab, ah * 128 + amap * 64, ah * 128, qb, Qp, Kp, Vp, Op, (char*)lds + RING_OFF, F.wave);
              asm volatile("s_waitcnt vmcnt(0)" ::: "memory");
              __syncthreads();
              if (F.wave == 0 && lane_id() == 0) { const int blk = (grp >> 1) * 32 + qb;
                  if (xb_add((unsigned*)(F.ctl + CW_PAIR + 16 * blk), 1u) == 1u) { const unsigned qi = xb_add((unsigned*)(F.ctl + CW_QTAIL), 1u);
                      __hip_atomic_store((unsigned*)(F.ctl + CW_QUEUE + 8 * (qi & 255u)), (unsigned)blk + 1u, RLX_AGENT); } } }

      }
    }
    asm volatile("s_waitcnt vmcnt(0)" ::: "memory");
    __syncthreads();
    if (F.wave == 0 && lane_id() == 0) {
        unsigned* tb = (unsigned*)(F.ctl + CW_BAR);
        const unsigned t = xb_add((unsigned*)(F.ctl + CW_TICKET), 1u);
        if (t < (unsigned)((MT / 256) * 2)) { XB_SPIN(xb_ld((unsigned*)(F.ctl + CW_CONV)) < (unsigned)F.G, tb); __builtin_amdgcn_fence(__ATOMIC_ACQUIRE, "agent"); asm volatile("s_waitcnt vmcnt(0)" ::: "memory"); }
        F.MISC[12] = t; }
    __syncthreads();
    { pg8::Gemm g{WSP(bf16, WS_C), WSP(bf16, WS_WPW), MT, 512, 512, 512}; pg8::TicketOrder S{__builtin_amdgcn_readfirstlane((int)F.MISC[12])};
      pg8::EpiPw2 E{A.in[18], WSP(bf16, WS_GC), WSP(bf16, WS_M)};
      pg8::gemm_phase<pg8::EpiPw2, pg8::TicketOrder, PG8_ALIGN, PG8_SP2>(F.lds + RING_OFF, g, S, E, F.wave); }
    { const int t_ = __builtin_amdgcn_readfirstlane((int)F.MISC[12]);
      if (t_ < 128) {
          asm volatile("s_waitcnt vmcnt(0)" ::: "memory");
          __syncthreads();
          if (F.wave == 0 && lane_id() == 0) panel_post((unsigned*)F.ctl, t_ >> 1); } }
    for (;;) {
        __syncthreads();
        if (F.wave == 0 && lane_id() == 0) { unsigned* tb = (unsigned*)(F.ctl + CW_BAR);
            const unsigned qi = xb_add((unsigned*)(F.ctl + CW_QHEAD), 1u); unsigned e = 0u;
            if (qi < 256u) { unsigned* qe = (unsigned*)(F.ctl + CW_QUEUE + 8 * qi); XB_SPIN((e = xb_ld(qe)) == 0u, tb);
                __builtin_amdgcn_fence(__ATOMIC_ACQUIRE, "agent"); asm volatile("s_waitcnt vmcnt(0)" ::: "memory"); }
            F.MISC[13] = e; }
        __syncthreads();
        const int e = __builtin_amdgcn_readfirstlane((int)F.MISC[13]);
        if (e == 0) break;
        attn_post(F, A, e - 1);
        asm volatile("s_waitcnt vmcnt(0)" ::: "memory");
        __syncthreads();
        if (F.wave == 0 && lane_id() == 0) panel_post((unsigned*)F.ctl, ((e - 1) >> 7) * 32 + ((e - 1) & 31));
    }
    for (;;) {
        __syncthreads();
        if (F.wave == 0 && lane_id() == 0) { unsigned* tb = (unsigned*)(F.ctl + CW_BAR);
            const unsigned qi = xb_add((unsigned*)(F.ctl + CW_PHEAD), 1u); unsigned e = 0u;
            if (qi < 256u) { unsigned* qe = (unsigned*)(F.ctl + CW_PQ + 4 * qi); XB_SPIN((e = xb_ld(qe)) == 0u, tb);
                __builtin_amdgcn_fence(__ATOMIC_ACQUIRE, "agent"); asm volatile("s_waitcnt vmcnt(0)" ::: "memory"); }
            F.MISC[13] = e; }
        __syncthreads();
        const int e = __builtin_amdgcn_readfirstlane((int)F.MISC[13]);
        if (e == 0) break;
        { pg8::Gemm g{WSP(bf16, WS_M), WSP(bf16, WS_WOUT), MP, D_MODEL, D_MODEL, D_MODEL}; pg8::OneUnit S{(e - 1) >> 2, (e - 1) & 3};
          pg8::EpiOut E{WSP(bf16, WS_MIX)};
          pg8::gemm_phase<pg8::EpiOut, pg8::OneUnit, PG8_ALIGN, PG8_SP2>(F.lds + RING_OFF, g, S, E, F.wave); }
    }
    xcd_barrier(bar);
    { const int c = (int)blockIdx.x, kc = c & 3;
      pg8::Gemm g{WSP(bf16, WS_M) + kc * 256, WSP(bf16, WS_WOUT) + kc * 256, MT, D_MODEL, 256, D_MODEL}; pg8::SampleOrder S{c};
      pg8::EpiPart E{WSP(float, WS_PART) + (size_t)kc * MS * D_MODEL};
      pg8::gemm_phase<pg8::EpiPart, pg8::SampleOrder, PG8_ALIGN, PG8_SP2>(F.lds + RING_OFF, g, S, E, F.wave); }
    if ((int)blockIdx.x < 64) {
        const int rb = (int)blockIdx.x >> 4;
        asm volatile("s_waitcnt vmcnt(0)" ::: "memory");
        __syncthreads();
        if (F.wave == 0 && lane_id() == 0) {
            unsigned* cnt = (unsigned*)(F.ctl + CW_SROW + 64 * rb); unsigned* tb = (unsigned*)(F.ctl + CW_BAR);
            __builtin_amdgcn_fence(__ATOMIC_RELEASE, "agent");
            asm volatile("s_waitcnt vmcnt(0)" ::: "memory");
            (void)xb_add(cnt, 1u);
            XB_SPIN(xb_ld(cnt) < 16u, tb);
            __builtin_amdgcn_fence(__ATOMIC_ACQUIRE, "agent");
            asm volatile("s_waitcnt vmcnt(0)" ::: "memory");
        }
        __syncthreads();
        final_norm<false>(F, A, rb * 256 + ((int)blockIdx.x & 15) * 16);
    }
#ifndef SKIP_FIN
    else final_norm<true>(F, A, 64);
#endif
}

extern "C" void kernel_launch(void* const* d_in, const int* in_sizes, int n_in, void* d_out, int out_size, void* d_ws, size_t ws_size, hipStream_t stream) {
    static int grid = 0;
    if (grid == 0) {
        if (n_in != 21 || in_sizes[0] != MP * D_MODEL || (size_t)out_size != OUT_TOTAL || ws_size < WS_END) { fprintf(stderr, "kernel_launch: unexpected problem (n_in %d, in0 %d, out %d, ws %zu); nothing launched\n", n_in, n_in > 0 ? in_sizes[0] : -1, out_size, ws_size); grid = -1; return; }
        int dev = 0, cus = 0, per_cu = 0;
        if (hipGetDevice(&dev) != hipSuccess || hipDeviceGetAttribute(&cus, hipDeviceAttributeMultiprocessorCount, dev) != hipSuccess) { fprintf(stderr, "kernel_launch: device query failed\n"); grid = -1; return; }
        if (hipFuncSetAttribute((const void*)hymba_fwd, hipFuncAttributeMaxDynamicSharedMemorySize, LDS_BYTES) != hipSuccess) { fprintf(stderr, "kernel_launch: hipFuncSetAttribute failed\n"); grid = -1; return; }
        if (hipOccupancyMaxActiveBlocksPerMultiprocessor(&per_cu, (const void*)hymba_fwd, NWAVES * 64, LDS_BYTES) != hipSuccess || per_cu < 1)
            fprintf(stderr, "kernel_launch: note: occupancy query reports %d workgroups per CU\n", per_cu);
        (void)hipGetLastError();
        grid = cus;
        if (grid != 256) fprintf(stderr, "kernel_launch: %d CUs; the attention unit deal is written for 256\n", grid);
    }
    if (grid < 0) return;
    if (hipMemsetAsync((char*)d_ws + WS_CTL, 0, CTL_ZERO_BYTES, stream) != hipSuccess) { fprintf(stderr, "kernel_launch: memset failed\n"); return; }
    Args a{};
    for (int i = 0; i < 21; ++i) a.in[i] = (const float*)d_in[i];
    a.out = (float*)d_out; a.ws = (unsigned char*)d_ws;
    hipLaunchKernelGGL(hymba_fwd, dim3(grid), dim3(NWAVES * 64), LDS_BYTES, stream, a);
    const hipError_t le = hipPeekAtLastError();
    if (le != hipSuccess) fprintf(stderr, "kernel_launch: launch failed: %s\n", hipGetErrorName(le));
}
```
